# Optimizing an MI355X kernel written in HIP

```python
import math
import jax, jax.numpy as jnp
from jax import lax
import numpy as np

D_MODEL = 1024
BATCH = 8
SEQ = 8192
DEPTH = 1

MLA_HEADS = 8
Q_LORA_RANK = 256
KV_LORA_RANK = 128
QK_NOPE_DIM = 64
QK_ROPE_DIM = 32
V_HEAD_DIM = 64
ROPE_THETA = 10000.0
Q_BLOCK = 128
SSM_GROUP = 16
SSM_GROUPS = 32
SSM_WIDTH = SSM_GROUP * SSM_GROUPS
SSM_STATE = 64
DT_MIN = 0.001
DT_MAX = 0.1
D_FF = 2816
FFN_RES = 0.5
EPS = 1e-6
N_BRANCH = 2
MAX_POS_OFFSET = 4096

OFF_CQ = 0
OFF_CKV = OFF_CQ + Q_LORA_RANK
OFF_KR = OFF_CKV + KV_LORA_RANK
OFF_U = OFF_KR + QK_ROPE_DIM
OFF_GA = OFF_U + SSM_WIDTH
OFF_GS = OFF_GA + D_MODEL
IN_PROJ = OFF_GS + D_MODEL

kernel_name = "hybrid_mla_s5_macaron_encoder"


def _rmsnorm(x, g):
    x32 = x.astype(jnp.float32)
    y = x32 * lax.rsqrt(jnp.mean(x32 * x32, axis=-1, keepdims=True) + EPS)
    return (y * g.astype(jnp.float32)).astype(x.dtype)


def _swiglu(x, w_gate, w_up, w_down):
    return (jax.nn.silu(x @ w_gate) * (x @ w_up)) @ w_down


def _rope_tables(positions):
    inv_freq = ROPE_THETA ** (-jnp.arange(0, QK_ROPE_DIM, 2, dtype=jnp.float32) / QK_ROPE_DIM)
    ang = positions.astype(jnp.float32)[..., None] * inv_freq
    return jnp.cos(ang), jnp.sin(ang)


def _apply_rope(t, cos, sin):
    half = t.shape[-1] // 2
    cos = cos.astype(t.dtype)
    sin = sin.astype(t.dtype)
    t1, t2 = t[..., :half], t[..., half:]
    return jnp.concatenate([t1 * cos - t2 * sin, t2 * cos + t1 * sin], axis=-1)


def _mla_attention(q_nope, q_rope, k_nope, k_rope, v):
    b, s, h, _ = q_nope.shape
    dv = v.shape[-1]
    n_blk = s // Q_BLOCK
    scale = (QK_NOPE_DIM + QK_ROPE_DIM) ** -0.5

    def blocks(t):
        return t.reshape((b, n_blk, Q_BLOCK) + t.shape[2:]).swapaxes(0, 1)

    def attend(qs):
        qn, qr = qs
        sc = (jnp.einsum('bqhd,bkhd->bhqk', qn, k_nope)
              + jnp.einsum('bqhr,bkr->bhqk', qr, k_rope))
        p = jax.nn.softmax(sc.astype(jnp.float32) * scale, axis=-1).astype(v.dtype)
        return jnp.einsum('bhqk,bkhd->bqhd', p, v)

    o = lax.map(attend, (blocks(q_nope), blocks(q_rope)))
    return o.swapaxes(0, 1).reshape(b, s, h * dv)


def _ssm_direction(u, lam_re, lam_im, log_dt, b_re, b_im, c_re, c_im, reverse):
    dt = jnp.exp(log_dt)[:, None]
    mag = jnp.exp(lam_re * dt)
    lb_re = mag * jnp.cos(lam_im * dt)
    lb_im = mag * jnp.sin(lam_im * dt)
    den = lam_re * lam_re + lam_im * lam_im
    nr = lb_re - 1.0
    k_re = (nr * lam_re + lb_im * lam_im) / den
    k_im = (lb_im * lam_re - nr * lam_im) / den
    bb_re = k_re[..., None] * b_re - k_im[..., None] * b_im
    bb_im = k_re[..., None] * b_im + k_im[..., None] * b_re
    x_re = jnp.einsum('sbgi,gpi->sbgp', u, bb_re)
    x_im = jnp.einsum('sbgi,gpi->sbgp', u, bb_im)
    seq = u.shape[0]
    a_re = jnp.broadcast_to(lb_re, (seq, 1) + lb_re.shape)
    a_im = jnp.broadcast_to(lb_im, (seq, 1) + lb_im.shape)

    def combine(e1, e2):
        ar1, ai1, xr1, xi1 = e1
        ar2, ai2, xr2, xi2 = e2
        ar = ar2 * ar1 - ai2 * ai1
        ai = ar2 * ai1 + ai2 * ar1
        xr = ar2 * xr1 - ai2 * xi1 + xr2
        xi = ar2 * xi1 + ai2 * xr1 + xi2
        return (ar, ai, xr, xi)

    _, _, h_re, h_im = lax.associative_scan(combine, (a_re, a_im, x_re, x_im),
                                            reverse=reverse, axis=0)
    return (jnp.einsum('sbgp,gip->sbgi', h_re, c_re)
            - jnp.einsum('sbgp,gip->sbgi', h_im, c_im))


def setup_inputs(seed: int = 0) -> dict:
    key = jax.random.key(seed)
    ks = iter(jax.random.split(key, 48))
    f32 = jnp.float32

    def nrm(shape, fan_in):
        return jax.random.normal(next(ks), shape, f32) * (fan_in ** -0.5)

    def gain(shape):
        return 1.0 + 0.02 * jax.random.normal(next(ks), shape, f32)

    L, D, G, P, I = DEPTH, D_MODEL, SSM_GROUPS, SSM_STATE, SSM_GROUP
    x = jax.random.normal(next(ks), (BATCH, SEQ, D), f32)
    offset = jax.random.randint(next(ks), (BATCH, 1), 0, MAX_POS_OFFSET, dtype=jnp.int32)
    positions = (jnp.arange(SEQ, dtype=jnp.int32)[None, :] + offset).astype(jnp.int32)

    n_idx = jnp.arange(P, dtype=f32)
    lam_re = -0.5 + 0.01 * jax.random.normal(next(ks), (L, 2, G, P), f32)
    lam_im = jnp.pi * n_idx + 0.01 * jax.random.normal(next(ks), (L, 2, G, P), f32)
    log_dt = jax.random.uniform(next(ks), (L, 2, G), f32,
                                minval=math.log(DT_MIN), maxval=math.log(DT_MAX))

    return {
        "x": x,
        "positions": positions,
        "ffn1_norm": gain((L, D)),
        "ffn1_w_gate": nrm((L, D, D_FF), D),
        "ffn1_w_up": nrm((L, D, D_FF), D),
        "ffn1_w_down": nrm((L, D_FF, D), D_FF),
        "mix_norm": gain((L, D)),
        "w_in": nrm((L, D, IN_PROJ), D),
        "q_norm": gain((L, Q_LORA_RANK)),
        "w_uq": nrm((L, Q_LORA_RANK, MLA_HEADS * (QK_NOPE_DIM + QK_ROPE_DIM)), Q_LORA_RANK),
        "kv_norm": gain((L, KV_LORA_RANK)),
        "w_ukv": nrm((L, KV_LORA_RANK, MLA_HEADS * (QK_NOPE_DIM + V_HEAD_DIM)), KV_LORA_RANK),
        "w_o_attn": nrm((L, MLA_HEADS * V_HEAD_DIM, D), MLA_HEADS * V_HEAD_DIM),
        "ssm_lambda_re": lam_re,
        "ssm_lambda_im": lam_im,
        "ssm_log_dt": log_dt,
        "ssm_b_re": nrm((L, 2, G, P, I), 2 * I),
        "ssm_b_im": nrm((L, 2, G, P, I), 2 * I),
        "ssm_c_re": nrm((L, 2, G, I, P), 2 * P),
        "ssm_c_im": nrm((L, 2, G, I, P), 2 * P),
        "ssm_d": jax.random.normal(next(ks), (L, SSM_WIDTH), f32),
        "w_glu": nrm((L, SSM_WIDTH, 2 * SSM_WIDTH), SSM_WIDTH),
        "b_glu": 0.01 * jax.random.normal(next(ks), (L, 2 * SSM_WIDTH), f32),
        "w_o_ssm": nrm((L, SSM_WIDTH, D), SSM_WIDTH),
        "w_out": nrm((L, D, D), D),
        "ffn2_norm": gain((L, D)),
        "ffn2_w_gate": nrm((L, D, D_FF), D),
        "ffn2_w_up": nrm((L, D, D_FF), D),
        "ffn2_w_down": nrm((L, D_FF, D), D_FF),
        "final_norm": gain((D,)),
    }


def reference(x, positions, ffn1_norm, ffn1_w_gate, ffn1_w_up, ffn1_w_down, mix_norm, w_in,
              q_norm, w_uq, kv_norm, w_ukv, w_o_attn, ssm_lambda_re, ssm_lambda_im,
              ssm_log_dt, ssm_b_re, ssm_b_im, ssm_c_re, ssm_c_im, ssm_d, w_glu, b_glu,
              w_o_ssm, w_out, ffn2_norm, ffn2_w_gate, ffn2_w_up, ffn2_w_down, final_norm):
    b, s, _ = x.shape
    f32 = jnp.float32
    cos, sin = _rope_tables(positions)
    h = x
    for l in range(DEPTH):
        h = h + FFN_RES * _swiglu(_rmsnorm(h, ffn1_norm[l]), ffn1_w_gate[l], ffn1_w_up[l], ffn1_w_down[l])

        n = _rmsnorm(h, mix_norm[l])
        z = n @ w_in[l]
        c_q = z[..., OFF_CQ:OFF_CKV]
        c_kv = z[..., OFF_CKV:OFF_KR]
        k_r = z[..., OFF_KR:OFF_U]
        u = z[..., OFF_U:OFF_GA]
        g_attn = z[..., OFF_GA:OFF_GS]
        g_ssm = z[..., OFF_GS:IN_PROJ]

        q = (_rmsnorm(c_q, q_norm[l]) @ w_uq[l]).reshape(b, s, MLA_HEADS, QK_NOPE_DIM + QK_ROPE_DIM)
        q_nope = q[..., :QK_NOPE_DIM]
        q_rope = _apply_rope(q[..., QK_NOPE_DIM:], cos[:, :, None, :], sin[:, :, None, :])
        kv = (_rmsnorm(c_kv, kv_norm[l]) @ w_ukv[l]).reshape(b, s, MLA_HEADS, QK_NOPE_DIM + V_HEAD_DIM)
        k_nope = kv[..., :QK_NOPE_DIM]
        v = kv[..., QK_NOPE_DIM:]
        k_rope = _apply_rope(k_r, cos, sin)
        attn = _mla_attention(q_nope, q_rope, k_nope, k_rope, v)

        u32 = u.astype(f32)
        ug = u32.reshape(b, s, SSM_GROUPS, SSM_GROUP).swapaxes(0, 1)
        y_dirs = []
        for direction, rev in ((0, False), (1, True)):
            y_dirs.append(_ssm_direction(
                ug,
                ssm_lambda_re[l, direction].astype(f32), ssm_lambda_im[l, direction].astype(f32),
                ssm_log_dt[l, direction].astype(f32),
                ssm_b_re[l, direction].astype(f32), ssm_b_im[l, direction].astype(f32),
                ssm_c_re[l, direction].astype(f32), ssm_c_im[l, direction].astype(f32),
                rev))
        y_ssm = (y_dirs[0] + y_dirs[1]).swapaxes(0, 1).reshape(b, s, SSM_WIDTH)
        y_ssm = (y_ssm + ssm_d[l].astype(f32) * u32).astype(x.dtype)
        glu = jax.nn.gelu(y_ssm) @ w_glu[l] + b_glu[l]
        ssm_out = glu[..., :SSM_WIDTH] * jax.nn.sigmoid(glu[..., SSM_WIDTH:])

        merged = (jax.nn.sigmoid(g_attn) * (attn @ w_o_attn[l])
                  + jax.nn.sigmoid(g_ssm) * (ssm_out @ w_o_ssm[l]))
        h = h + merged @ w_out[l]

        h = h + FFN_RES * _swiglu(_rmsnorm(h, ffn2_norm[l]), ffn2_w_gate[l], ffn2_w_up[l], ffn2_w_down[l])
    return _rmsnorm(h, final_norm)
```

```cpp
#include <hip/hip_runtime.h>
#include <hip/hip_cooperative_groups.h>
#include <cstdio>
#include <cstdint>
namespace cg = cooperative_groups;

#define LAS __attribute__((address_space(3)))
#define DI __device__ __forceinline__
typedef unsigned short bf16_t;
typedef short bf16x8 __attribute__((ext_vector_type(8)));
typedef short s16x4 __attribute__((ext_vector_type(4)));
typedef float f32x2 __attribute__((ext_vector_type(2)));
typedef float f32x4 __attribute__((ext_vector_type(4)));
typedef float f32x16 __attribute__((ext_vector_type(16)));
typedef unsigned u32x2 __attribute__((ext_vector_type(2)));
typedef unsigned u32x4 __attribute__((ext_vector_type(4)));
typedef __bf16 bf16x2_t __attribute__((ext_vector_type(2)));

constexpr int NB = 8, SEQ = 8192, T = NB * SEQ, D = 1024, FF = 2816, NH = 8;
constexpr int NIN = 3072;
constexpr int CL = 32, NCH = SEQ / CL;
constexpr int MG = T / CL;
constexpr int KP = 768;
constexpr float EPS = 1e-6f;
constexpr float QSCALE = 0.14724438f;

constexpr size_t MiB = 1u << 20, QM = MiB / 4;
constexpr size_t O_WGU1 = 0, O_WD1 = 11 * MiB, O_WGU2 = O_WD1 + 22 * QM, O_WD2 = O_WGU2 + 11 * MiB, O_WIN = O_WD2 + 22 * QM;
constexpr size_t O_WUQ = O_WIN + 6 * MiB, O_WUK = O_WUQ + 2 * QM, O_WUV = O_WUK + QM, O_WOA = O_WUV + QM, O_WGLU = O_WOA + MiB, O_WOS = O_WGLU + MiB, O_WOUT = O_WOS + MiB;
constexpr size_t O_WST = O_WOUT + 2 * MiB, O_WSS2 = O_WST + 8 * MiB, O_KT = O_WSS2 + 24 * MiB, O_AL = O_KT + 2 * MiB, O_SSQ = O_AL + QM;
constexpr size_t O_ROPE = O_SSQ + 6 * QM, O_HB = O_ROPE + 8 * MiB, O_H = O_HB + 128 * MiB, O_ACT = O_H + 256 * MiB, O_R4 = O_ACT + 352 * MiB;
constexpr size_t O_CQ = O_ACT, O_CKV = O_CQ + 32 * MiB, O_KR = O_CKV + 16 * MiB, O_APACK = O_KR + 4 * MiB, O_Q = O_APACK + 96 * MiB, O_KN = O_Q + 96 * MiB;
constexpr size_t O_MG = O_Q, O_MRG = O_HB;
constexpr size_t O_VT = O_R4, O_SLOC = O_VT + 64 * MiB, O_ATTN = O_SLOC + 64 * MiB, O_END = O_ATTN + 64 * MiB, O_GY = O_VT, O_SO = O_SLOC;
static_assert(O_KN + 64 * MiB <= O_R4, "act overlay");
static_assert(O_END <= 1024 * MiB, "workspace");
static_assert(O_WIN == 33 * MiB && O_ROPE % 256 == 0 && O_HB % 256 == 0, "map");

DI unsigned pk2(float lo, float hi) { f32x2 v = {lo, hi}; bf16x2_t b = __builtin_convertvector(v, bf16x2_t); return __builtin_bit_cast(unsigned, b); }
DI float bflo(unsigned u) { return __builtin_bit_cast(float, u << 16); }
DI float bfhi(unsigned u) { return __builtin_bit_cast(float, u & 0xffff0000u); }
DI float sigm(float x) { return __builtin_amdgcn_rcpf(1.0f + __expf(-x)); }
DI float silu(float x) { return x * sigm(x); }
DI float gelu_tanh(float x) { const float z = 1.5957691216f * (x + 0.044715f * x * x * x); return x * sigm(z); }
DI float wave_sum(float v) {
#pragma unroll
    for (int o = 1; o < 64; o <<= 1) v += __shfl_xor(v, o);
    return v;
}
DI int lane_id() { int l; asm volatile("v_mbcnt_lo_u32_b32 %0, -1, 0\n\tv_mbcnt_hi_u32_b32 %0, -1, %0" : "=v"(l)); return l; }
DI u32x4 pack8(f32x4 a, f32x4 b) { u32x4 w; w.x = pk2(a[0], a[1]); w.y = pk2(a[2], a[3]); w.z = pk2(b[0], b[1]); w.w = pk2(b[2], b[3]); return w; }

namespace pg8 {
constexpr int BM = 256, BK = 64, HALF = 128, HTB = HALF * BK * 2, STAGE_BYTES = 8 * HTB, NXCD = 8, WGM = 8;
DI int lds_byte(int r, int c) { const int st = (r >> 4) * 2 + (c >> 5), rr = r & 15, cc = c & 31, ob = rr * 64 + cc * 2; return st * 1024 + (ob ^ (((ob >> 9) & 1) << 5)); }
DI void stage_rc(int b, int& R, int& C) { const int st = b / 1024, sb = b % 1024, swz = sb ^ (((sb >> 9) & 1) << 5); R = (st >> 1) * 16 + swz / 64; C = (st & 1) * 32 + (swz % 64) / 2; }
DI int perm32(int rho) { const int n = rho >> 4, i = rho & 15; return 8 * (i >> 2) + 4 * n + (i & 3); }

struct Unit { int g, pm, pn; };
struct Gemm { const bf16_t* A; const bf16_t* Bt; int lda, ldb, K; size_t gsA, gsB; };
struct Order {
    int nM, nN, nwg, total, G, c;
    DI void init(int nM_, int nN_, int ngroups, int G_, int c_) { nM = nM_; nN = nN_; nwg = nM * nN; total = nwg * ngroups; G = G_; c = c_; }
    DI bool next(int i, Unit& u) const {
        const long L = (long)i * G + c; if (L >= total) return false;
        u.g = (int)(L / nwg); int wgid = (int)(L % nwg);
        { const int q = nwg / NXCD, r = nwg % NXCD, xcd = wgid % NXCD, off = wgid / NXCD; wgid = (xcd < r ? xcd * (q + 1) : r * (q + 1) + (xcd - r) * q) + off; }
        const int nig = WGM * nN, gid = wgid / nig, fm = gid * WGM, gsz = (nM - fm) < WGM ? (nM - fm) : WGM;
        u.pm = fm + ((wgid % nig) % gsz); u.pn = (wgid % nig) / gsz; return true;
    }
};

template <class Epi>
DI void gemm_phase(LAS unsigned char* lds, const int wid, const Gemm g, const Order& S, const Epi& E) {
    const int lane = lane_id(), tid = wid * 64 + lane, wr = wid >> 2, wc = wid & 3, fr = lane & 15, fq = lane >> 4;
    const int K = g.K, nt = K / BK;
    unsigned voffA[2], voffB[2];
#pragma unroll
    for (int i = 0; i < 2; ++i) { int R, C; stage_rc(tid * 16 + i * 8192, R, C); const int Rb = (R & ~31) + perm32(R & 31);
        voffA[i] = (unsigned)(R * g.lda + C) * 2u; voffB[i] = (unsigned)(Rb * g.ldb + C) * 2u; }
    const size_t kstep = (size_t)(BK * 2);
    const size_t hstepA = (size_t)HALF * g.lda * 2, hstepB = (size_t)HALF * g.ldb * 2;
    const unsigned ldsw = (unsigned)wid * 1024u;
    const int aoff = lds_byte(wr * 64 + fr, fq * 8), boff = lds_byte(wc * 32 + fr, fq * 8);
#define PG8_SA(b, h) (((b) * 2 + (h)) * HTB)
#define PG8_SB(b, h) ((4 + (b) * 2 + (h)) * HTB)
#define PG8_STAGE(bufoff, gbase, voff) do { _Pragma("unroll") for (int _i = 0; _i < 2; ++_i) \
        __builtin_amdgcn_global_load_lds((const unsigned*)((const char*)(gbase) + (voff)[_i]), (LAS unsigned*)(lds + (bufoff) + ldsw + _i * 8192), 16, 0, 0); } while (0)
#define PG8_LDA(dst, b, h) do { _Pragma("unroll") for (int m = 0; m < 4; ++m) _Pragma("unroll") for (int k = 0; k < 2; ++k) dst[m][k] = *(const LAS bf16x8*)(lds + PG8_SA(b, h) + aoff + m * 2048 + k * 1024); } while (0)
#define PG8_LDB(dst, b, h) do { _Pragma("unroll") for (int n = 0; n < 2; ++n) _Pragma("unroll") for (int k = 0; k < 2; ++k) dst[n][k] = *(const LAS bf16x8*)(lds + PG8_SB(b, h) + boff + n * 2048 + k * 1024); } while (0)
#define PG8_MMA(ai, bj, At, Bt) do { __builtin_amdgcn_s_setprio(1); _Pragma("unroll") for (int m = 0; m < 4; ++m) _Pragma("unroll") for (int n = 0; n < 2; ++n) _Pragma("unroll") for (int k = 0; k < 2; ++k) \
        acc[ai][bj][m][n] = __builtin_amdgcn_mfma_f32_16x16x32_bf16(Bt[n][k], At[m][k], acc[ai][bj][m][n], 0, 0, 0); __builtin_amdgcn_s_setprio(0); } while (0)
#define PG8_WAIT_V(n) asm volatile("s_waitcnt vmcnt(" #n ")" ::: "memory")
#define PG8_WAIT_L(n) asm volatile("s_waitcnt lgkmcnt(" #n ")" ::: "memory")
#define PG8_BAR __builtin_amdgcn_s_barrier()
#define PG8_SCHED __builtin_amdgcn_sched_barrier(0)
    Unit cur, nxt; int ui = 0;
    if (!S.next(0, cur)) return;
    f32x4 acc[2][2][4][2];
#pragma unroll
    for (int a = 0; a < 2; ++a)
#pragma unroll
        for (int b = 0; b < 2; ++b)
#pragma unroll
            for (int m = 0; m < 4; ++m)
#pragma unroll
                for (int n = 0; n < 2; ++n) acc[a][b][m][n] = (f32x4){0.f, 0.f, 0.f, 0.f};
    bf16x8 At[4][2], B0[2][2], B1[2][2];
    const char* cA = (const char*)(g.A + (size_t)cur.g * g.gsA + (size_t)cur.pm * BM * g.lda);
    const char* cB = (const char*)(g.Bt + (size_t)cur.g * g.gsB + (size_t)cur.pn * BM * g.ldb);
    PG8_STAGE(PG8_SB(0, 0), cB, voffB); PG8_STAGE(PG8_SB(0, 1), cB + hstepB, voffB); PG8_STAGE(PG8_SA(0, 0), cA, voffA); PG8_STAGE(PG8_SA(0, 1), cA + hstepA, voffA);
    if (wr == 1) PG8_BAR;
    PG8_WAIT_V(2); PG8_BAR;
    PG8_STAGE(PG8_SB(1, 0), cB + kstep, voffB); PG8_STAGE(PG8_SA(1, 0), cA + kstep, voffA); PG8_STAGE(PG8_SB(1, 1), cB + hstepB + kstep, voffB);
    PG8_WAIT_V(6); PG8_BAR;
    for (;;) {
        const bool has_next = S.next(ui + 1, nxt);
        const char* nA = has_next ? (const char*)(g.A + (size_t)nxt.g * g.gsA + (size_t)nxt.pm * BM * g.lda) : cA;
        const char* nB = has_next ? (const char*)(g.Bt + (size_t)nxt.g * g.gsB + (size_t)nxt.pn * BM * g.ldb) : cB;
        for (int t = 0; t < nt; t += 2) {
            const bool last = (t == nt - 2);
            const char* a1 = cA + (size_t)(t + 1) * kstep;
            const char* a2 = last ? nA : cA + (size_t)(t + 2) * kstep; const char* b2 = last ? nB : cB + (size_t)(t + 2) * kstep;
            const char* a3 = a2 + kstep; const char* b3 = b2 + kstep;
            PG8_LDB(B0, 0, 0); PG8_LDB(B1, 0, 1); PG8_SCHED; PG8_LDA(At, 0, 0); PG8_STAGE(PG8_SA(1, 1), a1 + hstepA, voffA);
            PG8_WAIT_V(8); PG8_WAIT_L(0); PG8_BAR; PG8_MMA(0, 0, At, B0); PG8_MMA(0, 1, At, B1); PG8_BAR; PG8_SCHED;
            PG8_LDA(At, 0, 1); PG8_STAGE(PG8_SB(0, 0), b2, voffB); PG8_STAGE(PG8_SB(0, 1), b2 + hstepB, voffB); PG8_STAGE(PG8_SA(0, 0), a2, voffA);
            PG8_WAIT_V(8); PG8_WAIT_L(0); PG8_BAR; PG8_MMA(1, 0, At, B0); PG8_MMA(1, 1, At, B1); PG8_BAR; PG8_SCHED;
            PG8_LDB(B0, 1, 0); PG8_LDB(B1, 1, 1); PG8_SCHED; PG8_LDA(At, 1, 0); PG8_STAGE(PG8_SA(0, 1), a2 + hstepA, voffA);
            PG8_WAIT_V(8); PG8_WAIT_L(0); PG8_BAR; PG8_MMA(0, 0, At, B0); PG8_MMA(0, 1, At, B1); PG8_BAR; PG8_SCHED;
            PG8_LDA(At, 1, 1); PG8_STAGE(PG8_SB(1, 0), b3, voffB); PG8_STAGE(PG8_SB(1, 1), b3 + hstepB, voffB); PG8_STAGE(PG8_SA(1, 0), a3, voffA);
            PG8_WAIT_V(8); PG8_WAIT_L(0); PG8_BAR; PG8_MMA(1, 0, At, B0); PG8_MMA(1, 1, At, B1); PG8_BAR; PG8_SCHED;
        }
        if (wr == 0) PG8_BAR;
        E(acc, cur, wr, wc, fr, fq);
        if (!has_next) break;
#pragma unroll
        for (int a = 0; a < 2; ++a)
#pragma unroll
            for (int b = 0; b < 2; ++b)
#pragma unroll
                for (int m = 0; m < 4; ++m)
#pragma unroll
                    for (int n = 0; n < 2; ++n) acc[a][b][m][n] = (f32x4){0.f, 0.f, 0.f, 0.f};
        cur = nxt; cA = nA; cB = nB; ++ui;
        if (wr == 1) PG8_BAR;
    }
    PG8_WAIT_V(0);
    PG8_BAR;
#undef PG8_SA
#undef PG8_SB
#undef PG8_STAGE
#undef PG8_LDA
#undef PG8_LDB
#undef PG8_MMA
#undef PG8_WAIT_V
#undef PG8_WAIT_L
#undef PG8_BAR
#undef PG8_SCHED
}
}
using pg8::Unit;
typedef f32x4 Acc[2][2][4][2];

#define EPI_ROWS(ai, m) _Pragma("unroll") for (int ai = 0; ai < 2; ++ai) _Pragma("unroll") for (int m = 0; m < 4; ++m)
DI int epi_row(const Unit& u, int ai, int wr, int m, int fr) { return u.pm * 256 + ai * 128 + wr * 64 + m * 16 + fr; }
DI int epi_col(const Unit& u, int bj, int wc, int fq) { return u.pn * 256 + bj * 128 + wc * 32 + 8 * fq; }
DI float rstd_of(float ssq, float invn) { return __builtin_amdgcn_rsqf(ssq * invn + EPS); }

struct EpiSwiglu {
    const float* ssq; bf16_t* act;
    DI void operator()(const Acc& acc, const Unit& u, int wr, int wc, int fr, int fq) const {
        const int cb = u.pn * 128 + wc * 32 + 8 * fq;
        EPI_ROWS(ai, m) { const int row = epi_row(u, ai, wr, m, fr); const float r = rstd_of(ssq[row], 1.0f / D);
            f32x4 v[2];
#pragma unroll
            for (int n = 0; n < 2; ++n)
#pragma unroll
                for (int j = 0; j < 4; ++j) v[n][j] = silu(acc[ai][0][m][n][j] * r) * (acc[ai][1][m][n][j] * r);
            *(u32x4*)(act + (size_t)row * FF + cb) = pack8(v[0], v[1]); }
    }
};
struct EpiResid {
    const float* res; float* out; float alpha; bf16_t* ob; float* ssq;
    DI void operator()(const Acc& acc, const Unit& u, int wr, int wc, int fr, int fq) const {
        EPI_ROWS(ai, m) { const int row = epi_row(u, ai, wr, m, fr); float sq = 0.f;
#pragma unroll
            for (int bj = 0; bj < 2; ++bj) { const size_t off = (size_t)row * D + epi_col(u, bj, wc, fq);
                const f32x4 r0 = *(const f32x4*)(res + off), r1 = *(const f32x4*)(res + off + 4);
                const f32x4 o0 = r0 + alpha * acc[ai][bj][m][0], o1 = r1 + alpha * acc[ai][bj][m][1];
                *(f32x4*)(out + off) = o0; *(f32x4*)(out + off + 4) = o1;
                if (ob) *(u32x4*)(ob + off) = pack8(o0, o1);
                sq += (o0[0] * o0[0] + o0[1] * o0[1]) + (o0[2] * o0[2] + o0[3] * o0[3]) + (o1[0] * o1[0] + o1[1] * o1[1]) + (o1[2] * o1[2] + o1[3] * o1[3]); }
            sq += __shfl_xor(sq, 16); sq += __shfl_xor(sq, 32);
            if (fq == 0) unsafeAtomicAdd(ssq + row, sq); }
    }
};
struct EpiWin {
    float* ssq1; const f32x2* rope; unsigned char* ws; bf16_t* sga;
    DI void operator()(const Acc& acc, const Unit& u, int wr, int wc, int fr, int fq) const {
        const int pn = u.pn;
        const float* ssq2 = ssq1 + T; float* ssqq = ssq1 + 2 * T; float* ssqkv = ssq1 + 3 * T;
        bf16_t* cq = (bf16_t*)(ws + O_CQ); bf16_t* ckv = (bf16_t*)(ws + O_CKV); bf16_t* kr = (bf16_t*)(ws + O_KR); bf16_t* apack = (bf16_t*)(ws + O_APACK); bf16_t* sgs = sga + (size_t)T * D;
        EPI_ROWS(ai, m) { const int row = epi_row(u, ai, wr, m, fr); const float r = rstd_of(ssq2[row], 1.0f / D);
            if (pn == 0) { float sq = 0.f;
#pragma unroll
                for (int bj = 0; bj < 2; ++bj) { const f32x4 a = acc[ai][bj][m][0] * r, b = acc[ai][bj][m][1] * r;
                    *(u32x4*)(cq + (size_t)row * 256 + bj * 128 + wc * 32 + 8 * fq) = pack8(a, b);
                    sq += (a[0] * a[0] + a[1] * a[1]) + (a[2] * a[2] + a[3] * a[3]) + (b[0] * b[0] + b[1] * b[1]) + (b[2] * b[2] + b[3] * b[3]); }
                sq += __shfl_xor(sq, 16); sq += __shfl_xor(sq, 32);
                if (fq == 0) unsafeAtomicAdd(ssqq + row, sq);
            } else if (pn == 1) {
                { const f32x4 a = acc[ai][0][m][0] * r, b = acc[ai][0][m][1] * r;
                  *(u32x4*)(ckv + (size_t)row * 128 + wc * 32 + 8 * fq) = pack8(a, b);
                  float sq = (a[0] * a[0] + a[1] * a[1]) + (a[2] * a[2] + a[3] * a[3]) + (b[0] * b[0] + b[1] * b[1]) + (b[2] * b[2] + b[3] * b[3]);
                  sq += __shfl_xor(sq, 16); sq += __shfl_xor(sq, 32);
                  if (fq == 0) unsafeAtomicAdd(ssqkv + row, sq); }
                if (wc == 0) {
                    const f32x4 a = acc[ai][1][m][0] * r, b = acc[ai][1][m][1] * r;
                    const f32x4 c0 = *(const f32x4*)(rope + (size_t)row * 16 + 4 * fq), c1 = *(const f32x4*)(rope + (size_t)row * 16 + 4 * fq + 2);
                    f32x4 oa, ob;
                    oa[0] = a[0] * c0[0] - a[1] * c0[1]; oa[1] = a[1] * c0[0] + a[0] * c0[1]; oa[2] = a[2] * c0[2] - a[3] * c0[3]; oa[3] = a[3] * c0[2] + a[2] * c0[3];
                    ob[0] = b[0] * c1[0] - b[1] * c1[1]; ob[1] = b[1] * c1[0] + b[0] * c1[1]; ob[2] = b[2] * c1[2] - b[3] * c1[3]; ob[3] = b[3] * c1[2] + b[2] * c1[3];
                    *(u32x4*)(kr + (size_t)row * 32 + 8 * fq) = pack8(oa, ob); }
            } else if (pn < 4) {
#pragma unroll
                for (int bj = 0; bj < 2; ++bj) { const int uc = (pn - 2) * 256 + bj * 128 + wc * 32 + 8 * fq; const int gg = uc >> 4, i0 = uc & 15;
                    *(u32x4*)(apack + ((size_t)gg * MG + (row >> 5)) * KP + (row & 31) * 16 + i0) = pack8(acc[ai][bj][m][0] * r, acc[ai][bj][m][1] * r); }
            } else { bf16_t* dst = pn < 8 ? sga : sgs; const int c0 = ((pn - 4) & 3) * 256;
#pragma unroll
                for (int bj = 0; bj < 2; ++bj) { f32x4 a, b;
#pragma unroll
                    for (int j = 0; j < 4; ++j) { a[j] = sigm(acc[ai][bj][m][0][j] * r); b[j] = sigm(acc[ai][bj][m][1][j] * r); }
                    *(u32x4*)(dst + (size_t)row * D + c0 + bj * 128 + wc * 32 + 8 * fq) = pack8(a, b); }
            } }
    }
};
struct EpiQ {
    const float* ssqq; const f32x2* rope; bf16_t* q;
    DI void operator()(const Acc& acc, const Unit& u, int wr, int wc, int fr, int fq) const {
        EPI_ROWS(ai, m) { const int row = epi_row(u, ai, wr, m, fr); const float r = rstd_of(ssqq[row], 1.0f / 256) * QSCALE;
#pragma unroll
            for (int bj = 0; bj < 2; ++bj) { const int c = epi_col(u, bj, wc, fq); const int d = c % 96;
                f32x4 a = acc[ai][bj][m][0] * r, b = acc[ai][bj][m][1] * r;
                if (d >= 64) { const int i0 = (d - 64) >> 1;
                    const f32x4 c0 = *(const f32x4*)(rope + (size_t)row * 16 + i0), c1 = *(const f32x4*)(rope + (size_t)row * 16 + i0 + 2);
                    f32x4 oa, ob;
                    oa[0] = a[0] * c0[0] - a[1] * c0[1]; oa[1] = a[1] * c0[0] + a[0] * c0[1]; oa[2] = a[2] * c0[2] - a[3] * c0[3]; oa[3] = a[3] * c0[2] + a[2] * c0[3];
                    ob[0] = b[0] * c1[0] - b[1] * c1[1]; ob[1] = b[1] * c1[0] + b[0] * c1[1]; ob[2] = b[2] * c1[2] - b[3] * c1[3]; ob[3] = b[3] * c1[2] + b[2] * c1[3];
                    a = oa; b = ob; }
                *(u32x4*)(q + (size_t)row * 768 + c) = pack8(a, b); } }
    }
};
struct EpiRowScale {
    const float* ssq; float invn; bf16_t* o; int ldo;
    DI void operator()(const Acc& acc, const Unit& u, int wr, int wc, int fr, int fq) const {
        EPI_ROWS(ai, m) { const int row = epi_row(u, ai, wr, m, fr); const float r = rstd_of(ssq[row], invn);
#pragma unroll
            for (int bj = 0; bj < 2; ++bj) *(u32x4*)(o + (size_t)row * ldo + epi_col(u, bj, wc, fq)) = pack8(acc[ai][bj][m][0] * r, acc[ai][bj][m][1] * r); }
    }
};
struct EpiVt {
    const float* ssq; bf16_t* vt;
    DI void operator()(const Acc& acc, const Unit& u, int wr, int wc, int fr, int fq) const {
#pragma unroll
        for (int bj = 0; bj < 2; ++bj) { const int c = epi_col(u, bj, wc, fq);
            const f32x4 s0 = *(const f32x4*)(ssq + c), s1 = *(const f32x4*)(ssq + c + 4); f32x4 r0, r1;
#pragma unroll
            for (int j = 0; j < 4; ++j) { r0[j] = rstd_of(s0[j], 1.0f / 128); r1[j] = rstd_of(s1[j], 1.0f / 128); }
            EPI_ROWS(ai, m) { const int row = epi_row(u, ai, wr, m, fr);
                *(u32x4*)(vt + (size_t)row * T + c) = pack8(acc[ai][bj][m][0] * r0, acc[ai][bj][m][1] * r1); } }
    }
};
struct EpiSloc {
    float* sloc;
    DI void operator()(const Acc& acc, const Unit& u, int wr, int wc, int fr, int fq) const {
        EPI_ROWS(ai, m) { const int row = epi_row(u, ai, wr, m, fr);
#pragma unroll
            for (int bj = 0; bj < 2; ++bj) { float* p = sloc + ((size_t)u.g * MG + row) * 256 + bj * 128 + wc * 32 + 8 * fq;
                *(f32x4*)p = acc[ai][bj][m][0]; *(f32x4*)(p + 4) = acc[ai][bj][m][1]; } }
    }
};
struct EpiSsmOut {
    bf16_t* gy;
    DI void operator()(const Acc& acc, const Unit& u, int wr, int wc, int fr, int fq) const {
        EPI_ROWS(ai, m) { const int row = epi_row(u, ai, wr, m, fr);
#pragma unroll
            for (int bj = 0; bj < 2; ++bj) { const int c = epi_col(u, bj, wc, fq); const int tau = c >> 4, i0 = c & 15; f32x4 a, b;
#pragma unroll
                for (int j = 0; j < 4; ++j) { a[j] = gelu_tanh(acc[ai][bj][m][0][j]); b[j] = gelu_tanh(acc[ai][bj][m][1][j]); }
                *(u32x4*)(gy + ((size_t)row * CL + tau) * 512 + u.g * 16 + i0) = pack8(a, b); } }
    }
};
template <int MODE> struct EpiGate {
    const bf16_t* gate; const bf16_t* prev; bf16_t* o;
    DI void operator()(const Acc& acc, const Unit& u, int wr, int wc, int fr, int fq) const {
        EPI_ROWS(ai, m) { const int row = epi_row(u, ai, wr, m, fr);
#pragma unroll
            for (int bj = 0; bj < 2; ++bj) { const size_t off = (size_t)row * D + epi_col(u, bj, wc, fq);
                const u32x4 gv = *(const u32x4*)(gate + off); f32x4 a, b;
                a[0] = bflo(gv.x) * acc[ai][bj][m][0][0]; a[1] = bfhi(gv.x) * acc[ai][bj][m][0][1]; a[2] = bflo(gv.y) * acc[ai][bj][m][0][2]; a[3] = bfhi(gv.y) * acc[ai][bj][m][0][3];
                b[0] = bflo(gv.z) * acc[ai][bj][m][1][0]; b[1] = bfhi(gv.z) * acc[ai][bj][m][1][1]; b[2] = bflo(gv.w) * acc[ai][bj][m][1][2]; b[3] = bfhi(gv.w) * acc[ai][bj][m][1][3];
                if (MODE == 1) { const u32x4 pv = *(const u32x4*)(prev + off);
                    a[0] += bflo(pv.x); a[1] += bfhi(pv.x); a[2] += bflo(pv.y); a[3] += bfhi(pv.y); b[0] += bflo(pv.z); b[1] += bfhi(pv.z); b[2] += bflo(pv.w); b[3] += bfhi(pv.w); }
                *(u32x4*)(o + off) = pack8(a, b); } }
    }
};
struct EpiGlu {
    const float* bias; bf16_t* so;
    DI void operator()(const Acc& acc, const Unit& u, int wr, int wc, int fr, int fq) const {
        const int cb = u.pn * 128 + wc * 32 + 8 * fq;
        const f32x4 bv0 = *(const f32x4*)(bias + cb), bv1 = *(const f32x4*)(bias + cb + 4), bg0 = *(const f32x4*)(bias + 512 + cb), bg1 = *(const f32x4*)(bias + 512 + cb + 4);
        EPI_ROWS(ai, m) { const int row = epi_row(u, ai, wr, m, fr); f32x4 a, b;
#pragma unroll
            for (int j = 0; j < 4; ++j) { a[j] = (acc[ai][0][m][0][j] + bv0[j]) * sigm(acc[ai][1][m][0][j] + bg0[j]); b[j] = (acc[ai][0][m][1][j] + bv1[j]) * sigm(acc[ai][1][m][1][j] + bg1[j]); }
            *(u32x4*)(so + (size_t)row * 512 + cb) = pack8(a, b); }
    }
};

struct Args { const void* in[30]; float* out; unsigned char* ws; };
typedef __attribute__((address_space(4))) const char* kseg_t;
DI const void* karg(int idx) { kseg_t kp = (kseg_t)__builtin_amdgcn_kernarg_segment_ptr(); asm volatile("" : "+s"(kp)); return *(const void* const __attribute__((address_space(4)))*)(kp + idx * 8); }
#define INF(i) ((const float*)karg(i))
#define KOUT ((float*)karg(30))
#define KWS ((unsigned char*)karg(31))
enum { I_X = 0, I_POS, I_N1, I_WG1, I_WU1, I_WD1, I_NMIX, I_WIN, I_QN, I_WUQ, I_KVN, I_WUKV, I_WOA, I_LRE, I_LIM, I_LDT, I_BRE, I_BIM, I_CRE, I_CIM, I_DSK, I_WGLU, I_BGLU, I_WOS, I_WOUT, I_N2, I_WG2, I_WU2, I_WD2, I_NF };

template <class F> DI void prep_item(const F& f, int K, int nblk, bf16_t* WT, LAS float* scr, int item, int lane) {
    const int kb = item / nblk, nb = item % nblk, k0 = 64 * kb, n0 = 32 * nb;
#pragma unroll 8
    for (int i = 0; i < 32; ++i) { const int kk = 2 * i + (lane >> 5); scr[kk * 33 + (lane & 31)] = f(k0 + kk, n0 + (lane & 31)); }
    asm volatile("s_waitcnt lgkmcnt(0)" ::: "memory");
    const int c = lane & 7;
#pragma unroll
    for (int j = 0; j < 4; ++j) { const int n = (lane >> 3) + 8 * j; const LAS float* s = scr + (8 * c) * 33 + n;
        u32x4 o; o.x = pk2(s[0 * 33], s[1 * 33]); o.y = pk2(s[2 * 33], s[3 * 33]); o.z = pk2(s[4 * 33], s[5 * 33]); o.w = pk2(s[6 * 33], s[7 * 33]);
        *(u32x4*)(WT + (size_t)(n0 + n) * K + k0 + 8 * c) = o; }
    asm volatile("s_waitcnt lgkmcnt(0)" ::: "memory");
}
struct FGateUp { const float *wg, *wu, *gain; DI float operator()(int k, int n) const { const int col = (n >> 8) * 128 + (n & 127); const long delta = (n & 128) ? ((const char*)wu - (const char*)wg) : 0l; const float* w = (const float*)((const char*)wg + delta); return w[(size_t)k * FF + col] * gain[k]; } };
struct FPlain { const float* w; int N; DI float operator()(int k, int n) const { return w[(size_t)k * N + n]; } };
struct FWin { const float *w, *gain; DI float operator()(int k, int n) const {
    int src;
    if (n < 384) src = n; else if (n < 416) { const int j = n - 384; src = 384 + (j & 1) * 16 + (j >> 1); } else if (n < 512) src = -1; else src = n - 96;
    return src < 0 ? 0.f : w[(size_t)k * 2976 + src] * gain[k]; } };
struct FWuq { const float *w, *gain; DI float operator()(int k, int n) const { const int h = n / 96, d = n % 96; int src = n; if (d >= 64) { const int j = d - 64; src = h * 96 + 64 + (j & 1) * 16 + (j >> 1); } return w[(size_t)k * 768 + src] * gain[k]; } };
struct FWukv { const float *w, *gain; int off; DI float operator()(int k, int n) const { return w[(size_t)k * 1024 + (n >> 6) * 128 + off + (n & 63)] * gain[k]; } };
struct FWglu { const float* w; DI float operator()(int k, int n) const { return w[(size_t)k * 1024 + ((n >> 7) & 1) * 512 + (n >> 8) * 128 + (n & 127)]; } };

DI void lam_pow(float lre, float lim, float dt, float e, float& pr, float& pi) { const float mag = expf(e * lre * dt), ang = e * (lim * dt); pr = mag * cosf(ang); pi = mag * sinf(ang); }
DI void lam_kfac(float lre, float lim, float dt, float& kr, float& ki) { float br, bi; lam_pow(lre, lim, dt, 1.0f, br, bi); const float den = lre * lre + lim * lim, nr = br - 1.0f; kr = (nr * lre + bi * lim) / den; ki = (bi * lre - nr * lim) / den; }

constexpr int KS_STRIDE = 208, VS_STRIDE = 144, KS_BYTES = 64 * KS_STRIDE, VS_BYTES = 64 * VS_STRIDE, ABUF = KS_BYTES + VS_BYTES;
DI void attn_phase(LAS unsigned char* lds, const int wid, const bf16_t* Q, const bf16_t* Kn, const bf16_t* Kr, const bf16_t* Vt, bf16_t* O, int G, int c) {
    const int lane = lane_id(), tid = wid * 64 + lane, r = lane & 31, hh = lane >> 5;
    for (int it = 0;; ++it) {
        const long L = (long)it * G + c; if (L >= 2048) break;
        const int xcd = (int)(L & 7), idx = (int)(L >> 3), bh = (idx >> 5) * 8 + xcd, qb = idx & 31, b = bh >> 3, h = bh & 7;
        const size_t tok0 = (size_t)b * SEQ;
        const int q0 = qb * 256 + wid * 32;
        bf16x8 qf[6];
        { const bf16_t* qp = Q + (tok0 + q0 + r) * 768 + h * 96 + 8 * hh;
#pragma unroll
          for (int s = 0; s < 6; ++s) qf[s] = *(const bf16x8*)(qp + 16 * s); }
        f32x16 o0, o1;
#pragma unroll
        for (int i = 0; i < 16; ++i) { o0[i] = 0.f; o1[i] = 0.f; }
        float mrun = -1e30f, lrun = 0.f;
        const int skey = tid >> 3, sch = tid & 7;
        const int rkey = (tid & 255) >> 2, rch = tid & 3;
        const bf16_t* gkn = Kn + (tok0 + skey) * 512 + h * 64 + sch * 8;
        const bf16_t* gkr = Kr + (tok0 + rkey) * 32 + rch * 8;
        const bf16_t* gvt = Vt + (size_t)(h * 64 + skey) * T + tok0 + sch * 8;
        const unsigned lkn = skey * KS_STRIDE + sch * 16, lkr = rkey * KS_STRIDE + 128 + rch * 16, lvt = KS_BYTES + skey * VS_STRIDE + sch * 16;
        u32x4 rkn = *(const u32x4*)gkn, rvt = *(const u32x4*)gvt, rkr = {0u, 0u, 0u, 0u};
        if (tid < 256) rkr = *(const u32x4*)gkr;
        *(LAS u32x4*)(lds + lkn) = rkn; *(LAS u32x4*)(lds + lvt) = rvt; if (tid < 256) *(LAS u32x4*)(lds + lkr) = rkr;
        __syncthreads();
        for (int kt = 0; kt < SEQ / 64; ++kt) {
            const int cb = (kt & 1) * ABUF, nb = ((kt + 1) & 1) * ABUF;
            if (kt + 1 < SEQ / 64) { const size_t k1 = (size_t)(kt + 1) * 64;
                rkn = *(const u32x4*)(gkn + k1 * 512); rvt = *(const u32x4*)(gvt + k1); if (tid < 256) rkr = *(const u32x4*)(gkr + k1 * 32); }
            f32x16 s0, s1;
#pragma unroll
            for (int i = 0; i < 16; ++i) { s0[i] = 0.f; s1[i] = 0.f; }
            const LAS unsigned char* kp = lds + cb + r * KS_STRIDE + hh * 16;
#pragma unroll
            for (int s = 0; s < 6; ++s) {
                const bf16x8 k0 = *(const LAS bf16x8*)(kp + s * 32), k1 = *(const LAS bf16x8*)(kp + 32 * KS_STRIDE + s * 32);
                s0 = __builtin_amdgcn_mfma_f32_32x32x16_bf16(k0, qf[s], s0, 0, 0, 0);
                s1 = __builtin_amdgcn_mfma_f32_32x32x16_bf16(k1, qf[s], s1, 0, 0, 0); }
            float mx = s0[0];
#pragma unroll
            for (int i = 1; i < 16; ++i) mx = fmaxf(mx, s0[i]);
#pragma unroll
            for (int i = 0; i < 16; ++i) mx = fmaxf(mx, s1[i]);
            mx = fmaxf(mx, __shfl_xor(mx, 32));
            const float mnew = fmaxf(mrun, mx), alpha = exp2f(mrun - mnew);
            mrun = mnew;
            float ps = 0.f;
#pragma unroll
            for (int i = 0; i < 16; ++i) { s0[i] = exp2f(s0[i] - mnew); s1[i] = exp2f(s1[i] - mnew); ps += s0[i] + s1[i]; }
            lrun = lrun * alpha + ps;
#pragma unroll
            for (int i = 0; i < 16; ++i) { o0[i] *= alpha; o1[i] *= alpha; }
            const LAS unsigned char* vp = lds + cb + KS_BYTES + r * VS_STRIDE + hh * 8;
#pragma unroll
            for (int s2 = 0; s2 < 4; ++s2) {
                u32x4 pw;
                if (s2 < 2) { const int e = 8 * (s2 & 1); pw.x = pk2(s0[e], s0[e + 1]); pw.y = pk2(s0[e + 2], s0[e + 3]); pw.z = pk2(s0[e + 4], s0[e + 5]); pw.w = pk2(s0[e + 6], s0[e + 7]); }
                else { const int e = 8 * (s2 & 1); pw.x = pk2(s1[e], s1[e + 1]); pw.y = pk2(s1[e + 2], s1[e + 3]); pw.z = pk2(s1[e + 4], s1[e + 5]); pw.w = pk2(s1[e + 6], s1[e + 7]); }
                const bf16x8 pf = __builtin_bit_cast(bf16x8, pw);
                const int ko = (32 * (s2 >> 1) + 16 * (s2 & 1)) * 2;
                u32x4 va, vb;
                { const u32x2 a0 = *(const LAS u32x2*)(vp + ko), a1 = *(const LAS u32x2*)(vp + ko + 16); va.x = a0.x; va.y = a0.y; va.z = a1.x; va.w = a1.y; }
                { const u32x2 a0 = *(const LAS u32x2*)(vp + 32 * VS_STRIDE + ko), a1 = *(const LAS u32x2*)(vp + 32 * VS_STRIDE + ko + 16); vb.x = a0.x; vb.y = a0.y; vb.z = a1.x; vb.w = a1.y; }
                o0 = __builtin_amdgcn_mfma_f32_32x32x16_bf16(__builtin_bit_cast(bf16x8, va), pf, o0, 0, 0, 0);
                o1 = __builtin_amdgcn_mfma_f32_32x32x16_bf16(__builtin_bit_cast(bf16x8, vb), pf, o1, 0, 0, 0); }
            if (kt + 1 < SEQ / 64) { *(LAS u32x4*)(lds + nb + lkn) = rkn; *(LAS u32x4*)(lds + nb + lvt) = rvt; if (tid < 256) *(LAS u32x4*)(lds + nb + lkr) = rkr; }
            __syncthreads();
        }
        lrun += __shfl_xor(lrun, 32);
        const float inv = 1.0f / lrun;
        bf16_t* op = O + (tok0 + q0 + r) * 512 + h * 64 + 4 * hh;
#pragma unroll
        for (int gq = 0; gq < 4; ++gq) {
            u32x2 w0, w1;
            w0.x = pk2(o0[4 * gq] * inv, o0[4 * gq + 1] * inv); w0.y = pk2(o0[4 * gq + 2] * inv, o0[4 * gq + 3] * inv);
            w1.x = pk2(o1[4 * gq] * inv, o1[4 * gq + 1] * inv); w1.y = pk2(o1[4 * gq + 2] * inv, o1[4 * gq + 3] * inv);
            *(u32x2*)(op + 8 * gq) = w0; *(u32x2*)(op + 32 + 8 * gq) = w1; }
    }
}


constexpr int LDS_BYTES = 147456;
#define WSB(off) ((bf16_t*)(KWS + (off)))
#define WSF(off) ((float*)(KWS + (off)))
#define SSQ(k) (WSF(O_SSQ) + (size_t)(k) * T)
__global__ void __launch_bounds__(512, 2) fwd_megakernel(Args args_unused) {
    extern __shared__ __attribute__((aligned(16))) unsigned char lds_raw[];
    LAS unsigned char* lds = (LAS unsigned char*)lds_raw;
    cg::grid_group grid = cg::this_grid();
    const int wid_s = __builtin_amdgcn_readfirstlane((int)threadIdx.x >> 6);
#define TID (wid_s * 64 + lane_id())
#define LANE (lane_id())
#define WID (wid_s)
#define GG ((int)gridDim.x)
#define CC ((int)blockIdx.x)
#define GW (CC * 8 + WID)
#define NGW (GG * 8)
#define GT ((long)CC * 512 + TID)
#define NGT ((long)GG * 512)

    {
        { float* z = SSQ(1); for (long i = GT; i < 5L * T; i += NGT) z[i] = 0.f; }
        { const float* x = INF(I_X); bf16_t* hb = WSB(O_HB); float* ssq1 = SSQ(0); const int lane = LANE;
          for (int row = GW; row < T; row += NGW) {
            const f32x4* xr = (const f32x4*)(x + (size_t)row * D) + lane; f32x4 v[4]; float s = 0.f;
#pragma unroll
            for (int j = 0; j < 4; ++j) { v[j] = xr[64 * j]; s += (v[j][0] * v[j][0] + v[j][1] * v[j][1]) + (v[j][2] * v[j][2] + v[j][3] * v[j][3]); }
            s = wave_sum(s); if (lane == 0) ssq1[row] = s;
            u32x2* o8 = (u32x2*)(hb + (size_t)row * D) + lane;
#pragma unroll
            for (int j = 0; j < 4; ++j) { u32x2 w; w.x = pk2(v[j][0], v[j][1]); w.y = pk2(v[j][2], v[j][3]); o8[64 * j] = w; }
          } }
        { const int* pos = (const int*)karg(I_POS); f32x2* rope = (f32x2*)(KWS + O_ROPE);
          for (long i = GT; i < (long)T * 16; i += NGT) { const int t = (int)(i >> 4), fi = (int)(i & 15);
            const float invf = (float)exp2(-(double)fi * 0.83048202372184058696); const float ang = (float)pos[t] * invf;
            rope[i] = (f32x2){cosf(ang), sinf(ang)}; } }
        {
            const int lane = LANE; LAS float* scr = (LAS float*)(lds + WID * 16384);
            constexpr int I_GU = 16 * 176, I_D = 44 * 32, I_IN = 16 * 96, I_UQ = 4 * 24, I_UK = 2 * 16, I_OA = 8 * 32, I_OUT = 16 * 32;
            constexpr int NITEMS = 2 * I_GU + 2 * I_D + I_IN + I_UQ + 2 * I_UK + 3 * I_OA + I_OUT;
            for (int it = GW; it < NITEMS; it += NGW) {
                int r = it;
                if (r < I_GU) { prep_item(FGateUp{INF(I_WG1), INF(I_WU1), INF(I_N1)}, D, 176, WSB(O_WGU1), scr, r, lane); continue; } r -= I_GU;
                if (r < I_GU) { prep_item(FGateUp{INF(I_WG2), INF(I_WU2), INF(I_N2)}, D, 176, WSB(O_WGU2), scr, r, lane); continue; } r -= I_GU;
                if (r < I_D) { prep_item(FPlain{INF(I_WD1), D}, FF, 32, WSB(O_WD1), scr, r, lane); continue; } r -= I_D;
                if (r < I_D) { prep_item(FPlain{INF(I_WD2), D}, FF, 32, WSB(O_WD2), scr, r, lane); continue; } r -= I_D;
                if (r < I_IN) { prep_item(FWin{INF(I_WIN), INF(I_NMIX)}, D, 96, WSB(O_WIN), scr, r, lane); continue; } r -= I_IN;
                if (r < I_UQ) { prep_item(FWuq{INF(I_WUQ), INF(I_QN)}, 256, 24, WSB(O_WUQ), scr, r, lane); continue; } r -= I_UQ;
                if (r < I_UK) { prep_item(FWukv{INF(I_WUKV), INF(I_KVN), 0}, 128, 16, WSB(O_WUK), scr, r, lane); continue; } r -= I_UK;
                if (r < I_UK) { prep_item(FWukv{INF(I_WUKV), INF(I_KVN), 64}, 128, 16, WSB(O_WUV), scr, r, lane); continue; } r -= I_UK;
                if (r < I_OA) { prep_item(FPlain{INF(I_WOA), D}, 512, 32, WSB(O_WOA), scr, r, lane); continue; } r -= I_OA;
                if (r < I_OA) { prep_item(FWglu{INF(I_WGLU)}, 512, 32, WSB(O_WGLU), scr, r, lane); continue; } r -= I_OA;
                if (r < I_OA) { prep_item(FPlain{INF(I_WOS), D}, 512, 32, WSB(O_WOS), scr, r, lane); continue; } r -= I_OA;
                prep_item(FPlain{INF(I_WOUT), D}, D, 32, WSB(O_WOUT), scr, r, lane);
            }
        }
        { const float *ilre = INF(I_LRE), *ilim = INF(I_LIM), *ildt = INF(I_LDT), *ibre = INF(I_BRE), *ibim = INF(I_BIM), *icre = INF(I_CRE), *icim = INF(I_CIM); float* kt = WSF(O_KT);
          for (long it = GT; it < 32768; it += NGT) {
            const int i = (int)it & 15, d = ((int)it >> 4) & 31, dir = ((int)it >> 9) & 1, g = (int)it >> 10, dg = dir * 32 + g;
            const float dt = expf(ildt[dg]); float a16[16];
#pragma unroll
            for (int q = 0; q < 16; ++q) a16[q] = 0.f;
            for (int p = 0; p < 64; ++p) {
                const float lre = ilre[dg * 64 + p], lim = ilim[dg * 64 + p]; float kr_, ki_, pr, pi;
                lam_kfac(lre, lim, dt, kr_, ki_); lam_pow(lre, lim, dt, (float)d, pr, pi);
                const float cr = icre[(dg * 16 + i) * 64 + p], ci = icim[(dg * 16 + i) * 64 + p];
                const float tr = cr * pr - ci * pi, ti = cr * pi + ci * pr, gr = tr * kr_ - ti * ki_, gi = tr * ki_ + ti * kr_;
                const f32x4* br = (const f32x4*)(ibre + (size_t)(dg * 64 + p) * 16); const f32x4* bi = (const f32x4*)(ibim + (size_t)(dg * 64 + p) * 16);
#pragma unroll
                for (int q = 0; q < 4; ++q) { const f32x4 x = br[q], y = bi[q];
#pragma unroll
                    for (int e = 0; e < 4; ++e) a16[4 * q + e] += gr * x[e] - gi * y[e]; }
            }
            f32x4* o = (f32x4*)(kt + ((size_t)(g * 2 + dir) * 32 + d) * 256 + i * 16);
#pragma unroll
            for (int q = 0; q < 4; ++q) o[q] = (f32x4){a16[4 * q], a16[4 * q + 1], a16[4 * q + 2], a16[4 * q + 3]};
          }
          bf16_t* wst = WSB(O_WST);
          for (long it = GT; it < 262144; it += NGT) {
            const int j = (int)it & 31, n = ((int)it >> 5) & 255, g = (int)it >> 13, dir = n >> 7, p = (n & 127) >> 1, ri = n & 1, dg = dir * 32 + g;
            const float dt = expf(ildt[dg]), lre = ilre[dg * 64 + p], lim = ilim[dg * 64 + p]; float kr_, ki_, pr, pi;
            lam_kfac(lre, lim, dt, kr_, ki_); lam_pow(lre, lim, dt, (float)(dir == 0 ? 31 - j : j), pr, pi);
            const float gr = pr * kr_ - pi * ki_, gi = pr * ki_ + pi * kr_;
            const f32x4* br = (const f32x4*)(ibre + (size_t)(dg * 64 + p) * 16); const f32x4* bi = (const f32x4*)(ibim + (size_t)(dg * 64 + p) * 16);
            f32x4 v[4];
#pragma unroll
            for (int q = 0; q < 4; ++q) { const f32x4 x = br[q], y = bi[q]; v[q] = ri ? (gr * y + gi * x) : (gr * x - gi * y); }
            u32x4* o = (u32x4*)(wst + ((size_t)g * 256 + n) * 512 + j * 16);
            o[0] = pack8(v[0], v[1]); o[1] = pack8(v[2], v[3]);
          }
          bf16_t* wss2 = WSB(O_WSS2);
          for (long it = GT; it < 262144; it += NGT) {
            const int pc = (int)it & 7, dir = ((int)it >> 3) & 1, n = ((int)it >> 4) & 511, g = (int)it >> 13, tau = n >> 4, i = n & 15, dg = dir * 32 + g;
            const float dt = expf(ildt[dg]), e = (float)(dir == 0 ? tau + 1 : 32 - tau); float v[16];
#pragma unroll
            for (int q = 0; q < 8; ++q) { const int p = pc * 8 + q; float pr, pi; lam_pow(ilre[dg * 64 + p], ilim[dg * 64 + p], dt, e, pr, pi);
                const float cr = icre[(dg * 16 + i) * 64 + p], ci = icim[(dg * 16 + i) * 64 + p];
                v[2 * q] = cr * pr - ci * pi; v[2 * q + 1] = -(cr * pi + ci * pr); }
            u32x4* o = (u32x4*)(wss2 + ((size_t)g * 512 + n) * KP + 512 + dir * 128 + pc * 16);
            u32x4 w0, w1; w0.x = pk2(v[0], v[1]); w0.y = pk2(v[2], v[3]); w0.z = pk2(v[4], v[5]); w0.w = pk2(v[6], v[7]); w1.x = pk2(v[8], v[9]); w1.y = pk2(v[10], v[11]); w1.z = pk2(v[12], v[13]); w1.w = pk2(v[14], v[15]);
            o[0] = w0; o[1] = w1;
          }
          float* al = WSF(O_AL);
          for (long it = GT; it < 4096; it += NGT) { const int p = (int)it & 63, dir = ((int)it >> 6) & 1, g = (int)it >> 7, dg = dir * 32 + g; float pr, pi;
            lam_pow(ilre[dg * 64 + p], ilim[dg * 64 + p], expf(ildt[dg]), 32.0f, pr, pi); al[it * 2] = pr; al[it * 2 + 1] = pi; }
        }
    }
    grid.sync();

    { const float* kt = WSF(O_KT); const float* dsk = INF(I_DSK); bf16_t* wss2 = WSB(O_WSS2);
      for (long it = GT; it < 524288; it += NGT) {
        const int j = (int)it & 31, n = ((int)it >> 5) & 511, g = (int)it >> 14, tau = n >> 4, i = n & 15;
        f32x4 v[4];
#pragma unroll
        for (int q = 0; q < 4; ++q) v[q] = (f32x4){0.f, 0.f, 0.f, 0.f};
        if (j <= tau) { const f32x4* s = (const f32x4*)(kt + ((size_t)(g * 2 + 0) * 32 + (tau - j)) * 256 + i * 16);
#pragma unroll
            for (int q = 0; q < 4; ++q) v[q] += s[q]; }
        if (j >= tau) { const f32x4* s = (const f32x4*)(kt + ((size_t)(g * 2 + 1) * 32 + (j - tau)) * 256 + i * 16);
#pragma unroll
            for (int q = 0; q < 4; ++q) v[q] += s[q]; }
        if (j == tau) { const float dv = dsk[g * 16 + i];
#pragma unroll
            for (int q = 0; q < 4; ++q)
#pragma unroll
                for (int e = 0; e < 4; ++e) if (4 * q + e == i) v[q][e] += dv; }
        u32x4* o = (u32x4*)(wss2 + ((size_t)g * 512 + n) * KP + j * 16);
        o[0] = pack8(v[0], v[1]); o[1] = pack8(v[2], v[3]);
      } }
    { pg8::Gemm g{WSB(O_HB), WSB(O_WGU1), D, D, D, 0, 0}; pg8::Order S; S.init(T / 256, 22, 1, GG, CC); EpiSwiglu E{SSQ(0), WSB(O_ACT)}; pg8::gemm_phase(lds, wid_s, g, S, E); }
    grid.sync();
    { pg8::Gemm g{WSB(O_ACT), WSB(O_WD1), FF, FF, FF, 0, 0}; pg8::Order S; S.init(T / 256, 4, 1, GG, CC); EpiResid E{INF(I_X), WSF(O_H), 0.5f, WSB(O_HB), SSQ(1)}; pg8::gemm_phase(lds, wid_s, g, S, E); }
    grid.sync();
    { pg8::Gemm g{WSB(O_HB), WSB(O_WIN), D, D, D, 0, 0}; pg8::Order S; S.init(T / 256, 12, 1, GG, CC); EpiWin E{SSQ(0), (const f32x2*)(KWS + O_ROPE), KWS, (bf16_t*)KOUT}; pg8::gemm_phase(lds, wid_s, g, S, E); }
    grid.sync();
    { pg8::Gemm g{WSB(O_CQ), WSB(O_WUQ), 256, 256, 256, 0, 0}; pg8::Order S; S.init(T / 256, 3, 1, GG, CC); EpiQ E{SSQ(2), (const f32x2*)(KWS + O_ROPE), WSB(O_Q)}; pg8::gemm_phase(lds, wid_s, g, S, E); }
    { pg8::Gemm g{WSB(O_CKV), WSB(O_WUK), 128, 128, 128, 0, 0}; pg8::Order S; S.init(T / 256, 2, 1, GG, CC); EpiRowScale E{SSQ(3), 1.0f / 128, WSB(O_KN), 512}; pg8::gemm_phase(lds, wid_s, g, S, E); }
    { pg8::Gemm g{WSB(O_WUV), WSB(O_CKV), 128, 128, 128, 0, 0}; pg8::Order S; S.init(2, T / 256, 1, GG, CC); EpiVt E{SSQ(3), WSB(O_VT)}; pg8::gemm_phase(lds, wid_s, g, S, E); }
    { pg8::Gemm g{WSB(O_APACK), WSB(O_WST), KP, 512, 512, (size_t)MG * KP, (size_t)256 * 512}; pg8::Order S; S.init(MG / 256, 1, 32, GG, CC); EpiSloc E{WSF(O_SLOC)}; pg8::gemm_phase(lds, wid_s, g, S, E); }
    grid.sync();
    { const float* al = WSF(O_AL); const float* sloc = WSF(O_SLOC); bf16_t* apack = WSB(O_APACK); const int G = GG;
      for (int it = WID * G + CC; it < 512; it += 8 * G) {
        const int dir = it & 1, g = (it >> 1) & 31, b = it >> 6, p = LANE;
        const float ar = al[((g * 2 + dir) * 64 + p) * 2], ai_ = al[((g * 2 + dir) * 64 + p) * 2 + 1];
        float hr = 0.f, hi = 0.f;
        for (int c0 = 0; c0 < NCH; c0 += 8) {
            f32x2 s[8];
#pragma unroll
            for (int e = 0; e < 8; ++e) { const int cc = dir ? NCH - 1 - (c0 + e) : c0 + e; s[e] = *(const f32x2*)(sloc + ((size_t)g * MG + b * NCH + cc) * 256 + dir * 128 + 2 * p); }
#pragma unroll
            for (int e = 0; e < 8; ++e) { const int cc = dir ? NCH - 1 - (c0 + e) : c0 + e;
                *(unsigned*)(apack + ((size_t)g * MG + b * NCH + cc) * KP + 512 + dir * 128 + 2 * p) = pk2(hr, hi);
                const float nr = ar * hr - ai_ * hi + s[e][0], ni = ar * hi + ai_ * hr + s[e][1]; hr = nr; hi = ni; }
        }
      } }
    attn_phase(lds, wid_s, WSB(O_Q), WSB(O_KN), WSB(O_KR), WSB(O_VT), WSB(O_ATTN), GG, CC);
    grid.sync();
    { pg8::Gemm g{WSB(O_APACK), WSB(O_WSS2), KP, KP, KP, (size_t)MG * KP, (size_t)512 * KP}; pg8::Order S; S.init(MG / 256, 2, 32, GG, CC); EpiSsmOut E{WSB(O_GY)}; pg8::gemm_phase(lds, wid_s, g, S, E); }
    { pg8::Gemm g{WSB(O_ATTN), WSB(O_WOA), 512, 512, 512, 0, 0}; pg8::Order S; S.init(T / 256, 4, 1, GG, CC); EpiGate<0> E{(const bf16_t*)KOUT, nullptr, WSB(O_MRG)}; pg8::gemm_phase(lds, wid_s, g, S, E); }
    grid.sync();
    { pg8::Gemm g{WSB(O_GY), WSB(O_WGLU), 512, 512, 512, 0, 0}; pg8::Order S; S.init(T / 256, 4, 1, GG, CC); EpiGlu E{INF(I_BGLU), WSB(O_SO)}; pg8::gemm_phase(lds, wid_s, g, S, E); }
    grid.sync();
    { pg8::Gemm g{WSB(O_SO), WSB(O_WOS), 512, 512, 512, 0, 0}; pg8::Order S; S.init(T / 256, 4, 1, GG, CC); EpiGate<1> E{(const bf16_t*)KOUT + (size_t)T * D, WSB(O_MRG), WSB(O_MG)}; pg8::gemm_phase(lds, wid_s, g, S, E); }
    grid.sync();
    { pg8::Gemm g{WSB(O_MG), WSB(O_WOUT), D, D, D, 0, 0}; pg8::Order S; S.init(T / 256, 4, 1, GG, CC); EpiResid E{WSF(O_H), WSF(O_H), 1.0f, WSB(O_HB), SSQ(4)}; pg8::gemm_phase(lds, wid_s, g, S, E); }
    grid.sync();
    { pg8::Gemm g{WSB(O_HB), WSB(O_WGU2), D, D, D, 0, 0}; pg8::Order S; S.init(T / 256, 22, 1, GG, CC); EpiSwiglu E{SSQ(4), WSB(O_ACT)}; pg8::gemm_phase(lds, wid_s, g, S, E); }
    grid.sync();
    { pg8::Gemm g{WSB(O_ACT), WSB(O_WD2), FF, FF, FF, 0, 0}; pg8::Order S; S.init(T / 256, 4, 1, GG, CC); EpiResid E{WSF(O_H), KOUT, 0.5f, nullptr, SSQ(5)}; pg8::gemm_phase(lds, wid_s, g, S, E); }
    grid.sync();
    { const float* ssq4 = SSQ(5); float* out = KOUT; const f32x4* gn = (const f32x4*)INF(I_NF) + LANE; const int lane = LANE;
      for (int row = GW; row < T; row += NGW) {
        const float r = rstd_of(ssq4[row], 1.0f / D);
        f32x4* o = (f32x4*)(out + (size_t)row * D) + lane;
#pragma unroll
        for (int j = 0; j < 4; ++j) o[64 * j] = o[64 * j] * r * gn[64 * j];
      } }
}

extern "C" void kernel_launch(void* const* d_in, const int* in_sizes, int n_in, void* d_out, int out_size, void* d_ws, size_t ws_size, hipStream_t stream) {
    static int grid = 0;
    if (grid == 0) {
        if (n_in != 30 || out_size != T * D || ws_size < O_END) { fprintf(stderr, "kernel_launch: unexpected problem (n_in %d, out %d, ws %zu)\n", n_in, out_size, ws_size); grid = -1; return; }
        int dev = 0, cus = 0, per_cu = 0;
        (void)hipGetDevice(&dev); (void)hipDeviceGetAttribute(&cus, hipDeviceAttributeMultiprocessorCount, dev);
        if (hipFuncSetAttribute((const void*)fwd_megakernel, hipFuncAttributeMaxDynamicSharedMemorySize, LDS_BYTES) != hipSuccess) { fprintf(stderr, "kernel_launch: hipFuncSetAttribute failed\n"); grid = -1; return; }
        if (hipOccupancyMaxActiveBlocksPerMultiprocessor(&per_cu, (const void*)fwd_megakernel, 512, LDS_BYTES) != hipSuccess || per_cu < 1) { fprintf(stderr, "kernel_launch: occupancy query gave %d\n", per_cu); per_cu = 1; }
        (void)hipGetLastError();
        grid = cus * per_cu; if (grid > 256) grid = 256; grid &= ~7; if (grid < 8) grid = 8;
    }
    if (grid < 0) return;
    Args a{};
    for (int i = 0; i < 30; ++i) a.in[i] = d_in[i];
    a.out = (float*)d_out; a.ws = (unsigned char*)d_ws;
    void* kargs[] = {&a};
    hipError_t e = hipLaunchCooperativeKernel((const void*)fwd_megakernel, dim3(grid), dim3(512), kargs, LDS_BYTES, stream);
    if (e != hipSuccess) fprintf(stderr, "cooperative launch failed: %s (grid %d)\n", hipGetErrorString(e), grid);
}
```

```cpp
#include <hip/hip_runtime.h>
#include <hip/hip_cooperative_groups.h>
#include <cstdio>
#include <cstdint>
namespace cg = cooperative_groups;

#define LAS __attribute__((address_space(3)))
#define DI __device__ __forceinline__
typedef unsigned short bf16_t;
typedef short bf16x8 __attribute__((ext_vector_type(8)));
typedef short s16x4 __attribute__((ext_vector_type(4)));
typedef float f32x2 __attribute__((ext_vector_type(2)));
typedef float f32x4 __attribute__((ext_vector_type(4)));
typedef float f32x16 __attribute__((ext_vector_type(16)));
typedef unsigned u32x2 __attribute__((ext_vector_type(2)));
typedef unsigned u32x4 __attribute__((ext_vector_type(4)));
typedef __bf16 bf16x2_t __attribute__((ext_vector_type(2)));

constexpr int NB = 8, SEQ = 8192, T = NB * SEQ, D = 1024, FF = 2816, NH = 8;
constexpr int NIN = 3072;
constexpr int CL = 32, NCH = SEQ / CL;
constexpr int MG = T / CL;
constexpr int KP = 768;
constexpr float EPS = 1e-6f;
constexpr float QSCALE = 0.14724438f;

constexpr size_t MiB = 1u << 20, QM = MiB / 4;
constexpr size_t O_WGU1 = 0, O_WD1 = 11 * MiB, O_WGU2 = O_WD1 + 22 * QM, O_WD2 = O_WGU2 + 11 * MiB, O_WIN = O_WD2 + 22 * QM;
constexpr size_t O_WUQ = O_WIN + 6 * MiB, O_WUK = O_WUQ + 2 * QM, O_WUV = O_WUK + QM, O_WOA = O_WUV + QM, O_WGLU = O_WOA + MiB, O_WOS = O_WGLU + MiB, O_WOUT = O_WOS + MiB;
constexpr size_t O_WST = O_WOUT + 2 * MiB, O_WSS2 = O_WST + 8 * MiB, O_KT = O_WSS2 + 24 * MiB, O_AL = O_KT + 2 * MiB, O_SSQ = O_AL + QM;
constexpr size_t O_ROPE = O_SSQ + 6 * QM, O_HB = O_ROPE + 8 * MiB, O_H = O_HB + 128 * MiB, O_ACT = O_H + 256 * MiB, O_R4 = O_ACT + 352 * MiB;
constexpr size_t O_CQ = O_ACT, O_CKV = O_CQ + 32 * MiB, O_KR = O_CKV + 16 * MiB, O_APACK = O_KR + 4 * MiB, O_Q = O_APACK + 96 * MiB, O_KN = O_Q + 96 * MiB;
constexpr size_t O_MG = O_Q, O_MRG = O_HB;
constexpr size_t O_VT = O_R4, O_SLOC = O_VT + 64 * MiB, O_ATTN = O_SLOC + 64 * MiB, O_END = O_ATTN + 64 * MiB, O_GY = O_VT, O_SO = O_SLOC;
static_assert(O_KN + 64 * MiB <= O_R4, "act overlay");
static_assert(O_END <= 1024 * MiB, "workspace");
static_assert(O_WIN == 33 * MiB && O_ROPE % 256 == 0 && O_HB % 256 == 0, "map");

DI unsigned pk2(float lo, float hi) { f32x2 v = {lo, hi}; bf16x2_t b = __builtin_convertvector(v, bf16x2_t); return __builtin_bit_cast(unsigned, b); }
DI float bflo(unsigned u) { return __builtin_bit_cast(float, u << 16); }
DI float bfhi(unsigned u) { return __builtin_bit_cast(float, u & 0xffff0000u); }
DI float sigm(float x) { return __builtin_amdgcn_rcpf(1.0f + __expf(-x)); }
DI float silu(float x) { return x * sigm(x); }
DI float gelu_tanh(float x) { const float z = 1.5957691216f * (x + 0.044715f * x * x * x); return x * sigm(z); }
DI float wave_sum(float v) {
#pragma unroll
    for (int o = 1; o < 64; o <<= 1) v += __shfl_xor(v, o);
    return v;
}
DI int lane_id() { int l; asm volatile("v_mbcnt_lo_u32_b32 %0, -1, 0\n\tv_mbcnt_hi_u32_b32 %0, -1, %0" : "=v"(l)); return l; }
DI float max3f(float a, float b, float c) { return __builtin_fmaxf(__builtin_fmaxf(a, b), c); }
DI u32x4 pack8(f32x4 a, f32x4 b) { u32x4 w; w.x = pk2(a[0], a[1]); w.y = pk2(a[2], a[3]); w.z = pk2(b[0], b[1]); w.w = pk2(b[2], b[3]); return w; }

namespace pg8 {
constexpr int BM = 256, BK = 64, HALF = 128, HTB = HALF * BK * 2, STAGE_BYTES = 8 * HTB, NXCD = 8, WGM = 8;
DI int lds_byte(int r, int c) { const int st = (r >> 4) * 2 + (c >> 5), rr = r & 15, cc = c & 31, ob = rr * 64 + cc * 2; return st * 1024 + (ob ^ (((ob >> 9) & 1) << 5)); }
DI void stage_rc(int b, int& R, int& C) { const int st = b / 1024, sb = b % 1024, swz = sb ^ (((sb >> 9) & 1) << 5); R = (st >> 1) * 16 + swz / 64; C = (st & 1) * 32 + (swz % 64) / 2; }
DI int perm32(int rho) { const int n = rho >> 4, i = rho & 15; return 8 * (i >> 2) + 4 * n + (i & 3); }

struct Unit { int g, pm, pn; };
struct Gemm { const bf16_t* A; const bf16_t* Bt; int lda, ldb, K; size_t gsA, gsB; };
struct Order {
    int nM, nN, nwg, total, G, c;
    DI void init(int nM_, int nN_, int ngroups, int G_, int c_) { nM = nM_; nN = nN_; nwg = nM * nN; total = nwg * ngroups; G = G_; c = c_; }
    DI bool next(int i, Unit& u) const {
        const long L = (long)i * G + c; if (L >= total) return false;
        u.g = (int)(L / nwg); int wgid = (int)(L % nwg);
        { const int q = nwg / NXCD, r = nwg % NXCD, xcd = wgid % NXCD, off = wgid / NXCD; wgid = (xcd < r ? xcd * (q + 1) : r * (q + 1) + (xcd - r) * q) + off; }
        const int nig = WGM * nN, gid = wgid / nig, fm = gid * WGM, gsz = (nM - fm) < WGM ? (nM - fm) : WGM;
        u.pm = fm + ((wgid % nig) % gsz); u.pn = (wgid % nig) / gsz; return true;
    }
};

template <class Epi>
DI void gemm_phase(LAS unsigned char* lds, const int wid, const Gemm g, const Order& S, const Epi& E) {
    const int lane = lane_id(), tid = wid * 64 + lane, wr = wid >> 2, wc = wid & 3, fr = lane & 15, fq = lane >> 4;
    const int K = g.K, nt = K / BK;
    unsigned voffA[2], voffB[2];
#pragma unroll
    for (int i = 0; i < 2; ++i) { int R, C; stage_rc(tid * 16 + i * 8192, R, C); const int Rb = (R & ~31) + perm32(R & 31);
        voffA[i] = (unsigned)(R * g.lda + C) * 2u; voffB[i] = (unsigned)(Rb * g.ldb + C) * 2u; }
    const size_t kstep = (size_t)(BK * 2);
    const size_t hstepA = (size_t)HALF * g.lda * 2, hstepB = (size_t)HALF * g.ldb * 2;
    const unsigned ldsw = (unsigned)wid * 1024u;
    const int aoff = lds_byte(wr * 64 + fr, fq * 8), boff = lds_byte(wc * 32 + fr, fq * 8);
#define PG8_SA(b, h) (((b) * 2 + (h)) * HTB)
#define PG8_SB(b, h) ((4 + (b) * 2 + (h)) * HTB)
#define PG8_STAGE(bufoff, gbase, voff) do { _Pragma("unroll") for (int _i = 0; _i < 2; ++_i) \
        __builtin_amdgcn_global_load_lds((const unsigned*)((const char*)(gbase) + (voff)[_i]), (LAS unsigned*)(lds + (bufoff) + ldsw + _i * 8192), 16, 0, 0); } while (0)
#define PG8_LDA(dst, b, h) do { _Pragma("unroll") for (int m = 0; m < 4; ++m) _Pragma("unroll") for (int k = 0; k < 2; ++k) dst[m][k] = *(const LAS bf16x8*)(lds + PG8_SA(b, h) + aoff + m * 2048 + k * 1024); } while (0)
#define PG8_LDB(dst, b, h) do { _Pragma("unroll") for (int n = 0; n < 2; ++n) _Pragma("unroll") for (int k = 0; k < 2; ++k) dst[n][k] = *(const LAS bf16x8*)(lds + PG8_SB(b, h) + boff + n * 2048 + k * 1024); } while (0)
#define PG8_MMA(ai, bj, At, Bt) do { __builtin_amdgcn_s_setprio(1); _Pragma("unroll") for (int m = 0; m < 4; ++m) _Pragma("unroll") for (int n = 0; n < 2; ++n) _Pragma("unroll") for (int k = 0; k < 2; ++k) \
        acc[ai][bj][m][n] = __builtin_amdgcn_mfma_f32_16x16x32_bf16(Bt[n][k], At[m][k], acc[ai][bj][m][n], 0, 0, 0); __builtin_amdgcn_s_setprio(0); } while (0)
#define PG8_WAIT_V(n) asm volatile("s_waitcnt vmcnt(" #n ")" ::: "memory")
#define PG8_WAIT_L(n) asm volatile("s_waitcnt lgkmcnt(" #n ")" ::: "memory")
#define PG8_BAR __builtin_amdgcn_s_barrier()
#define PG8_SCHED __builtin_amdgcn_sched_barrier(0)
    Unit cur, nxt; int ui = 0;
    if (!S.next(0, cur)) return;
    f32x4 acc[2][2][4][2];
#pragma unroll
    for (int a = 0; a < 2; ++a)
#pragma unroll
        for (int b = 0; b < 2; ++b)
#pragma unroll
            for (int m = 0; m < 4; ++m)
#pragma unroll
                for (int n = 0; n < 2; ++n) acc[a][b][m][n] = (f32x4){0.f, 0.f, 0.f, 0.f};
    bf16x8 At[4][2], B0[2][2], B1[2][2];
    const char* cA = (const char*)(g.A + (size_t)cur.g * g.gsA + (size_t)cur.pm * BM * g.lda);
    const char* cB = (const char*)(g.Bt + (size_t)cur.g * g.gsB + (size_t)cur.pn * BM * g.ldb);
    PG8_STAGE(PG8_SB(0, 0), cB, voffB); PG8_STAGE(PG8_SB(0, 1), cB + hstepB, voffB); PG8_STAGE(PG8_SA(0, 0), cA, voffA); PG8_STAGE(PG8_SA(0, 1), cA + hstepA, voffA);
    if (wr == 1) PG8_BAR;
    PG8_WAIT_V(2); PG8_BAR;
    PG8_STAGE(PG8_SB(1, 0), cB + kstep, voffB); PG8_STAGE(PG8_SA(1, 0), cA + kstep, voffA); PG8_STAGE(PG8_SB(1, 1), cB + hstepB + kstep, voffB);
    PG8_WAIT_V(6); PG8_BAR;
    for (;;) {
        const bool has_next = S.next(ui + 1, nxt);
        const char* nA = has_next ? (const char*)(g.A + (size_t)nxt.g * g.gsA + (size_t)nxt.pm * BM * g.lda) : cA;
        const char* nB = has_next ? (const char*)(g.Bt + (size_t)nxt.g * g.gsB + (size_t)nxt.pn * BM * g.ldb) : cB;
        for (int t = 0; t < nt; t += 2) {
            const bool last = (t == nt - 2);
            const char* a1 = cA + (size_t)(t + 1) * kstep;
            const char* a2 = last ? nA : cA + (size_t)(t + 2) * kstep; const char* b2 = last ? nB : cB + (size_t)(t + 2) * kstep;
            const char* a3 = a2 + kstep; const char* b3 = b2 + kstep;
            PG8_LDB(B0, 0, 0); PG8_LDB(B1, 0, 1); PG8_SCHED; PG8_LDA(At, 0, 0); PG8_STAGE(PG8_SA(1, 1), a1 + hstepA, voffA);
            PG8_WAIT_V(8); PG8_WAIT_L(0); PG8_BAR; PG8_MMA(0, 0, At, B0); PG8_MMA(0, 1, At, B1); PG8_BAR; PG8_SCHED;
            PG8_LDA(At, 0, 1); PG8_STAGE(PG8_SB(0, 0), b2, voffB); PG8_STAGE(PG8_SB(0, 1), b2 + hstepB, voffB); PG8_STAGE(PG8_SA(0, 0), a2, voffA);
            PG8_WAIT_V(8); PG8_WAIT_L(0); PG8_BAR; PG8_MMA(1, 0, At, B0); PG8_MMA(1, 1, At, B1); PG8_BAR; PG8_SCHED;
            PG8_LDB(B0, 1, 0); PG8_LDB(B1, 1, 1); PG8_SCHED; PG8_LDA(At, 1, 0); PG8_STAGE(PG8_SA(0, 1), a2 + hstepA, voffA);
            PG8_WAIT_V(8); PG8_WAIT_L(0); PG8_BAR; PG8_MMA(0, 0, At, B0); PG8_MMA(0, 1, At, B1); PG8_BAR; PG8_SCHED;
            PG8_LDA(At, 1, 1); PG8_STAGE(PG8_SB(1, 0), b3, voffB); PG8_STAGE(PG8_SB(1, 1), b3 + hstepB, voffB); PG8_STAGE(PG8_SA(1, 0), a3, voffA);
            PG8_WAIT_V(8); PG8_WAIT_L(0); PG8_BAR; PG8_MMA(1, 0, At, B0); PG8_MMA(1, 1, At, B1); PG8_BAR; PG8_SCHED;
        }
        if (wr == 0) PG8_BAR;
        E(acc, cur, wr, wc, fr, fq);
        if (!has_next) break;
#pragma unroll
        for (int a = 0; a < 2; ++a)
#pragma unroll
            for (int b = 0; b < 2; ++b)
#pragma unroll
                for (int m = 0; m < 4; ++m)
#pragma unroll
                    for (int n = 0; n < 2; ++n) acc[a][b][m][n] = (f32x4){0.f, 0.f, 0.f, 0.f};
        cur = nxt; cA = nA; cB = nB; ++ui;
        if (wr == 1) PG8_BAR;
    }
    PG8_WAIT_V(0);
    PG8_BAR;
#undef PG8_SA
#undef PG8_SB
#undef PG8_STAGE
#undef PG8_LDA
#undef PG8_LDB
#undef PG8_MMA
#undef PG8_WAIT_V
#undef PG8_WAIT_L
#undef PG8_BAR
#undef PG8_SCHED
}
}
using pg8::Unit;
typedef f32x4 Acc[2][2][4][2];

#define EPI_ROWS(ai, m) _Pragma("unroll") for (int ai = 0; ai < 2; ++ai) _Pragma("unroll") for (int m = 0; m < 4; ++m)
DI int epi_row(const Unit& u, int ai, int wr, int m, int fr) { return u.pm * 256 + ai * 128 + wr * 64 + m * 16 + fr; }
DI int epi_col(const Unit& u, int bj, int wc, int fq) { return u.pn * 256 + bj * 128 + wc * 32 + 8 * fq; }
DI float rstd_of(float ssq, float invn) { return __builtin_amdgcn_rsqf(ssq * invn + EPS); }

struct EpiSwiglu {
    const float* ssq; bf16_t* act;
    DI void operator()(const Acc& acc, const Unit& u, int wr, int wc, int fr, int fq) const {
        const int cb = u.pn * 128 + wc * 32 + 8 * fq;
        EPI_ROWS(ai, m) { const int row = epi_row(u, ai, wr, m, fr); const float r = rstd_of(ssq[row], 1.0f / D);
            f32x4 v[2];
#pragma unroll
            for (int n = 0; n < 2; ++n)
#pragma unroll
                for (int j = 0; j < 4; ++j) v[n][j] = silu(acc[ai][0][m][n][j] * r) * (acc[ai][1][m][n][j] * r);
            *(u32x4*)(act + (size_t)row * FF + cb) = pack8(v[0], v[1]); }
    }
};
struct EpiResid {
    const float* res; float* out; float alpha; bf16_t* ob; float* ssq;
    DI void operator()(const Acc& acc, const Unit& u, int wr, int wc, int fr, int fq) const {
        EPI_ROWS(ai, m) { const int row = epi_row(u, ai, wr, m, fr); float sq = 0.f;
#pragma unroll
            for (int bj = 0; bj < 2; ++bj) { const size_t off = (size_t)row * D + epi_col(u, bj, wc, fq);
                const f32x4 r0 = *(const f32x4*)(res + off), r1 = *(const f32x4*)(res + off + 4);
                const f32x4 o0 = r0 + alpha * acc[ai][bj][m][0], o1 = r1 + alpha * acc[ai][bj][m][1];
                *(f32x4*)(out + off) = o0; *(f32x4*)(out + off + 4) = o1;
                if (ob) *(u32x4*)(ob + off) = pack8(o0, o1);
                sq += (o0[0] * o0[0] + o0[1] * o0[1]) + (o0[2] * o0[2] + o0[3] * o0[3]) + (o1[0] * o1[0] + o1[1] * o1[1]) + (o1[2] * o1[2] + o1[3] * o1[3]); }
            sq += __shfl_xor(sq, 16); sq += __shfl_xor(sq, 32);
            if (fq == 0) unsafeAtomicAdd(ssq + row, sq); }
    }
};
struct EpiWin {
    float* ssq1; const f32x2* rope; unsigned char* ws; bf16_t* sga;
    DI void operator()(const Acc& acc, const Unit& u, int wr, int wc, int fr, int fq) const {
        const int pn = u.pn;
        const float* ssq2 = ssq1 + T; float* ssqq = ssq1 + 2 * T; float* ssqkv = ssq1 + 3 * T;
        bf16_t* cq = (bf16_t*)(ws + O_CQ); bf16_t* ckv = (bf16_t*)(ws + O_CKV); bf16_t* kr = (bf16_t*)(ws + O_KR); bf16_t* apack = (bf16_t*)(ws + O_APACK); bf16_t* sgs = sga + (size_t)T * D;
        EPI_ROWS(ai, m) { const int row = epi_row(u, ai, wr, m, fr); const float r = rstd_of(ssq2[row], 1.0f / D);
            if (pn == 0) { float sq = 0.f;
#pragma unroll
                for (int bj = 0; bj < 2; ++bj) { const f32x4 a = acc[ai][bj][m][0] * r, b = acc[ai][bj][m][1] * r;
                    *(u32x4*)(cq + (size_t)row * 256 + bj * 128 + wc * 32 + 8 * fq) = pack8(a, b);
                    sq += (a[0] * a[0] + a[1] * a[1]) + (a[2] * a[2] + a[3] * a[3]) + (b[0] * b[0] + b[1] * b[1]) + (b[2] * b[2] + b[3] * b[3]); }
                sq += __shfl_xor(sq, 16); sq += __shfl_xor(sq, 32);
                if (fq == 0) unsafeAtomicAdd(ssqq + row, sq);
            } else if (pn == 1) {
                { const f32x4 a = acc[ai][0][m][0] * r, b = acc[ai][0][m][1] * r;
                  *(u32x4*)(ckv + (size_t)row * 128 + wc * 32 + 8 * fq) = pack8(a, b);
                  float sq = (a[0] * a[0] + a[1] * a[1]) + (a[2] * a[2] + a[3] * a[3]) + (b[0] * b[0] + b[1] * b[1]) + (b[2] * b[2] + b[3] * b[3]);
                  sq += __shfl_xor(sq, 16); sq += __shfl_xor(sq, 32);
                  if (fq == 0) unsafeAtomicAdd(ssqkv + row, sq); }
                if (wc == 0) {
                    const f32x4 a = acc[ai][1][m][0] * r, b = acc[ai][1][m][1] * r;
                    const f32x4 c0 = *(const f32x4*)(rope + (size_t)row * 16 + 4 * fq), c1 = *(const f32x4*)(rope + (size_t)row * 16 + 4 * fq + 2);
                    f32x4 oa, ob;
                    oa[0] = a[0] * c0[0] - a[1] * c0[1]; oa[1] = a[1] * c0[0] + a[0] * c0[1]; oa[2] = a[2] * c0[2] - a[3] * c0[3]; oa[3] = a[3] * c0[2] + a[2] * c0[3];
                    ob[0] = b[0] * c1[0] - b[1] * c1[1]; ob[1] = b[1] * c1[0] + b[0] * c1[1]; ob[2] = b[2] * c1[2] - b[3] * c1[3]; ob[3] = b[3] * c1[2] + b[2] * c1[3];
                    *(u32x4*)(kr + (size_t)row * 32 + 8 * fq) = pack8(oa, ob); }
            } else if (pn < 4) {
#pragma unroll
                for (int bj = 0; bj < 2; ++bj) { const int uc = (pn - 2) * 256 + bj * 128 + wc * 32 + 8 * fq; const int gg = uc >> 4, i0 = uc & 15;
                    *(u32x4*)(apack + ((size_t)gg * MG + (row >> 5)) * KP + (row & 31) * 16 + i0) = pack8(acc[ai][bj][m][0] * r, acc[ai][bj][m][1] * r); }
            } else { bf16_t* dst = pn < 8 ? sga : sgs; const int c0 = ((pn - 4) & 3) * 256;
#pragma unroll
                for (int bj = 0; bj < 2; ++bj) { f32x4 a, b;
#pragma unroll
                    for (int j = 0; j < 4; ++j) { a[j] = sigm(acc[ai][bj][m][0][j] * r); b[j] = sigm(acc[ai][bj][m][1][j] * r); }
                    *(u32x4*)(dst + (size_t)row * D + c0 + bj * 128 + wc * 32 + 8 * fq) = pack8(a, b); }
            } }
    }
};
struct EpiQ {
    const float* ssqq; const f32x2* rope; bf16_t* q;
    DI void operator()(const Acc& acc, const Unit& u, int wr, int wc, int fr, int fq) const {
        EPI_ROWS(ai, m) { const int row = epi_row(u, ai, wr, m, fr); const float r = rstd_of(ssqq[row], 1.0f / 256) * QSCALE;
#pragma unroll
            for (int bj = 0; bj < 2; ++bj) { const int c = epi_col(u, bj, wc, fq); const int d = c % 96;
                f32x4 a = acc[ai][bj][m][0] * r, b = acc[ai][bj][m][1] * r;
                if (d >= 64) { const int i0 = (d - 64) >> 1;
                    const f32x4 c0 = *(const f32x4*)(rope + (size_t)row * 16 + i0), c1 = *(const f32x4*)(rope + (size_t)row * 16 + i0 + 2);
                    f32x4 oa, ob;
                    oa[0] = a[0] * c0[0] - a[1] * c0[1]; oa[1] = a[1] * c0[0] + a[0] * c0[1]; oa[2] = a[2] * c0[2] - a[3] * c0[3]; oa[3] = a[3] * c0[2] + a[2] * c0[3];
                    ob[0] = b[0] * c1[0] - b[1] * c1[1]; ob[1] = b[1] * c1[0] + b[0] * c1[1]; ob[2] = b[2] * c1[2] - b[3] * c1[3]; ob[3] = b[3] * c1[2] + b[2] * c1[3];
                    a = oa; b = ob; }
                *(u32x4*)(q + (size_t)row * 768 + c) = pack8(a, b); } }
    }
};
struct EpiRowScale {
    const float* ssq; float invn; bf16_t* o; int ldo;
    DI void operator()(const Acc& acc, const Unit& u, int wr, int wc, int fr, int fq) const {
        EPI_ROWS(ai, m) { const int row = epi_row(u, ai, wr, m, fr); const float r = rstd_of(ssq[row], invn);
#pragma unroll
            for (int bj = 0; bj < 2; ++bj) *(u32x4*)(o + (size_t)row * ldo + epi_col(u, bj, wc, fq)) = pack8(acc[ai][bj][m][0] * r, acc[ai][bj][m][1] * r); }
    }
};
struct EpiVt {
    const float* ssq; bf16_t* vt;
    DI void operator()(const Acc& acc, const Unit& u, int wr, int wc, int fr, int fq) const {
#pragma unroll
        for (int bj = 0; bj < 2; ++bj) { const int c = epi_col(u, bj, wc, fq);
            const f32x4 s0 = *(const f32x4*)(ssq + c), s1 = *(const f32x4*)(ssq + c + 4); f32x4 r0, r1;
#pragma unroll
            for (int j = 0; j < 4; ++j) { r0[j] = rstd_of(s0[j], 1.0f / 128); r1[j] = rstd_of(s1[j], 1.0f / 128); }
            EPI_ROWS(ai, m) { const int row = epi_row(u, ai, wr, m, fr);
                *(u32x4*)(vt + (size_t)row * T + c) = pack8(acc[ai][bj][m][0] * r0, acc[ai][bj][m][1] * r1); } }
    }
};
struct EpiSloc {
    float* sloc;
    DI void operator()(const Acc& acc, const Unit& u, int wr, int wc, int fr, int fq) const {
        EPI_ROWS(ai, m) { const int row = epi_row(u, ai, wr, m, fr);
#pragma unroll
            for (int bj = 0; bj < 2; ++bj) { float* p = sloc + ((size_t)u.g * MG + row) * 256 + bj * 128 + wc * 32 + 8 * fq;
                *(f32x4*)p = acc[ai][bj][m][0]; *(f32x4*)(p + 4) = acc[ai][bj][m][1]; } }
    }
};
struct EpiSsmOut {
    bf16_t* gy;
    DI void operator()(const Acc& acc, const Unit& u, int wr, int wc, int fr, int fq) const {
        EPI_ROWS(ai, m) { const int row = epi_row(u, ai, wr, m, fr);
#pragma unroll
            for (int bj = 0; bj < 2; ++bj) { const int c = epi_col(u, bj, wc, fq); const int tau = c >> 4, i0 = c & 15; f32x4 a, b;
#pragma unroll
                for (int j = 0; j < 4; ++j) { a[j] = gelu_tanh(acc[ai][bj][m][0][j]); b[j] = gelu_tanh(acc[ai][bj][m][1][j]); }
                *(u32x4*)(gy + ((size_t)row * CL + tau) * 512 + u.g * 16 + i0) = pack8(a, b); } }
    }
};
template <int MODE> struct EpiGate {
    const bf16_t* gate; const bf16_t* prev; bf16_t* o;
    DI void operator()(const Acc& acc, const Unit& u, int wr, int wc, int fr, int fq) const {
        EPI_ROWS(ai, m) { const int row = epi_row(u, ai, wr, m, fr);
#pragma unroll
            for (int bj = 0; bj < 2; ++bj) { const size_t off = (size_t)row * D + epi_col(u, bj, wc, fq);
                const u32x4 gv = *(const u32x4*)(gate + off); f32x4 a, b;
                a[0] = bflo(gv.x) * acc[ai][bj][m][0][0]; a[1] = bfhi(gv.x) * acc[ai][bj][m][0][1]; a[2] = bflo(gv.y) * acc[ai][bj][m][0][2]; a[3] = bfhi(gv.y) * acc[ai][bj][m][0][3];
                b[0] = bflo(gv.z) * acc[ai][bj][m][1][0]; b[1] = bfhi(gv.z) * acc[ai][bj][m][1][1]; b[2] = bflo(gv.w) * acc[ai][bj][m][1][2]; b[3] = bfhi(gv.w) * acc[ai][bj][m][1][3];
                if (MODE == 1) { const u32x4 pv = *(const u32x4*)(prev + off);
                    a[0] += bflo(pv.x); a[1] += bfhi(pv.x); a[2] += bflo(pv.y); a[3] += bfhi(pv.y); b[0] += bflo(pv.z); b[1] += bfhi(pv.z); b[2] += bflo(pv.w); b[3] += bfhi(pv.w); }
                *(u32x4*)(o + off) = pack8(a, b); } }
    }
};
struct EpiGlu {
    const float* bias; bf16_t* so;
    DI void operator()(const Acc& acc, const Unit& u, int wr, int wc, int fr, int fq) const {
        const int cb = u.pn * 128 + wc * 32 + 8 * fq;
        const f32x4 bv0 = *(const f32x4*)(bias + cb), bv1 = *(const f32x4*)(bias + cb + 4), bg0 = *(const f32x4*)(bias + 512 + cb), bg1 = *(const f32x4*)(bias + 512 + cb + 4);
        EPI_ROWS(ai, m) { const int row = epi_row(u, ai, wr, m, fr); f32x4 a, b;
#pragma unroll
            for (int j = 0; j < 4; ++j) { a[j] = (acc[ai][0][m][0][j] + bv0[j]) * sigm(acc[ai][1][m][0][j] + bg0[j]); b[j] = (acc[ai][0][m][1][j] + bv1[j]) * sigm(acc[ai][1][m][1][j] + bg1[j]); }
            *(u32x4*)(so + (size_t)row * 512 + cb) = pack8(a, b); }
    }
};

struct Args { const void* in[30]; float* out; unsigned char* ws; };
typedef __attribute__((address_space(4))) const char* kseg_t;
DI const void* karg(int idx) { kseg_t kp = (kseg_t)__builtin_amdgcn_kernarg_segment_ptr(); asm volatile("" : "+s"(kp)); return *(const void* const __attribute__((address_space(4)))*)(kp + idx * 8); }
#define INF(i) ((const float*)karg(i))
#define KOUT ((float*)karg(30))
#define KWS ((unsigned char*)karg(31))
enum { I_X = 0, I_POS, I_N1, I_WG1, I_WU1, I_WD1, I_NMIX, I_WIN, I_QN, I_WUQ, I_KVN, I_WUKV, I_WOA, I_LRE, I_LIM, I_LDT, I_BRE, I_BIM, I_CRE, I_CIM, I_DSK, I_WGLU, I_BGLU, I_WOS, I_WOUT, I_N2, I_WG2, I_WU2, I_WD2, I_NF };

template <class F> DI void prep_item(const F& f, int K, int nblk, bf16_t* WT, LAS float* scr, int item, int lane) {
    const int kb = item / nblk, nb = item % nblk, k0 = 64 * kb, n0 = 32 * nb;
#pragma unroll 8
    for (int i = 0; i < 32; ++i) { const int kk = 2 * i + (lane >> 5); scr[kk * 33 + (lane & 31)] = f(k0 + kk, n0 + (lane & 31)); }
    asm volatile("s_waitcnt lgkmcnt(0)" ::: "memory");
    const int c = lane & 7;
#pragma unroll
    for (int j = 0; j < 4; ++j) { const int n = (lane >> 3) + 8 * j; const LAS float* s = scr + (8 * c) * 33 + n;
        u32x4 o; o.x = pk2(s[0 * 33], s[1 * 33]); o.y = pk2(s[2 * 33], s[3 * 33]); o.z = pk2(s[4 * 33], s[5 * 33]); o.w = pk2(s[6 * 33], s[7 * 33]);
        *(u32x4*)(WT + (size_t)(n0 + n) * K + k0 + 8 * c) = o; }
    asm volatile("s_waitcnt lgkmcnt(0)" ::: "memory");
}
struct FGateUp { const float *wg, *wu, *gain; DI float operator()(int k, int n) const { const int col = (n >> 8) * 128 + (n & 127); const long delta = (n & 128) ? ((const char*)wu - (const char*)wg) : 0l; const float* w = (const float*)((const char*)wg + delta); return w[(size_t)k * FF + col] * gain[k]; } };
struct FPlain { const float* w; int N; DI float operator()(int k, int n) const { return w[(size_t)k * N + n]; } };
struct FWin { const float *w, *gain; DI float operator()(int k, int n) const {
    int src;
    if (n < 384) src = n; else if (n < 416) { const int j = n - 384; src = 384 + (j & 1) * 16 + (j >> 1); } else if (n < 512) src = -1; else src = n - 96;
    return src < 0 ? 0.f : w[(size_t)k * 2976 + src] * gain[k]; } };
struct FWuq { const float *w, *gain; DI float operator()(int k, int n) const { const int h = n / 96, d = n % 96; int src = n; if (d >= 64) { const int j = d - 64; src = h * 96 + 64 + (j & 1) * 16 + (j >> 1); } return w[(size_t)k * 768 + src] * gain[k]; } };
struct FWukv { const float *w, *gain; int off; DI float operator()(int k, int n) const { return w[(size_t)k * 1024 + (n >> 6) * 128 + off + (n & 63)] * gain[k]; } };
struct FWglu { const float* w; DI float operator()(int k, int n) const { return w[(size_t)k * 1024 + ((n >> 7) & 1) * 512 + (n >> 8) * 128 + (n & 127)]; } };

DI void lam_pow(float lre, float lim, float dt, float e, float& pr, float& pi) { const float mag = expf(e * lre * dt), ang = e * (lim * dt); pr = mag * cosf(ang); pi = mag * sinf(ang); }
DI void lam_kfac(float lre, float lim, float dt, float& kr, float& ki) { float br, bi; lam_pow(lre, lim, dt, 1.0f, br, bi); const float den = lre * lre + lim * lim, nr = br - 1.0f; kr = (nr * lre + bi * lim) / den; ki = (bi * lre - nr * lim) / den; }

constexpr int KS_STRIDE = 208, VS_STRIDE = 144, KS_BYTES = 64 * KS_STRIDE, VS_BYTES = 64 * VS_STRIDE, ABUF = KS_BYTES + VS_BYTES;
DI void attn_phase(LAS unsigned char* lds, const int wid, const bf16_t* Q, const bf16_t* Kn, const bf16_t* Kr, const bf16_t* Vt, bf16_t* O, int G, int c) {
    const int lane = lane_id(), tid = wid * 64 + lane, r = lane & 31, hh = lane >> 5;
    for (int it = 0;; ++it) {
        const long L = (long)it * G + c; if (L >= 2048) break;
        const int xcd = (int)(L & 7), idx = (int)(L >> 3), bh = (idx >> 5) * 8 + xcd, qb = idx & 31, b = bh >> 3, h = bh & 7;
        const size_t tok0 = (size_t)b * SEQ;
        const int q0 = qb * 256 + wid * 32;
        bf16x8 qf[6];
        { const bf16_t* qp = Q + (tok0 + q0 + r) * 768 + h * 96 + 8 * hh;
#pragma unroll
          for (int s = 0; s < 6; ++s) qf[s] = *(const bf16x8*)(qp + 16 * s); }
        f32x16 o0, o1, negm;
#pragma unroll
        for (int i = 0; i < 16; ++i) { o0[i] = 0.f; o1[i] = 0.f; negm[i] = 0.f; }
        float lrun = 0.f;
        const int skey = tid >> 3, sch = tid & 7;
        const int rkey = (tid & 255) >> 2, rch = tid & 3;
        const bf16_t* gkn = Kn + (tok0 + skey) * 512 + h * 64 + sch * 8;
        const bf16_t* gkr = Kr + (tok0 + rkey) * 32 + rch * 8;
        const bf16_t* gvt = Vt + (size_t)(h * 64 + skey) * T + tok0 + sch * 8;
        const unsigned lkn = skey * KS_STRIDE + sch * 16, lkr = rkey * KS_STRIDE + 128 + rch * 16, lvt = KS_BYTES + skey * VS_STRIDE + sch * 16;
        u32x4 rkn = *(const u32x4*)gkn, rvt = *(const u32x4*)gvt, rkr = {0u, 0u, 0u, 0u};
        if (tid < 256) rkr = *(const u32x4*)gkr;
        *(LAS u32x4*)(lds + lkn) = rkn; *(LAS u32x4*)(lds + lvt) = rvt; if (tid < 256) *(LAS u32x4*)(lds + lkr) = rkr;
        __syncthreads();
        for (int kt = 0; kt < SEQ / 64; ++kt) {
            const int cb = (kt & 1) * ABUF, nb = ((kt + 1) & 1) * ABUF;
            if (kt + 1 < SEQ / 64) { const size_t k1 = (size_t)(kt + 1) * 64;
                rkn = *(const u32x4*)(gkn + k1 * 512); rvt = *(const u32x4*)(gvt + k1); if (tid < 256) rkr = *(const u32x4*)(gkr + k1 * 32); }
            f32x16 s0 = negm, s1 = negm;
            const LAS unsigned char* kp = lds + cb + r * KS_STRIDE + hh * 16;
#pragma unroll
            for (int s = 0; s < 6; ++s) {
                const bf16x8 k0 = *(const LAS bf16x8*)(kp + s * 32), k1 = *(const LAS bf16x8*)(kp + 32 * KS_STRIDE + s * 32);
                s0 = __builtin_amdgcn_mfma_f32_32x32x16_bf16(k0, qf[s], s0, 0, 0, 0);
                s1 = __builtin_amdgcn_mfma_f32_32x32x16_bf16(k1, qf[s], s1, 0, 0, 0); }
            float mx = max3f(s0[0], s0[1], s0[2]);
#pragma unroll
            for (int i = 3; i < 15; i += 2) mx = max3f(mx, s0[i], s0[i + 1]);
            mx = max3f(mx, s0[15], s1[0]);
#pragma unroll
            for (int i = 1; i < 15; i += 2) mx = max3f(mx, s1[i], s1[i + 1]);
            mx = fmaxf(mx, s1[15]);
            mx = fmaxf(mx, __shfl_xor(mx, 32));
            const bool up = (kt == 0) | (mx > 6.0f);
            if (__builtin_amdgcn_ballot_w64(up) != 0ull) {
                const float delta = up ? mx : 0.f, alpha = __builtin_amdgcn_exp2f(-delta);
                lrun *= alpha;
#pragma unroll
                for (int i = 0; i < 16; ++i) { negm[i] -= delta; s0[i] -= delta; s1[i] -= delta; o0[i] *= alpha; o1[i] *= alpha; }
            }
            float ps = 0.f;
#pragma unroll
            for (int i = 0; i < 16; ++i) { s0[i] = __builtin_amdgcn_exp2f(s0[i]); s1[i] = __builtin_amdgcn_exp2f(s1[i]); ps += s0[i] + s1[i]; }
            lrun += ps;
            const LAS unsigned char* vp = lds + cb + KS_BYTES + r * VS_STRIDE + hh * 8;
#pragma unroll
            for (int s2 = 0; s2 < 4; ++s2) {
                u32x4 pw;
                if (s2 < 2) { const int e = 8 * (s2 & 1); pw.x = pk2(s0[e], s0[e + 1]); pw.y = pk2(s0[e + 2], s0[e + 3]); pw.z = pk2(s0[e + 4], s0[e + 5]); pw.w = pk2(s0[e + 6], s0[e + 7]); }
                else { const int e = 8 * (s2 & 1); pw.x = pk2(s1[e], s1[e + 1]); pw.y = pk2(s1[e + 2], s1[e + 3]); pw.z = pk2(s1[e + 4], s1[e + 5]); pw.w = pk2(s1[e + 6], s1[e + 7]); }
                const bf16x8 pf = __builtin_bit_cast(bf16x8, pw);
                const int ko = (32 * (s2 >> 1) + 16 * (s2 & 1)) * 2;
                u32x4 va, vb;
                { const u32x2 a0 = *(const LAS u32x2*)(vp + ko), a1 = *(const LAS u32x2*)(vp + ko + 16); va.x = a0.x; va.y = a0.y; va.z = a1.x; va.w = a1.y; }
                { const u32x2 a0 = *(const LAS u32x2*)(vp + 32 * VS_STRIDE + ko), a1 = *(const LAS u32x2*)(vp + 32 * VS_STRIDE + ko + 16); vb.x = a0.x; vb.y = a0.y; vb.z = a1.x; vb.w = a1.y; }
                o0 = __builtin_amdgcn_mfma_f32_32x32x16_bf16(__builtin_bit_cast(bf16x8, va), pf, o0, 0, 0, 0);
                o1 = __builtin_amdgcn_mfma_f32_32x32x16_bf16(__builtin_bit_cast(bf16x8, vb), pf, o1, 0, 0, 0); }
            if (kt + 1 < SEQ / 64) { *(LAS u32x4*)(lds + nb + lkn) = rkn; *(LAS u32x4*)(lds + nb + lvt) = rvt; if (tid < 256) *(LAS u32x4*)(lds + nb + lkr) = rkr; }
            __syncthreads();
        }
        lrun += __shfl_xor(lrun, 32);
        const float inv = 1.0f / lrun;
        bf16_t* op = O + (tok0 + q0 + r) * 512 + h * 64 + 4 * hh;
#pragma unroll
        for (int gq = 0; gq < 4; ++gq) {
            u32x2 w0, w1;
            w0.x = pk2(o0[4 * gq] * inv, o0[4 * gq + 1] * inv); w0.y = pk2(o0[4 * gq + 2] * inv, o0[4 * gq + 3] * inv);
            w1.x = pk2(o1[4 * gq] * inv, o1[4 * gq + 1] * inv); w1.y = pk2(o1[4 * gq + 2] * inv, o1[4 * gq + 3] * inv);
            *(u32x2*)(op + 8 * gq) = w0; *(u32x2*)(op + 32 + 8 * gq) = w1; }
    }
}


constexpr int LDS_BYTES = 147456;
#define WSB(off) ((bf16_t*)(KWS + (off)))
#define WSF(off) ((float*)(KWS + (off)))
#define SSQ(k) (WSF(O_SSQ) + (size_t)(k) * T)
__global__ void __launch_bounds__(512, 2) fwd_megakernel(Args args_unused) {
    extern __shared__ __attribute__((aligned(16))) unsigned char lds_raw[];
    LAS unsigned char* lds = (LAS unsigned char*)lds_raw;
    cg::grid_group grid = cg::this_grid();
    const int wid_s = __builtin_amdgcn_readfirstlane((int)threadIdx.x >> 6);
#define TID (wid_s * 64 + lane_id())
#define LANE (lane_id())
#define WID (wid_s)
#define GG ((int)gridDim.x)
#define CC ((int)blockIdx.x)
#define GW (CC * 8 + WID)
#define NGW (GG * 8)
#define GT ((long)CC * 512 + TID)
#define NGT ((long)GG * 512)

    {
        { float* z = SSQ(1); for (long i = GT; i < 5L * T; i += NGT) z[i] = 0.f; }
        { const float* x = INF(I_X); bf16_t* hb = WSB(O_HB); float* ssq1 = SSQ(0); const int lane = LANE;
          for (int row = GW; row < T; row += NGW) {
            const f32x4* xr = (const f32x4*)(x + (size_t)row * D) + lane; f32x4 v[4]; float s = 0.f;
#pragma unroll
            for (int j = 0; j < 4; ++j) { v[j] = xr[64 * j]; s += (v[j][0] * v[j][0] + v[j][1] * v[j][1]) + (v[j][2] * v[j][2] + v[j][3] * v[j][3]); }
            s = wave_sum(s); if (lane == 0) ssq1[row] = s;
            u32x2* o8 = (u32x2*)(hb + (size_t)row * D) + lane;
#pragma unroll
            for (int j = 0; j < 4; ++j) { u32x2 w; w.x = pk2(v[j][0], v[j][1]); w.y = pk2(v[j][2], v[j][3]); o8[64 * j] = w; }
          } }
        { const int* pos = (const int*)karg(I_POS); f32x2* rope = (f32x2*)(KWS + O_ROPE);
          for (long i = GT; i < (long)T * 16; i += NGT) { const int t = (int)(i >> 4), fi = (int)(i & 15);
            const float invf = (float)exp2(-(double)fi * 0.83048202372184058696); const float ang = (float)pos[t] * invf;
            rope[i] = (f32x2){cosf(ang), sinf(ang)}; } }
        {
            const int lane = LANE; LAS float* scr = (LAS float*)(lds + WID * 16384);
            constexpr int I_GU = 16 * 176, I_D = 44 * 32, I_IN = 16 * 96, I_UQ = 4 * 24, I_UK = 2 * 16, I_OA = 8 * 32, I_OUT = 16 * 32;
            constexpr int NITEMS = 2 * I_GU + 2 * I_D + I_IN + I_UQ + 2 * I_UK + 3 * I_OA + I_OUT;
            for (int it = GW; it < NITEMS; it += NGW) {
                int r = it;
                if (r < I_GU) { prep_item(FGateUp{INF(I_WG1), INF(I_WU1), INF(I_N1)}, D, 176, WSB(O_WGU1), scr, r, lane); continue; } r -= I_GU;
                if (r < I_GU) { prep_item(FGateUp{INF(I_WG2), INF(I_WU2), INF(I_N2)}, D, 176, WSB(O_WGU2), scr, r, lane); continue; } r -= I_GU;
                if (r < I_D) { prep_item(FPlain{INF(I_WD1), D}, FF, 32, WSB(O_WD1), scr, r, lane); continue; } r -= I_D;
                if (r < I_D) { prep_item(FPlain{INF(I_WD2), D}, FF, 32, WSB(O_WD2), scr, r, lane); continue; } r -= I_D;
                if (r < I_IN) { prep_item(FWin{INF(I_WIN), INF(I_NMIX)}, D, 96, WSB(O_WIN), scr, r, lane); continue; } r -= I_IN;
                if (r < I_UQ) { prep_item(FWuq{INF(I_WUQ), INF(I_QN)}, 256, 24, WSB(O_WUQ), scr, r, lane); continue; } r -= I_UQ;
                if (r < I_UK) { prep_item(FWukv{INF(I_WUKV), INF(I_KVN), 0}, 128, 16, WSB(O_WUK), scr, r, lane); continue; } r -= I_UK;
                if (r < I_UK) { prep_item(FWukv{INF(I_WUKV), INF(I_KVN), 64}, 128, 16, WSB(O_WUV), scr, r, lane); continue; } r -= I_UK;
                if (r < I_OA) { prep_item(FPlain{INF(I_WOA), D}, 512, 32, WSB(O_WOA), scr, r, lane); continue; } r -= I_OA;
                if (r < I_OA) { prep_item(FWglu{INF(I_WGLU)}, 512, 32, WSB(O_WGLU), scr, r, lane); continue; } r -= I_OA;
                if (r < I_OA) { prep_item(FPlain{INF(I_WOS), D}, 512, 32, WSB(O_WOS), scr, r, lane); continue; } r -= I_OA;
                prep_item(FPlain{INF(I_WOUT), D}, D, 32, WSB(O_WOUT), scr, r, lane);
            }
        }
        { const float *ilre = INF(I_LRE), *ilim = INF(I_LIM), *ildt = INF(I_LDT), *ibre = INF(I_BRE), *ibim = INF(I_BIM), *icre = INF(I_CRE), *icim = INF(I_CIM); float* kt = WSF(O_KT);
          for (long it = GT; it < 32768; it += NGT) {
            const int i = (int)it & 15, d = ((int)it >> 4) & 31, dir = ((int)it >> 9) & 1, g = (int)it >> 10, dg = dir * 32 + g;
            const float dt = expf(ildt[dg]); float a16[16];
#pragma unroll
            for (int q = 0; q < 16; ++q) a16[q] = 0.f;
            for (int p = 0; p < 64; ++p) {
                const float lre = ilre[dg * 64 + p], lim = ilim[dg * 64 + p]; float kr_, ki_, pr, pi;
                lam_kfac(lre, lim, dt, kr_, ki_); lam_pow(lre, lim, dt, (float)d, pr, pi);
                const float cr = icre[(dg * 16 + i) * 64 + p], ci = icim[(dg * 16 + i) * 64 + p];
                const float tr = cr * pr - ci * pi, ti = cr * pi + ci * pr, gr = tr * kr_ - ti * ki_, gi = tr * ki_ + ti * kr_;
                const f32x4* br = (const f32x4*)(ibre + (size_t)(dg * 64 + p) * 16); const f32x4* bi = (const f32x4*)(ibim + (size_t)(dg * 64 + p) * 16);
#pragma unroll
                for (int q = 0; q < 4; ++q) { const f32x4 x = br[q], y = bi[q];
#pragma unroll
                    for (int e = 0; e < 4; ++e) a16[4 * q + e] += gr * x[e] - gi * y[e]; }
            }
            f32x4* o = (f32x4*)(kt + ((size_t)(g * 2 + dir) * 32 + d) * 256 + i * 16);
#pragma unroll
            for (int q = 0; q < 4; ++q) o[q] = (f32x4){a16[4 * q], a16[4 * q + 1], a16[4 * q + 2], a16[4 * q + 3]};
          }
          bf16_t* wst = WSB(O_WST);
          for (long it = GT; it < 262144; it += NGT) {
            const int j = (int)it & 31, n = ((int)it >> 5) & 255, g = (int)it >> 13, dir = n >> 7, p = (n & 127) >> 1, ri = n & 1, dg = dir * 32 + g;
            const float dt = expf(ildt[dg]), lre = ilre[dg * 64 + p], lim = ilim[dg * 64 + p]; float kr_, ki_, pr, pi;
            lam_kfac(lre, lim, dt, kr_, ki_); lam_pow(lre, lim, dt, (float)(dir == 0 ? 31 - j : j), pr, pi);
            const float gr = pr * kr_ - pi * ki_, gi = pr * ki_ + pi * kr_;
            const f32x4* br = (const f32x4*)(ibre + (size_t)(dg * 64 + p) * 16); const f32x4* bi = (const f32x4*)(ibim + (size_t)(dg * 64 + p) * 16);
            f32x4 v[4];
#pragma unroll
            for (int q = 0; q < 4; ++q) { const f32x4 x = br[q], y = bi[q]; v[q] = ri ? (gr * y + gi * x) : (gr * x - gi * y); }
            u32x4* o = (u32x4*)(wst + ((size_t)g * 256 + n) * 512 + j * 16);
            o[0] = pack8(v[0], v[1]); o[1] = pack8(v[2], v[3]);
          }
          bf16_t* wss2 = WSB(O_WSS2);
          for (long it = GT; it < 262144; it += NGT) {
            const int pc = (int)it & 7, dir = ((int)it >> 3) & 1, n = ((int)it >> 4) & 511, g = (int)it >> 13, tau = n >> 4, i = n & 15, dg = dir * 32 + g;
            const float dt = expf(ildt[dg]), e = (float)(dir == 0 ? tau + 1 : 32 - tau); float v[16];
#pragma unroll
            for (int q = 0; q < 8; ++q) { const int p = pc * 8 + q; float pr, pi; lam_pow(ilre[dg * 64 + p], ilim[dg * 64 + p], dt, e, pr, pi);
                const float cr = icre[(dg * 16 + i) * 64 + p], ci = icim[(dg * 16 + i) * 64 + p];
                v[2 * q] = cr * pr - ci * pi; v[2 * q + 1] = -(cr * pi + ci * pr); }
            u32x4* o = (u32x4*)(wss2 + ((size_t)g * 512 + n) * KP + 512 + dir * 128 + pc * 16);
            u32x4 w0, w1; w0.x = pk2(v[0], v[1]); w0.y = pk2(v[2], v[3]); w0.z = pk2(v[4], v[5]); w0.w = pk2(v[6], v[7]); w1.x = pk2(v[8], v[9]); w1.y = pk2(v[10], v[11]); w1.z = pk2(v[12], v[13]); w1.w = pk2(v[14], v[15]);
            o[0] = w0; o[1] = w1;
          }
          float* al = WSF(O_AL);
          for (long it = GT; it < 4096; it += NGT) { const int p = (int)it & 63, dir = ((int)it >> 6) & 1, g = (int)it >> 7, dg = dir * 32 + g; float pr, pi;
            lam_pow(ilre[dg * 64 + p], ilim[dg * 64 + p], expf(ildt[dg]), 32.0f, pr, pi); al[it * 2] = pr; al[it * 2 + 1] = pi; }
        }
    }
    grid.sync();

    { const float* kt = WSF(O_KT); const float* dsk = INF(I_DSK); bf16_t* wss2 = WSB(O_WSS2);
      for (long it = GT; it < 524288; it += NGT) {
        const int j = (int)it & 31, n = ((int)it >> 5) & 511, g = (int)it >> 14, tau = n >> 4, i = n & 15;
        f32x4 v[4];
#pragma unroll
        for (int q = 0; q < 4; ++q) v[q] = (f32x4){0.f, 0.f, 0.f, 0.f};
        if (j <= tau) { const f32x4* s = (const f32x4*)(kt + ((size_t)(g * 2 + 0) * 32 + (tau - j)) * 256 + i * 16);
#pragma unroll
            for (int q = 0; q < 4; ++q) v[q] += s[q]; }
        if (j >= tau) { const f32x4* s = (const f32x4*)(kt + ((size_t)(g * 2 + 1) * 32 + (j - tau)) * 256 + i * 16);
#pragma unroll
            for (int q = 0; q < 4; ++q) v[q] += s[q]; }
        if (j == tau) { const float dv = dsk[g * 16 + i];
#pragma unroll
            for (int q = 0; q < 4; ++q)
#pragma unroll
                for (int e = 0; e < 4; ++e) if (4 * q + e == i) v[q][e] += dv; }
        u32x4* o = (u32x4*)(wss2 + ((size_t)g * 512 + n) * KP + j * 16);
        o[0] = pack8(v[0], v[1]); o[1] = pack8(v[2], v[3]);
      } }
    { pg8::Gemm g{WSB(O_HB), WSB(O_WGU1), D, D, D, 0, 0}; pg8::Order S; S.init(T / 256, 22, 1, GG, CC); EpiSwiglu E{SSQ(0), WSB(O_ACT)}; pg8::gemm_phase(lds, wid_s, g, S, E); }
    grid.sync();
    { pg8::Gemm g{WSB(O_ACT), WSB(O_WD1), FF, FF, FF, 0, 0}; pg8::Order S; S.init(T / 256, 4, 1, GG, CC); EpiResid E{INF(I_X), WSF(O_H), 0.5f, WSB(O_HB), SSQ(1)}; pg8::gemm_phase(lds, wid_s, g, S, E); }
    grid.sync();
    { pg8::Gemm g{WSB(O_HB), WSB(O_WIN), D, D, D, 0, 0}; pg8::Order S; S.init(T / 256, 12, 1, GG, CC); EpiWin E{SSQ(0), (const f32x2*)(KWS + O_ROPE), KWS, (bf16_t*)KOUT}; pg8::gemm_phase(lds, wid_s, g, S, E); }
    grid.sync();
    { pg8::Gemm g{WSB(O_CQ), WSB(O_WUQ), 256, 256, 256, 0, 0}; pg8::Order S; S.init(T / 256, 3, 1, GG, CC); EpiQ E{SSQ(2), (const f32x2*)(KWS + O_ROPE), WSB(O_Q)}; pg8::gemm_phase(lds, wid_s, g, S, E); }
    { pg8::Gemm g{WSB(O_CKV), WSB(O_WUK), 128, 128, 128, 0, 0}; pg8::Order S; S.init(T / 256, 2, 1, GG, CC); EpiRowScale E{SSQ(3), 1.0f / 128, WSB(O_KN), 512}; pg8::gemm_phase(lds, wid_s, g, S, E); }
    { pg8::Gemm g{WSB(O_WUV), WSB(O_CKV), 128, 128, 128, 0, 0}; pg8::Order S; S.init(2, T / 256, 1, GG, CC); EpiVt E{SSQ(3), WSB(O_VT)}; pg8::gemm_phase(lds, wid_s, g, S, E); }
    { pg8::Gemm g{WSB(O_APACK), WSB(O_WST), KP, 512, 512, (size_t)MG * KP, (size_t)256 * 512}; pg8::Order S; S.init(MG / 256, 1, 32, GG, CC); EpiSloc E{WSF(O_SLOC)}; pg8::gemm_phase(lds, wid_s, g, S, E); }
    grid.sync();
    { const float* al = WSF(O_AL); const float* sloc = WSF(O_SLOC); bf16_t* apack = WSB(O_APACK); const int G = GG;
      for (int it = WID * G + CC; it < 512; it += 8 * G) {
        const int dir = it & 1, g = (it >> 1) & 31, b = it >> 6, p = LANE;
        const float ar = al[((g * 2 + dir) * 64 + p) * 2], ai_ = al[((g * 2 + dir) * 64 + p) * 2 + 1];
        float hr = 0.f, hi = 0.f;
        for (int c0 = 0; c0 < NCH; c0 += 8) {
            f32x2 s[8];
#pragma unroll
            for (int e = 0; e < 8; ++e) { const int cc = dir ? NCH - 1 - (c0 + e) : c0 + e; s[e] = *(const f32x2*)(sloc + ((size_t)g * MG + b * NCH + cc) * 256 + dir * 128 + 2 * p); }
#pragma unroll
            for (int e = 0; e < 8; ++e) { const int cc = dir ? NCH - 1 - (c0 + e) : c0 + e;
                *(unsigned*)(apack + ((size_t)g * MG + b * NCH + cc) * KP + 512 + dir * 128 + 2 * p) = pk2(hr, hi);
                const float nr = ar * hr - ai_ * hi + s[e][0], ni = ar * hi + ai_ * hr + s[e][1]; hr = nr; hi = ni; }
        }
      } }
    attn_phase(lds, wid_s, WSB(O_Q), WSB(O_KN), WSB(O_KR), WSB(O_VT), WSB(O_ATTN), GG, CC);
    grid.sync();
    { pg8::Gemm g{WSB(O_APACK), WSB(O_WSS2), KP, KP, KP, (size_t)MG * KP, (size_t)512 * KP}; pg8::Order S; S.init(MG / 256, 2, 32, GG, CC); EpiSsmOut E{WSB(O_GY)}; pg8::gemm_phase(lds, wid_s, g, S, E); }
    { pg8::Gemm g{WSB(O_ATTN), WSB(O_WOA), 512, 512, 512, 0, 0}; pg8::Order S; S.init(T / 256, 4, 1, GG, CC); EpiGate<0> E{(const bf16_t*)KOUT, nullptr, WSB(O_MRG)}; pg8::gemm_phase(lds, wid_s, g, S, E); }
    grid.sync();
    { pg8::Gemm g{WSB(O_GY), WSB(O_WGLU), 512, 512, 512, 0, 0}; pg8::Order S; S.init(T / 256, 4, 1, GG, CC); EpiGlu E{INF(I_BGLU), WSB(O_SO)}; pg8::gemm_phase(lds, wid_s, g, S, E); }
    grid.sync();
    { pg8::Gemm g{WSB(O_SO), WSB(O_WOS), 512, 512, 512, 0, 0}; pg8::Order S; S.init(T / 256, 4, 1, GG, CC); EpiGate<1> E{(const bf16_t*)KOUT + (size_t)T * D, WSB(O_MRG), WSB(O_MG)}; pg8::gemm_phase(lds, wid_s, g, S, E); }
    grid.sync();
    { pg8::Gemm g{WSB(O_MG), WSB(O_WOUT), D, D, D, 0, 0}; pg8::Order S; S.init(T / 256, 4, 1, GG, CC); EpiResid E{WSF(O_H), WSF(O_H), 1.0f, WSB(O_HB), SSQ(4)}; pg8::gemm_phase(lds, wid_s, g, S, E); }
    grid.sync();
    { pg8::Gemm g{WSB(O_HB), WSB(O_WGU2), D, D, D, 0, 0}; pg8::Order S; S.init(T / 256, 22, 1, GG, CC); EpiSwiglu E{SSQ(4), WSB(O_ACT)}; pg8::gemm_phase(lds, wid_s, g, S, E); }
    grid.sync();
    { pg8::Gemm g{WSB(O_ACT), WSB(O_WD2), FF, FF, FF, 0, 0}; pg8::Order S; S.init(T / 256, 4, 1, GG, CC); EpiResid E{WSF(O_H), KOUT, 0.5f, nullptr, SSQ(5)}; pg8::gemm_phase(lds, wid_s, g, S, E); }
    grid.sync();
    { const float* ssq4 = SSQ(5); float* out = KOUT; const f32x4* gn = (const f32x4*)INF(I_NF) + LANE; const int lane = LANE;
      for (int row = GW; row < T; row += NGW) {
        const float r = rstd_of(ssq4[row], 1.0f / D);
        f32x4* o = (f32x4*)(out + (size_t)row * D) + lane;
#pragma unroll
        for (int j = 0; j < 4; ++j) o[64 * j] = o[64 * j] * r * gn[64 * j];
      } }
}

extern "C" void kernel_launch(void* const* d_in, const int* in_sizes, int n_in, void* d_out, int out_size, void* d_ws, size_t ws_size, hipStream_t stream) {
    static int grid = 0;
    if (grid == 0) {
        if (n_in != 30 || out_size != T * D || ws_size < O_END) { fprintf(stderr, "kernel_launch: unexpected problem (n_in %d, out %d, ws %zu)\n", n_in, out_size, ws_size); grid = -1; return; }
        int dev = 0, cus = 0, per_cu = 0;
        (void)hipGetDevice(&dev); (void)hipDeviceGetAttribute(&cus, hipDeviceAttributeMultiprocessorCount, dev);
        if (hipFuncSetAttribute((const void*)fwd_megakernel, hipFuncAttributeMaxDynamicSharedMemorySize, LDS_BYTES) != hipSuccess) { fprintf(stderr, "kernel_launch: hipFuncSetAttribute failed\n"); grid = -1; return; }
        if (hipOccupancyMaxActiveBlocksPerMultiprocessor(&per_cu, (const void*)fwd_megakernel, 512, LDS_BYTES) != hipSuccess || per_cu < 1) { fprintf(stderr, "kernel_launch: occupancy query gave %d\n", per_cu); per_cu = 1; }
        (void)hipGetLastError();
        grid = cus * per_cu; if (grid > 256) grid = 256; grid &= ~7; if (grid < 8) grid = 8;
    }
    if (grid < 0) return;
    Args a{};
    for (int i = 0; i < 30; ++i) a.in[i] = d_in[i];
    a.out = (float*)d_out; a.ws = (unsigned char*)d_ws;
    void* kargs[] = {&a};
    hipError_t e = hipLaunchCooperativeKernel((const void*)fwd_megakernel, dim3(grid), dim3(512), kargs, LDS_BYTES, stream);
    if (e != hipSuccess) fprintf(stderr, "cooperative launch failed: %s (grid %d)\n", hipGetErrorString(e), grid);
}
```

```cpp
#include <hip/hip_runtime.h>
#include <hip/hip_cooperative_groups.h>
#include <cstdio>
#include <cstdint>
namespace cg = cooperative_groups;

#define LAS __attribute__((address_space(3)))
#define DI __device__ __forceinline__
typedef unsigned short bf16_t;
typedef short bf16x8 __attribute__((ext_vector_type(8)));
typedef short s16x4 __attribute__((ext_vector_type(4)));
typedef float f32x2 __attribute__((ext_vector_type(2)));
typedef float f32x4 __attribute__((ext_vector_type(4)));
typedef float f32x16 __attribute__((ext_vector_type(16)));
typedef unsigned u32x2 __attribute__((ext_vector_type(2)));
typedef unsigned u32x4 __attribute__((ext_vector_type(4)));
typedef __bf16 bf16x2_t __attribute__((ext_vector_type(2)));

constexpr int NB = 8, SEQ = 8192, T = NB * SEQ, D = 1024, FF = 2816, NH = 8;
constexpr int NIN = 3072;
constexpr int CL = 32, NCH = SEQ / CL;
constexpr int MG = T / CL;
constexpr int KP = 768;
constexpr float EPS = 1e-6f;
constexpr float QSCALE = 0.14724438f;

constexpr size_t MiB = 1u << 20, QM = MiB / 4;
constexpr size_t O_WGU1 = 0, O_WD1 = 11 * MiB, O_WGU2 = O_WD1 + 22 * QM, O_WD2 = O_WGU2 + 11 * MiB, O_WIN = O_WD2 + 22 * QM;
constexpr size_t O_WUQ = O_WIN + 6 * MiB, O_WUK = O_WUQ + 2 * QM, O_WUV = O_WUK + QM, O_WOA = O_WUV + QM, O_WGLU = O_WOA + MiB, O_WOS = O_WGLU + MiB, O_WOUT = O_WOS + MiB;
constexpr size_t O_WST = O_WOUT + 2 * MiB, O_WSS2 = O_WST + 8 * MiB, O_KT = O_WSS2 + 24 * MiB, O_AL = O_KT + 2 * MiB, O_SSQ = O_AL + QM;
constexpr size_t O_ROPE = O_SSQ + 6 * QM, O_HB = O_ROPE + 8 * MiB, O_H = O_HB + 128 * MiB, O_ACT = O_H + 256 * MiB, O_R4 = O_ACT + 352 * MiB;
constexpr size_t O_CQ = O_ACT, O_CKV = O_CQ + 32 * MiB, O_KR = O_CKV + 16 * MiB, O_APACK = O_KR + 4 * MiB, O_Q = O_APACK + 96 * MiB, O_KN = O_Q + 96 * MiB;
constexpr size_t O_MG = O_Q, O_MRG = O_HB;
constexpr size_t O_VT = O_R4, O_SLOC = O_VT + 64 * MiB, O_ATTN = O_SLOC + 64 * MiB, O_END = O_ATTN + 64 * MiB, O_GY = O_VT, O_SO = O_SLOC;
static_assert(O_KN + 64 * MiB <= O_R4, "act overlay");
constexpr size_t O_CTL = O_END, CTL_BYTES = 16384, WS_NEED = O_CTL + CTL_BYTES;
static_assert(WS_NEED <= 1024 * MiB, "workspace");
static_assert(O_WIN == 33 * MiB && O_ROPE % 256 == 0 && O_HB % 256 == 0, "map");

DI unsigned pk2(float lo, float hi) { f32x2 v = {lo, hi}; bf16x2_t b = __builtin_convertvector(v, bf16x2_t); return __builtin_bit_cast(unsigned, b); }
DI float bflo(unsigned u) { return __builtin_bit_cast(float, u << 16); }
DI float bfhi(unsigned u) { return __builtin_bit_cast(float, u & 0xffff0000u); }
DI float sigm(float x) { return __builtin_amdgcn_rcpf(1.0f + __expf(-x)); }
DI float silu(float x) { return x * sigm(x); }
DI float gelu_tanh(float x) { const float z = 1.5957691216f * (x + 0.044715f * x * x * x); return x * sigm(z); }
DI float wave_sum(float v) {
#pragma unroll
    for (int o = 1; o < 64; o <<= 1) v += __shfl_xor(v, o);
    return v;
}
DI int lane_id() { int l; asm volatile("v_mbcnt_lo_u32_b32 %0, -1, 0\n\tv_mbcnt_hi_u32_b32 %0, -1, %0" : "=v"(l)); return l; }
DI float max3f(float a, float b, float c) { return __builtin_fmaxf(__builtin_fmaxf(a, b), c); }
DI u32x4 pack8(f32x4 a, f32x4 b) { u32x4 w; w.x = pk2(a[0], a[1]); w.y = pk2(a[2], a[3]); w.z = pk2(b[0], b[1]); w.w = pk2(b[2], b[3]); return w; }

namespace pg8 {
constexpr int BM = 256, BK = 64, HALF = 128, HTB = HALF * BK * 2, STAGE_BYTES = 8 * HTB, NXCD = 8, WGM = 8;
DI int lds_byte(int r, int c) { const int st = (r >> 4) * 2 + (c >> 5), rr = r & 15, cc = c & 31, ob = rr * 64 + cc * 2; return st * 1024 + (ob ^ (((ob >> 9) & 1) << 5)); }
DI void stage_rc(int b, int& R, int& C) { const int st = b / 1024, sb = b % 1024, swz = sb ^ (((sb >> 9) & 1) << 5); R = (st >> 1) * 16 + swz / 64; C = (st & 1) * 32 + (swz % 64) / 2; }
DI int perm32(int rho) { const int n = rho >> 4, i = rho & 15; return 8 * (i >> 2) + 4 * n + (i & 3); }

struct Unit { int g, pm, pn; };
struct Gemm { const bf16_t* A; const bf16_t* Bt; int lda, ldb, K; size_t gsA, gsB; };
struct Order {
    int nM, nN, nwg, total, G, c;
    DI void init(int nM_, int nN_, int ngroups, int G_, int c_) { nM = nM_; nN = nN_; nwg = nM * nN; total = nwg * ngroups; G = G_; c = c_; }
    DI bool next(int i, Unit& u) const {
        const long L = (long)i * G + c; if (L >= total) return false;
        u.g = (int)(L / nwg); int wgid = (int)(L % nwg);
        { const int q = nwg / NXCD, r = nwg % NXCD, xcd = wgid % NXCD, off = wgid / NXCD; wgid = (xcd < r ? xcd * (q + 1) : r * (q + 1) + (xcd - r) * q) + off; }
        const int nig = WGM * nN, gid = wgid / nig, fm = gid * WGM, gsz = (nM - fm) < WGM ? (nM - fm) : WGM;
        u.pm = fm + ((wgid % nig) % gsz); u.pn = (wgid % nig) / gsz; return true;
    }
};

template <class Epi>
DI void gemm_phase(LAS unsigned char* lds, const int wid, const Gemm g, const Order& S, const Epi& E) {
    const int lane = lane_id(), tid = wid * 64 + lane, wr = wid >> 2, wc = wid & 3, fr = lane & 15, fq = lane >> 4;
    const int K = g.K, nt = K / BK;
    unsigned voffA[2], voffB[2];
#pragma unroll
    for (int i = 0; i < 2; ++i) { int R, C; stage_rc(tid * 16 + i * 8192, R, C); const int Rb = (R & ~31) + perm32(R & 31);
        voffA[i] = (unsigned)(R * g.lda + C) * 2u; voffB[i] = (unsigned)(Rb * g.ldb + C) * 2u; }
    const size_t kstep = (size_t)(BK * 2);
    const size_t hstepA = (size_t)HALF * g.lda * 2, hstepB = (size_t)HALF * g.ldb * 2;
    const unsigned ldsw = (unsigned)wid * 1024u;
    const int aoff = lds_byte(wr * 64 + fr, fq * 8), boff = lds_byte(wc * 32 + fr, fq * 8);
#define PG8_SA(b, h) (((b) * 2 + (h)) * HTB)
#define PG8_SB(b, h) ((4 + (b) * 2 + (h)) * HTB)
#define PG8_STAGE(bufoff, gbase, voff) do { _Pragma("unroll") for (int _i = 0; _i < 2; ++_i) \
        __builtin_amdgcn_global_load_lds((const unsigned*)((const char*)(gbase) + (voff)[_i]), (LAS unsigned*)(lds + (bufoff) + ldsw + _i * 8192), 16, 0, 0); } while (0)
#define PG8_LDA(dst, b, h) do { _Pragma("unroll") for (int m = 0; m < 4; ++m) _Pragma("unroll") for (int k = 0; k < 2; ++k) dst[m][k] = *(const LAS bf16x8*)(lds + PG8_SA(b, h) + aoff + m * 2048 + k * 1024); } while (0)
#define PG8_LDB(dst, b, h) do { _Pragma("unroll") for (int n = 0; n < 2; ++n) _Pragma("unroll") for (int k = 0; k < 2; ++k) dst[n][k] = *(const LAS bf16x8*)(lds + PG8_SB(b, h) + boff + n * 2048 + k * 1024); } while (0)
#define PG8_MMA(ai, bj, At, Bt) do { __builtin_amdgcn_s_setprio(1); _Pragma("unroll") for (int m = 0; m < 4; ++m) _Pragma("unroll") for (int n = 0; n < 2; ++n) _Pragma("unroll") for (int k = 0; k < 2; ++k) \
        acc[ai][bj][m][n] = __builtin_amdgcn_mfma_f32_16x16x32_bf16(Bt[n][k], At[m][k], acc[ai][bj][m][n], 0, 0, 0); __builtin_amdgcn_s_setprio(0); } while (0)
#define PG8_WAIT_V(n) asm volatile("s_waitcnt vmcnt(" #n ")" ::: "memory")
#define PG8_WAIT_L(n) asm volatile("s_waitcnt lgkmcnt(" #n ")" ::: "memory")
#define PG8_BAR __builtin_amdgcn_s_barrier()
#define PG8_SCHED __builtin_amdgcn_sched_barrier(0)
    Unit cur, nxt; int ui = 0;
    if (!S.next(0, cur)) return;
    f32x4 acc[2][2][4][2];
#pragma unroll
    for (int a = 0; a < 2; ++a)
#pragma unroll
        for (int b = 0; b < 2; ++b)
#pragma unroll
            for (int m = 0; m < 4; ++m)
#pragma unroll
                for (int n = 0; n < 2; ++n) acc[a][b][m][n] = (f32x4){0.f, 0.f, 0.f, 0.f};
    bf16x8 At[4][2], B0[2][2], B1[2][2];
    const char* cA = (const char*)(g.A + (size_t)cur.g * g.gsA + (size_t)cur.pm * BM * g.lda);
    const char* cB = (const char*)(g.Bt + (size_t)cur.g * g.gsB + (size_t)cur.pn * BM * g.ldb);
    PG8_STAGE(PG8_SB(0, 0), cB, voffB); PG8_STAGE(PG8_SB(0, 1), cB + hstepB, voffB); PG8_STAGE(PG8_SA(0, 0), cA, voffA); PG8_STAGE(PG8_SA(0, 1), cA + hstepA, voffA);
    if (wr == 1) PG8_BAR;
    PG8_WAIT_V(2); PG8_BAR;
    PG8_STAGE(PG8_SB(1, 0), cB + kstep, voffB); PG8_STAGE(PG8_SA(1, 0), cA + kstep, voffA); PG8_STAGE(PG8_SB(1, 1), cB + hstepB + kstep, voffB);
    PG8_WAIT_V(6); PG8_BAR;
    for (;;) {
        const bool has_next = S.next(ui + 1, nxt);
        const char* nA = has_next ? (const char*)(g.A + (size_t)nxt.g * g.gsA + (size_t)nxt.pm * BM * g.lda) : cA;
        const char* nB = has_next ? (const char*)(g.Bt + (size_t)nxt.g * g.gsB + (size_t)nxt.pn * BM * g.ldb) : cB;
        for (int t = 0; t < nt; t += 2) {
            const bool last = (t == nt - 2);
            const char* a1 = cA + (size_t)(t + 1) * kstep;
            const char* a2 = last ? nA : cA + (size_t)(t + 2) * kstep; const char* b2 = last ? nB : cB + (size_t)(t + 2) * kstep;
            const char* a3 = a2 + kstep; const char* b3 = b2 + kstep;
            PG8_LDB(B0, 0, 0); PG8_LDB(B1, 0, 1); PG8_SCHED; PG8_LDA(At, 0, 0); PG8_STAGE(PG8_SA(1, 1), a1 + hstepA, voffA);
            PG8_WAIT_V(8); PG8_WAIT_L(0); PG8_BAR; PG8_MMA(0, 0, At, B0); PG8_MMA(0, 1, At, B1); PG8_BAR; PG8_SCHED;
            PG8_LDA(At, 0, 1); PG8_STAGE(PG8_SB(0, 0), b2, voffB); PG8_STAGE(PG8_SB(0, 1), b2 + hstepB, voffB); PG8_STAGE(PG8_SA(0, 0), a2, voffA);
            PG8_WAIT_V(8); PG8_WAIT_L(0); PG8_BAR; PG8_MMA(1, 0, At, B0); PG8_MMA(1, 1, At, B1); PG8_BAR; PG8_SCHED;
            PG8_LDB(B0, 1, 0); PG8_LDB(B1, 1, 1); PG8_SCHED; PG8_LDA(At, 1, 0); PG8_STAGE(PG8_SA(0, 1), a2 + hstepA, voffA);
            PG8_WAIT_V(8); PG8_WAIT_L(0); PG8_BAR; PG8_MMA(0, 0, At, B0); PG8_MMA(0, 1, At, B1); PG8_BAR; PG8_SCHED;
            PG8_LDA(At, 1, 1); PG8_STAGE(PG8_SB(1, 0), b3, voffB); PG8_STAGE(PG8_SB(1, 1), b3 + hstepB, voffB); PG8_STAGE(PG8_SA(1, 0), a3, voffA);
            PG8_WAIT_V(8); PG8_WAIT_L(0); PG8_BAR; PG8_MMA(1, 0, At, B0); PG8_MMA(1, 1, At, B1); PG8_BAR; PG8_SCHED;
        }
        if (wr == 0) PG8_BAR;
        E(acc, cur, wr, wc, fr, fq);
        if (!has_next) break;
#pragma unroll
        for (int a = 0; a < 2; ++a)
#pragma unroll
            for (int b = 0; b < 2; ++b)
#pragma unroll
                for (int m = 0; m < 4; ++m)
#pragma unroll
                    for (int n = 0; n < 2; ++n) acc[a][b][m][n] = (f32x4){0.f, 0.f, 0.f, 0.f};
        cur = nxt; cA = nA; cB = nB; ++ui;
        if (wr == 1) PG8_BAR;
    }
    PG8_WAIT_V(0);
    PG8_BAR;
#undef PG8_SA
#undef PG8_SB
#undef PG8_STAGE
#undef PG8_LDA
#undef PG8_LDB
#undef PG8_MMA
#undef PG8_WAIT_V
#undef PG8_WAIT_L
#undef PG8_BAR
#undef PG8_SCHED
}
}
using pg8::Unit;
typedef f32x4 Acc[2][2][4][2];

#define EPI_ROWS(ai, m) _Pragma("unroll") for (int ai = 0; ai < 2; ++ai) _Pragma("unroll") for (int m = 0; m < 4; ++m)
DI int epi_row(const Unit& u, int ai, int wr, int m, int fr) { return u.pm * 256 + ai * 128 + wr * 64 + m * 16 + fr; }
DI int epi_col(const Unit& u, int bj, int wc, int fq) { return u.pn * 256 + bj * 128 + wc * 32 + 8 * fq; }
DI float rstd_of(float ssq, float invn) { return __builtin_amdgcn_rsqf(ssq * invn + EPS); }

struct EpiSwiglu {
    const float* ssq; bf16_t* act;
    DI void operator()(const Acc& acc, const Unit& u, int wr, int wc, int fr, int fq) const {
        const int cb = u.pn * 128 + wc * 32 + 8 * fq;
        EPI_ROWS(ai, m) { const int row = epi_row(u, ai, wr, m, fr); const float r = rstd_of(ssq[row], 1.0f / D);
            f32x4 v[2];
#pragma unroll
            for (int n = 0; n < 2; ++n)
#pragma unroll
                for (int j = 0; j < 4; ++j) v[n][j] = silu(acc[ai][0][m][n][j] * r) * (acc[ai][1][m][n][j] * r);
            *(u32x4*)(act + (size_t)row * FF + cb) = pack8(v[0], v[1]); }
    }
};
struct EpiResid {
    const float* res; float* out; float alpha; bf16_t* ob; float* ssq;
    DI void operator()(const Acc& acc, const Unit& u, int wr, int wc, int fr, int fq) const {
        EPI_ROWS(ai, m) { const int row = epi_row(u, ai, wr, m, fr); float sq = 0.f;
#pragma unroll
            for (int bj = 0; bj < 2; ++bj) { const size_t off = (size_t)row * D + epi_col(u, bj, wc, fq);
                const f32x4 r0 = *(const f32x4*)(res + off), r1 = *(const f32x4*)(res + off + 4);
                const f32x4 o0 = r0 + alpha * acc[ai][bj][m][0], o1 = r1 + alpha * acc[ai][bj][m][1];
                *(f32x4*)(out + off) = o0; *(f32x4*)(out + off + 4) = o1;
                if (ob) *(u32x4*)(ob + off) = pack8(o0, o1);
                sq += (o0[0] * o0[0] + o0[1] * o0[1]) + (o0[2] * o0[2] + o0[3] * o0[3]) + (o1[0] * o1[0] + o1[1] * o1[1]) + (o1[2] * o1[2] + o1[3] * o1[3]); }
            sq += __shfl_xor(sq, 16); sq += __shfl_xor(sq, 32);
            if (fq == 0) unsafeAtomicAdd(ssq + row, sq); }
    }
};
struct EpiWin {
    float* ssq1; const f32x2* rope; unsigned char* ws; bf16_t* sga;
    DI void operator()(const Acc& acc, const Unit& u, int wr, int wc, int fr, int fq) const {
        const int pn = u.pn;
        const float* ssq2 = ssq1 + T; float* ssqq = ssq1 + 2 * T; float* ssqkv = ssq1 + 3 * T;
        bf16_t* cq = (bf16_t*)(ws + O_CQ); bf16_t* ckv = (bf16_t*)(ws + O_CKV); bf16_t* kr = (bf16_t*)(ws + O_KR); bf16_t* apack = (bf16_t*)(ws + O_APACK); bf16_t* sgs = sga + (size_t)T * D;
        EPI_ROWS(ai, m) { const int row = epi_row(u, ai, wr, m, fr); const float r = rstd_of(ssq2[row], 1.0f / D);
            if (pn == 0) { float sq = 0.f;
#pragma unroll
                for (int bj = 0; bj < 2; ++bj) { const f32x4 a = acc[ai][bj][m][0] * r, b = acc[ai][bj][m][1] * r;
                    *(u32x4*)(cq + (size_t)row * 256 + bj * 128 + wc * 32 + 8 * fq) = pack8(a, b);
                    sq += (a[0] * a[0] + a[1] * a[1]) + (a[2] * a[2] + a[3] * a[3]) + (b[0] * b[0] + b[1] * b[1]) + (b[2] * b[2] + b[3] * b[3]); }
                sq += __shfl_xor(sq, 16); sq += __shfl_xor(sq, 32);
                if (fq == 0) unsafeAtomicAdd(ssqq + row, sq);
            } else if (pn == 1) {
                { const f32x4 a = acc[ai][0][m][0] * r, b = acc[ai][0][m][1] * r;
                  *(u32x4*)(ckv + (size_t)row * 128 + wc * 32 + 8 * fq) = pack8(a, b);
                  float sq = (a[0] * a[0] + a[1] * a[1]) + (a[2] * a[2] + a[3] * a[3]) + (b[0] * b[0] + b[1] * b[1]) + (b[2] * b[2] + b[3] * b[3]);
                  sq += __shfl_xor(sq, 16); sq += __shfl_xor(sq, 32);
                  if (fq == 0) unsafeAtomicAdd(ssqkv + row, sq); }
                if (wc == 0) {
                    const f32x4 a = acc[ai][1][m][0] * r, b = acc[ai][1][m][1] * r;
                    const f32x4 c0 = *(const f32x4*)(rope + (size_t)row * 16 + 4 * fq), c1 = *(const f32x4*)(rope + (size_t)row * 16 + 4 * fq + 2);
                    f32x4 oa, ob;
                    oa[0] = a[0] * c0[0] - a[1] * c0[1]; oa[1] = a[1] * c0[0] + a[0] * c0[1]; oa[2] = a[2] * c0[2] - a[3] * c0[3]; oa[3] = a[3] * c0[2] + a[2] * c0[3];
                    ob[0] = b[0] * c1[0] - b[1] * c1[1]; ob[1] = b[1] * c1[0] + b[0] * c1[1]; ob[2] = b[2] * c1[2] - b[3] * c1[3]; ob[3] = b[3] * c1[2] + b[2] * c1[3];
                    *(u32x4*)(kr + (size_t)row * 32 + 8 * fq) = pack8(oa, ob); }
            } else if (pn < 4) {
#pragma unroll
                for (int bj = 0; bj < 2; ++bj) { const int uc = (pn - 2) * 256 + bj * 128 + wc * 32 + 8 * fq; const int gg = uc >> 4, i0 = uc & 15;
                    *(u32x4*)(apack + ((size_t)gg * MG + (row >> 5)) * KP + (row & 31) * 16 + i0) = pack8(acc[ai][bj][m][0] * r, acc[ai][bj][m][1] * r); }
            } else { bf16_t* dst = pn < 8 ? sga : sgs; const int c0 = ((pn - 4) & 3) * 256;
#pragma unroll
                for (int bj = 0; bj < 2; ++bj) { f32x4 a, b;
#pragma unroll
                    for (int j = 0; j < 4; ++j) { a[j] = sigm(acc[ai][bj][m][0][j] * r); b[j] = sigm(acc[ai][bj][m][1][j] * r); }
                    *(u32x4*)(dst + (size_t)row * D + c0 + bj * 128 + wc * 32 + 8 * fq) = pack8(a, b); }
            } }
    }
};
struct EpiQ {
    const float* ssqq; const f32x2* rope; bf16_t* q;
    DI void operator()(const Acc& acc, const Unit& u, int wr, int wc, int fr, int fq) const {
        EPI_ROWS(ai, m) { const int row = epi_row(u, ai, wr, m, fr); const float r = rstd_of(ssqq[row], 1.0f / 256) * QSCALE;
#pragma unroll
            for (int bj = 0; bj < 2; ++bj) { const int c = epi_col(u, bj, wc, fq); const int d = c % 96;
                f32x4 a = acc[ai][bj][m][0] * r, b = acc[ai][bj][m][1] * r;
                if (d >= 64) { const int i0 = (d - 64) >> 1;
                    const f32x4 c0 = *(const f32x4*)(rope + (size_t)row * 16 + i0), c1 = *(const f32x4*)(rope + (size_t)row * 16 + i0 + 2);
                    f32x4 oa, ob;
                    oa[0] = a[0] * c0[0] - a[1] * c0[1]; oa[1] = a[1] * c0[0] + a[0] * c0[1]; oa[2] = a[2] * c0[2] - a[3] * c0[3]; oa[3] = a[3] * c0[2] + a[2] * c0[3];
                    ob[0] = b[0] * c1[0] - b[1] * c1[1]; ob[1] = b[1] * c1[0] + b[0] * c1[1]; ob[2] = b[2] * c1[2] - b[3] * c1[3]; ob[3] = b[3] * c1[2] + b[2] * c1[3];
                    a = oa; b = ob; }
                *(u32x4*)(q + (size_t)row * 768 + c) = pack8(a, b); } }
    }
};
struct EpiRowScale {
    const float* ssq; float invn; bf16_t* o; int ldo;
    DI void operator()(const Acc& acc, const Unit& u, int wr, int wc, int fr, int fq) const {
        EPI_ROWS(ai, m) { const int row = epi_row(u, ai, wr, m, fr); const float r = rstd_of(ssq[row], invn);
#pragma unroll
            for (int bj = 0; bj < 2; ++bj) *(u32x4*)(o + (size_t)row * ldo + epi_col(u, bj, wc, fq)) = pack8(acc[ai][bj][m][0] * r, acc[ai][bj][m][1] * r); }
    }
};
struct EpiVt {
    const float* ssq; bf16_t* vt;
    DI void operator()(const Acc& acc, const Unit& u, int wr, int wc, int fr, int fq) const {
#pragma unroll
        for (int bj = 0; bj < 2; ++bj) { const int c = epi_col(u, bj, wc, fq);
            const f32x4 s0 = *(const f32x4*)(ssq + c), s1 = *(const f32x4*)(ssq + c + 4); f32x4 r0, r1;
#pragma unroll
            for (int j = 0; j < 4; ++j) { r0[j] = rstd_of(s0[j], 1.0f / 128); r1[j] = rstd_of(s1[j], 1.0f / 128); }
            EPI_ROWS(ai, m) { const int row = epi_row(u, ai, wr, m, fr);
                *(u32x4*)(vt + (size_t)row * T + c) = pack8(acc[ai][bj][m][0] * r0, acc[ai][bj][m][1] * r1); } }
    }
};
struct EpiSloc {
    float* sloc;
    DI void operator()(const Acc& acc, const Unit& u, int wr, int wc, int fr, int fq) const {
        EPI_ROWS(ai, m) { const int row = epi_row(u, ai, wr, m, fr);
#pragma unroll
            for (int bj = 0; bj < 2; ++bj) { float* p = sloc + ((size_t)u.g * MG + row) * 256 + bj * 128 + wc * 32 + 8 * fq;
                *(f32x4*)p = acc[ai][bj][m][0]; *(f32x4*)(p + 4) = acc[ai][bj][m][1]; } }
    }
};
struct EpiSsmOut {
    bf16_t* gy;
    DI void operator()(const Acc& acc, const Unit& u, int wr, int wc, int fr, int fq) const {
        EPI_ROWS(ai, m) { const int row = epi_row(u, ai, wr, m, fr);
#pragma unroll
            for (int bj = 0; bj < 2; ++bj) { const int c = epi_col(u, bj, wc, fq); const int tau = c >> 4, i0 = c & 15; f32x4 a, b;
#pragma unroll
                for (int j = 0; j < 4; ++j) { a[j] = gelu_tanh(acc[ai][bj][m][0][j]); b[j] = gelu_tanh(acc[ai][bj][m][1][j]); }
                *(u32x4*)(gy + ((size_t)row * CL + tau) * 512 + u.g * 16 + i0) = pack8(a, b); } }
    }
};
template <int MODE> struct EpiGate {
    const bf16_t* gate; const bf16_t* prev; bf16_t* o;
    DI void operator()(const Acc& acc, const Unit& u, int wr, int wc, int fr, int fq) const {
        EPI_ROWS(ai, m) { const int row = epi_row(u, ai, wr, m, fr);
#pragma unroll
            for (int bj = 0; bj < 2; ++bj) { const size_t off = (size_t)row * D + epi_col(u, bj, wc, fq);
                const u32x4 gv = *(const u32x4*)(gate + off); f32x4 a, b;
                a[0] = bflo(gv.x) * acc[ai][bj][m][0][0]; a[1] = bfhi(gv.x) * acc[ai][bj][m][0][1]; a[2] = bflo(gv.y) * acc[ai][bj][m][0][2]; a[3] = bfhi(gv.y) * acc[ai][bj][m][0][3];
                b[0] = bflo(gv.z) * acc[ai][bj][m][1][0]; b[1] = bfhi(gv.z) * acc[ai][bj][m][1][1]; b[2] = bflo(gv.w) * acc[ai][bj][m][1][2]; b[3] = bfhi(gv.w) * acc[ai][bj][m][1][3];
                if (MODE == 1) { const u32x4 pv = *(const u32x4*)(prev + off);
                    a[0] += bflo(pv.x); a[1] += bfhi(pv.x); a[2] += bflo(pv.y); a[3] += bfhi(pv.y); b[0] += bflo(pv.z); b[1] += bfhi(pv.z); b[2] += bflo(pv.w); b[3] += bfhi(pv.w); }
                *(u32x4*)(o + off) = pack8(a, b); } }
    }
};
struct EpiGlu {
    const float* bias; bf16_t* so;
    DI void operator()(const Acc& acc, const Unit& u, int wr, int wc, int fr, int fq) const {
        const int cb = u.pn * 128 + wc * 32 + 8 * fq;
        const f32x4 bv0 = *(const f32x4*)(bias + cb), bv1 = *(const f32x4*)(bias + cb + 4), bg0 = *(const f32x4*)(bias + 512 + cb), bg1 = *(const f32x4*)(bias + 512 + cb + 4);
        EPI_ROWS(ai, m) { const int row = epi_row(u, ai, wr, m, fr); f32x4 a, b;
#pragma unroll
            for (int j = 0; j < 4; ++j) { a[j] = (acc[ai][0][m][0][j] + bv0[j]) * sigm(acc[ai][1][m][0][j] + bg0[j]); b[j] = (acc[ai][0][m][1][j] + bv1[j]) * sigm(acc[ai][1][m][1][j] + bg1[j]); }
            *(u32x4*)(so + (size_t)row * 512 + cb) = pack8(a, b); }
    }
};

struct Args { const void* in[30]; float* out; unsigned char* ws; };
typedef __attribute__((address_space(4))) const char* kseg_t;
DI const void* karg(int idx) { kseg_t kp = (kseg_t)__builtin_amdgcn_kernarg_segment_ptr(); asm volatile("" : "+s"(kp)); return *(const void* const __attribute__((address_space(4)))*)(kp + idx * 8); }
#define INF(i) ((const float*)karg(i))
#define KOUT ((float*)karg(30))
#define KWS ((unsigned char*)karg(31))
enum { I_X = 0, I_POS, I_N1, I_WG1, I_WU1, I_WD1, I_NMIX, I_WIN, I_QN, I_WUQ, I_KVN, I_WUKV, I_WOA, I_LRE, I_LIM, I_LDT, I_BRE, I_BIM, I_CRE, I_CIM, I_DSK, I_WGLU, I_BGLU, I_WOS, I_WOUT, I_N2, I_WG2, I_WU2, I_WD2, I_NF };

template <class F> DI void prep_item(const F& f, int K, int nblk, bf16_t* WT, LAS float* scr, int item, int lane) {
    const int kb = item / nblk, nb = item % nblk, k0 = 64 * kb, n0 = 32 * nb;
#pragma unroll 8
    for (int i = 0; i < 32; ++i) { const int kk = 2 * i + (lane >> 5); scr[kk * 33 + (lane & 31)] = f(k0 + kk, n0 + (lane & 31)); }
    asm volatile("s_waitcnt lgkmcnt(0)" ::: "memory");
    const int c = lane & 7;
#pragma unroll
    for (int j = 0; j < 4; ++j) { const int n = (lane >> 3) + 8 * j; const LAS float* s = scr + (8 * c) * 33 + n;
        u32x4 o; o.x = pk2(s[0 * 33], s[1 * 33]); o.y = pk2(s[2 * 33], s[3 * 33]); o.z = pk2(s[4 * 33], s[5 * 33]); o.w = pk2(s[6 * 33], s[7 * 33]);
        *(u32x4*)(WT + (size_t)(n0 + n) * K + k0 + 8 * c) = o; }
    asm volatile("s_waitcnt lgkmcnt(0)" ::: "memory");
}
struct FGateUp { const float *wg, *wu, *gain; DI float operator()(int k, int n) const { const int col = (n >> 8) * 128 + (n & 127); const long delta = (n & 128) ? ((const char*)wu - (const char*)wg) : 0l; const float* w = (const float*)((const char*)wg + delta); return w[(size_t)k * FF + col] * gain[k]; } };
struct FPlain { const float* w; int N; DI float operator()(int k, int n) const { return w[(size_t)k * N + n]; } };
struct FWin { const float *w, *gain; DI float operator()(int k, int n) const {
    int src;
    if (n < 384) src = n; else if (n < 416) { const int j = n - 384; src = 384 + (j & 1) * 16 + (j >> 1); } else if (n < 512) src = -1; else src = n - 96;
    return src < 0 ? 0.f : w[(size_t)k * 2976 + src] * gain[k]; } };
struct FWuq { const float *w, *gain; DI float operator()(int k, int n) const { const int h = n / 96, d = n % 96; int src = n; if (d >= 64) { const int j = d - 64; src = h * 96 + 64 + (j & 1) * 16 + (j >> 1); } return w[(size_t)k * 768 + src] * gain[k]; } };
struct FWukv { const float *w, *gain; int off; DI float operator()(int k, int n) const { return w[(size_t)k * 1024 + (n >> 6) * 128 + off + (n & 63)] * gain[k]; } };
struct FWglu { const float* w; DI float operator()(int k, int n) const { return w[(size_t)k * 1024 + ((n >> 7) & 1) * 512 + (n >> 8) * 128 + (n & 127)]; } };

DI void lam_pow(float lre, float lim, float dt, float e, float& pr, float& pi) { const float mag = expf(e * lre * dt), ang = e * (lim * dt); pr = mag * cosf(ang); pi = mag * sinf(ang); }
DI void lam_kfac(float lre, float lim, float dt, float& kr, float& ki) { float br, bi; lam_pow(lre, lim, dt, 1.0f, br, bi); const float den = lre * lre + lim * lim, nr = br - 1.0f; kr = (nr * lre + bi * lim) / den; ki = (bi * lre - nr * lim) / den; }

constexpr int KS_STRIDE = 208, VS_STRIDE = 144, KS_BYTES = 64 * KS_STRIDE, VS_BYTES = 64 * VS_STRIDE, VOFF = 2 * KS_BYTES, NKT = SEQ / 64;
#define ATT_STEP(KTX, LKN, LKR, LVT, WKN, WKR, WVT, sc0, sc1, sn0, sn1) do { const int kt_ = (KTX); \
            if ((kt_) + 3 < NKT) { const size_t k3 = (size_t)((kt_) + 3) * 64; LKN = *(const u32x4*)(gkn + k3 * 512); if (tid < 256) LKR = *(const u32x4*)(gkr + k3 * 32); } \
            if ((kt_) + 2 < NKT) LVT = *(const u32x4*)(gvt + (size_t)((kt_) + 2) * 64); \
            bf16x8 kf[12]; \
            { const LAS unsigned char* kp = lds + ((kt_ + 1) & 1) * KS_BYTES + r * KS_STRIDE + hh * 16; \
            _Pragma("unroll") \
              for (int s = 0; s < 6; ++s) { kf[2 * s] = *(const LAS bf16x8*)(kp + s * 32); kf[2 * s + 1] = *(const LAS bf16x8*)(kp + 32 * KS_STRIDE + s * 32); } } \
            __builtin_amdgcn_sched_barrier(0); \
            float mx = max3f(sc0[0], sc0[1], sc0[2]); \
            _Pragma("unroll") \
            for (int i = 3; i < 15; i += 2) mx = max3f(mx, sc0[i], sc0[i + 1]); \
            mx = max3f(mx, sc0[15], sc1[0]); \
            _Pragma("unroll") \
            for (int i = 1; i < 15; i += 2) mx = max3f(mx, sc1[i], sc1[i + 1]); \
            mx = fmaxf(mx, sc1[15]); \
            mx = fmaxf(mx, __shfl_xor(mx, 32)); \
            const bool up = (kt_ == 0) | (mx > 6.0f); \
            if (__builtin_amdgcn_ballot_w64(up) != 0ull) { \
                const float delta = up ? mx : 0.f, alpha = __builtin_amdgcn_exp2f(-delta); \
                lrun *= alpha; \
            _Pragma("unroll") \
                for (int i = 0; i < 16; ++i) { negm[i] -= delta; sc0[i] -= delta; sc1[i] -= delta; o0[i] *= alpha; o1[i] *= alpha; } \
            } \
            sn0 = negm; sn1 = negm; \
            const LAS unsigned char* vp = lds + VOFF + (kt_ & 1) * VS_BYTES + r * VS_STRIDE + hh * 16; \
            u32x4 vf[8]; \
            _Pragma("unroll") \
            for (int s2 = 0; s2 < 4; ++s2) { vf[2 * s2] = *(const LAS u32x4*)(vp + 32 * s2); vf[2 * s2 + 1] = *(const LAS u32x4*)(vp + 32 * VS_STRIDE + 32 * s2); } \
            _Pragma("unroll") \
            for (int s = 0; s < 6; ++s) { \
                sn0 = __builtin_amdgcn_mfma_f32_32x32x16_bf16(kf[2 * s], qf[s], sn0, 0, 0, 0); \
                sn1 = __builtin_amdgcn_mfma_f32_32x32x16_bf16(kf[2 * s + 1], qf[s], sn1, 0, 0, 0); } \
            \
            float ps = 0.f; \
            _Pragma("unroll") \
            for (int i = 0; i < 16; ++i) { sc0[i] = __builtin_amdgcn_exp2f(sc0[i]); sc1[i] = __builtin_amdgcn_exp2f(sc1[i]); ps += sc0[i] + sc1[i]; } \
            lrun += ps; \
            _Pragma("unroll") \
            for (int s2 = 0; s2 < 4; ++s2) { \
                u32x4 pw; \
                if (s2 < 2) { const int e = 8 * (s2 & 1); pw.x = pk2(sc0[e], sc0[e + 1]); pw.y = pk2(sc0[e + 2], sc0[e + 3]); pw.z = pk2(sc0[e + 4], sc0[e + 5]); pw.w = pk2(sc0[e + 6], sc0[e + 7]); } \
                else { const int e = 8 * (s2 & 1); pw.x = pk2(sc1[e], sc1[e + 1]); pw.y = pk2(sc1[e + 2], sc1[e + 3]); pw.z = pk2(sc1[e + 4], sc1[e + 5]); pw.w = pk2(sc1[e + 6], sc1[e + 7]); } \
                const bf16x8 pf = __builtin_bit_cast(bf16x8, pw); \
                o0 = __builtin_amdgcn_mfma_f32_32x32x16_bf16(__builtin_bit_cast(bf16x8, vf[2 * s2]), pf, o0, 0, 0, 0); \
                o1 = __builtin_amdgcn_mfma_f32_32x32x16_bf16(__builtin_bit_cast(bf16x8, vf[2 * s2 + 1]), pf, o1, 0, 0, 0); } \
            if ((kt_) + 2 < NKT) { *(LAS u32x4*)(lds + ((kt_) & 1) * KS_BYTES + lkn) = WKN; if (tid < 256) *(LAS u32x4*)(lds + ((kt_) & 1) * KS_BYTES + lkr) = WKR; } \
            if ((kt_) + 1 < NKT) { *(LAS u32x2*)(lds + (((kt_) + 1) & 1) * VS_BYTES + lvt) = (u32x2){WVT.x, WVT.y}; *(LAS u32x2*)(lds + (((kt_) + 1) & 1) * VS_BYTES + lvt + 16) = (u32x2){WVT.z, WVT.w}; } \
            __syncthreads(); \
            } while (0)
DI void attn_phase(LAS unsigned char* lds, const int wid, const bf16_t* Q, const bf16_t* Kn, const bf16_t* Kr, const bf16_t* Vt, bf16_t* O, int G, int c) {
    const int lane = lane_id(), tid = wid * 64 + lane, r = lane & 31, hh = lane >> 5;
    for (int it = 0;; ++it) {
        const long L = (long)it * G + c; if (L >= 2048) break;
        const int xcd = (int)(L & 7), idx = (int)(L >> 3), bh = (idx >> 5) * 8 + xcd, qb = idx & 31, b = bh >> 3, h = bh & 7;
        const size_t tok0 = (size_t)b * SEQ;
        const int q0 = qb * 256 + wid * 32;
        bf16x8 qf[6];
        { const bf16_t* qp = Q + (tok0 + q0 + r) * 768 + h * 96 + 8 * hh;
#pragma unroll
          for (int s = 0; s < 6; ++s) qf[s] = *(const bf16x8*)(qp + 16 * s); }
        f32x16 o0, o1, negm;
#pragma unroll
        for (int i = 0; i < 16; ++i) { o0[i] = 0.f; o1[i] = 0.f; negm[i] = 0.f; }
        float lrun = 0.f;
        const int skey = tid >> 3, sch = tid & 7;
        const int rkey = (tid & 255) >> 2, rch = tid & 3;
        const bf16_t* gkn = Kn + (tok0 + skey) * 512 + h * 64 + sch * 8;
        const bf16_t* gkr = Kr + (tok0 + rkey) * 32 + rch * 8;
        const bf16_t* gvt = Vt + (size_t)(h * 64 + skey) * T + tok0 + sch * 8;
        const unsigned lkn = skey * KS_STRIDE + sch * 16, lkr = rkey * KS_STRIDE + 128 + rch * 16, lvt = VOFF + skey * VS_STRIDE + (sch >> 1) * 32 + (sch & 1) * 8;
        u32x4 rkn = *(const u32x4*)gkn, rvt = *(const u32x4*)gvt, rkr = {0u, 0u, 0u, 0u};
        if (tid < 256) rkr = *(const u32x4*)gkr;
        *(LAS u32x4*)(lds + lkn) = rkn; *(LAS u32x2*)(lds + lvt) = (u32x2){rvt.x, rvt.y}; *(LAS u32x2*)(lds + lvt + 16) = (u32x2){rvt.z, rvt.w}; if (tid < 256) *(LAS u32x4*)(lds + lkr) = rkr;
        rkn = *(const u32x4*)(gkn + 64 * 512); if (tid < 256) rkr = *(const u32x4*)(gkr + 64 * 32);
        *(LAS u32x4*)(lds + KS_BYTES + lkn) = rkn; if (tid < 256) *(LAS u32x4*)(lds + KS_BYTES + lkr) = rkr;
        __syncthreads();
        f32x16 sc0 = negm, sc1 = negm, sd0, sd1;
        { const LAS unsigned char* kp = lds + r * KS_STRIDE + hh * 16;
#pragma unroll
          for (int s = 0; s < 6; ++s) {
              const bf16x8 k0 = *(const LAS bf16x8*)(kp + s * 32), k1 = *(const LAS bf16x8*)(kp + 32 * KS_STRIDE + s * 32);
              sc0 = __builtin_amdgcn_mfma_f32_32x32x16_bf16(k0, qf[s], sc0, 0, 0, 0);
              sc1 = __builtin_amdgcn_mfma_f32_32x32x16_bf16(k1, qf[s], sc1, 0, 0, 0); } }
        __syncthreads();
        u32x4 akn = *(const u32x4*)(gkn + (size_t)2 * 64 * 512), avt = *(const u32x4*)(gvt + 64), akr = {0u, 0u, 0u, 0u}, bkn, bkr = {0u, 0u, 0u, 0u}, bvt;
        if (tid < 256) akr = *(const u32x4*)(gkr + (size_t)2 * 64 * 32);
        for (int kt = 0; kt < NKT; kt += 2) {
            ATT_STEP(kt, bkn, bkr, bvt, akn, akr, avt, sc0, sc1, sd0, sd1);
            ATT_STEP(kt + 1, akn, akr, avt, bkn, bkr, bvt, sd0, sd1, sc0, sc1);
        }
        lrun += __shfl_xor(lrun, 32);
        const float inv = 1.0f / lrun;
        bf16_t* op = O + (tok0 + q0 + r) * 512 + h * 64 + 4 * hh;
#pragma unroll
        for (int gq = 0; gq < 4; ++gq) {
            u32x2 w0, w1;
            w0.x = pk2(o0[4 * gq] * inv, o0[4 * gq + 1] * inv); w0.y = pk2(o0[4 * gq + 2] * inv, o0[4 * gq + 3] * inv);
            w1.x = pk2(o1[4 * gq] * inv, o1[4 * gq + 1] * inv); w1.y = pk2(o1[4 * gq + 2] * inv, o1[4 * gq + 3] * inv);
            *(u32x2*)(op + 8 * gq) = w0; *(u32x2*)(op + 32 + 8 * gq) = w1; }
    }
}

#define XB_TMO      128
#define XB_XCNT(j)  (256  + 64 * (j))
#define XB_XSUB(j)  (1280 + 64 * (j))
#define XB_XGEN(j)  (2304 + 64 * (j))
#define XB_TOP      3328
#define XB_TOPGEN   3392
#define XCD_BAR_WORDS 3456
#define XB_SPIN_CAP (1u << 18)

__device__ __forceinline__ unsigned xb_ld(unsigned* p)              { return __hip_atomic_load(p, __ATOMIC_RELAXED, __HIP_MEMORY_SCOPE_AGENT); }
__device__ __forceinline__ unsigned xb_add(unsigned* p, unsigned v) { return __hip_atomic_fetch_add(p, v, __ATOMIC_RELAXED, __HIP_MEMORY_SCOPE_AGENT); }
__device__ __forceinline__ unsigned xb_xcc_id() { return (unsigned)__builtin_amdgcn_s_getreg((3 << 11) | 20) & 0xFu; }
#define XB_SPIN(cond, bar) do { unsigned _sp = 0; while (cond) { __builtin_amdgcn_s_sleep(1); \
    if ((++_sp & 255u) == 0u) { if (xb_ld(&(bar)[XB_TMO])) break; if (_sp > XB_SPIN_CAP) { atomicAdd(&(bar)[XB_TMO], 1u); break; } } } } while (0)

struct XcdBarrier {
    unsigned* bar; unsigned x;
    volatile LAS unsigned* st;
};

__device__ __forceinline__ XcdBarrier xcd_barrier_post(unsigned* bar, volatile LAS unsigned* st, const bool t0) {
    XcdBarrier b; b.bar = bar; b.x = xb_xcc_id(); b.st = st;
    if (t0) (void)xb_add(&bar[XB_XCNT(b.x)], 1u);
    return b;
}
__device__ __forceinline__ void xcd_barrier_complete(unsigned* bar, unsigned x, unsigned& nloc, unsigned& nx) {
    const unsigned G = gridDim.x * gridDim.y * gridDim.z;
    unsigned sum, cnt, mine, sp = 0u;
    for (;;) {
        sum = 0u; cnt = 0u; mine = 0u;
#pragma unroll
        for (unsigned j = 0; j < 16; ++j) { const unsigned c = xb_ld(&bar[XB_XCNT(j)]); sum += c; cnt += (c > 0u) ? 1u : 0u; mine = (j == x) ? c : mine; }
        if (sum == G) break;
        __builtin_amdgcn_s_sleep(1);
        if ((++sp & 255u) == 0u) { if (xb_ld(&bar[XB_TMO])) break; if (sp > XB_SPIN_CAP) { atomicAdd(&bar[XB_TMO], 1u); break; } }
    }
    nloc = mine > 0u ? mine : 1u; nx = cnt > 0u ? cnt : 1u;
}

__device__ __forceinline__ void xcd_barrier(const XcdBarrier& b, const bool t0) {
    asm volatile("s_waitcnt vmcnt(0)" ::: "memory");
    __syncthreads();
    if (t0) {
        unsigned* bar = b.bar;
        __builtin_amdgcn_s_waitcnt(0);
        unsigned nloc = b.st[0], nx = b.st[1];
        if (nloc == 0u) { xcd_barrier_complete(bar, b.x, nloc, nx); b.st[0] = nloc; b.st[1] = nx; }
        const unsigned old = xb_add(&bar[XB_XSUB(b.x)], 1u);
        const unsigned gen = old / nloc;
        if (old + 1u == (gen + 1u) * nloc) {
            __builtin_amdgcn_fence(__ATOMIC_RELEASE, "agent");
            asm volatile("s_waitcnt vmcnt(0)" ::: "memory");
            const unsigned og = xb_add(&bar[XB_TOP], 1u);
            const unsigned tg = og / nx;
            if (og + 1u == (tg + 1u) * nx) xb_add(&bar[XB_TOPGEN], 1u);
            else XB_SPIN(xb_ld(&bar[XB_TOPGEN]) == tg, bar);
            __builtin_amdgcn_fence(__ATOMIC_ACQUIRE, "agent");
            xb_add(&bar[XB_XGEN(b.x)], 1u);
            asm volatile("s_waitcnt vmcnt(0)" ::: "memory");
        } else {
            XB_SPIN(xb_ld(&bar[XB_XGEN(b.x)]) == gen, bar);
            __builtin_amdgcn_fence(__ATOMIC_ACQUIRE, "agent");
            asm volatile("s_waitcnt vmcnt(0)" ::: "memory");
        }
    }
    __syncthreads();
}

constexpr int LDS_BYTES = 147456;
#define WSB(off) ((bf16_t*)(KWS + (off)))
#define WSF(off) ((float*)(KWS + (off)))
#define SSQ(k) (WSF(O_SSQ) + (size_t)(k) * T)
__global__ void __launch_bounds__(512, 2) fwd_megakernel(Args args_unused) {
    extern __shared__ __attribute__((aligned(16))) unsigned char lds_raw[];
    LAS unsigned char* lds = (LAS unsigned char*)lds_raw;
    cg::grid_group grid = cg::this_grid();
    const int wid_s = __builtin_amdgcn_readfirstlane((int)threadIdx.x >> 6);
#define BAR_ST ((volatile LAS unsigned*)(lds + 131072 + 64))
#define T0 (wid_s == 0 && lane_id() == 0)
    if (T0) { BAR_ST[0] = 0u; BAR_ST[1] = 0u; }
    __syncthreads();
    (void)xcd_barrier_post((unsigned*)(KWS + O_CTL), BAR_ST, T0);
#define GRID_BAR() do { XcdBarrier b_; b_.bar = (unsigned*)(KWS + O_CTL); b_.x = xb_xcc_id(); b_.st = BAR_ST; xcd_barrier(b_, T0); } while (0)
#define TID (wid_s * 64 + lane_id())
#define LANE (lane_id())
#define WID (wid_s)
#define GG ((int)gridDim.x)
#define CC ((int)blockIdx.x)
#define GW (CC * 8 + WID)
#define NGW (GG * 8)
#define GT ((long)CC * 512 + TID)
#define NGT ((long)GG * 512)

    {
        { float* z = SSQ(1); for (long i = GT; i < 5L * T; i += NGT) z[i] = 0.f; }
        { const float* x = INF(I_X); bf16_t* hb = WSB(O_HB); float* ssq1 = SSQ(0); const int lane = LANE;
          for (int row = GW; row < T; row += NGW) {
            const f32x4* xr = (const f32x4*)(x + (size_t)row * D) + lane; f32x4 v[4]; float s = 0.f;
#pragma unroll
            for (int j = 0; j < 4; ++j) { v[j] = xr[64 * j]; s += (v[j][0] * v[j][0] + v[j][1] * v[j][1]) + (v[j][2] * v[j][2] + v[j][3] * v[j][3]); }
            s = wave_sum(s); if (lane == 0) ssq1[row] = s;
            u32x2* o8 = (u32x2*)(hb + (size_t)row * D) + lane;
#pragma unroll
            for (int j = 0; j < 4; ++j) { u32x2 w; w.x = pk2(v[j][0], v[j][1]); w.y = pk2(v[j][2], v[j][3]); o8[64 * j] = w; }
          } }
        { const int* pos = (const int*)karg(I_POS); f32x2* rope = (f32x2*)(KWS + O_ROPE);
          for (long i = GT; i < (long)T * 16; i += NGT) { const int t = (int)(i >> 4), fi = (int)(i & 15);
            const float invf = (float)exp2(-(double)fi * 0.83048202372184058696); const float ang = (float)pos[t] * invf;
            rope[i] = (f32x2){cosf(ang), sinf(ang)}; } }
        {
            const int lane = LANE; LAS float* scr = (LAS float*)(lds + WID * 16384);
            constexpr int I_GU = 16 * 176, I_D = 44 * 32, I_IN = 16 * 96, I_UQ = 4 * 24, I_UK = 2 * 16, I_OA = 8 * 32, I_OUT = 16 * 32;
            constexpr int NITEMS = 2 * I_GU + 2 * I_D + I_IN + I_UQ + 2 * I_UK + 3 * I_OA + I_OUT;
            for (int it = GW; it < NITEMS; it += NGW) {
                int r = it;
                if (r < I_GU) { prep_item(FGateUp{INF(I_WG1), INF(I_WU1), INF(I_N1)}, D, 176, WSB(O_WGU1), scr, r, lane); continue; } r -= I_GU;
                if (r < I_GU) { prep_item(FGateUp{INF(I_WG2), INF(I_WU2), INF(I_N2)}, D, 176, WSB(O_WGU2), scr, r, lane); continue; } r -= I_GU;
                if (r < I_D) { prep_item(FPlain{INF(I_WD1), D}, FF, 32, WSB(O_WD1), scr, r, lane); continue; } r -= I_D;
                if (r < I_D) { prep_item(FPlain{INF(I_WD2), D}, FF, 32, WSB(O_WD2), scr, r, lane); continue; } r -= I_D;
                if (r < I_IN) { prep_item(FWin{INF(I_WIN), INF(I_NMIX)}, D, 96, WSB(O_WIN), scr, r, lane); continue; } r -= I_IN;
                if (r < I_UQ) { prep_item(FWuq{INF(I_WUQ), INF(I_QN)}, 256, 24, WSB(O_WUQ), scr, r, lane); continue; } r -= I_UQ;
                if (r < I_UK) { prep_item(FWukv{INF(I_WUKV), INF(I_KVN), 0}, 128, 16, WSB(O_WUK), scr, r, lane); continue; } r -= I_UK;
                if (r < I_UK) { prep_item(FWukv{INF(I_WUKV), INF(I_KVN), 64}, 128, 16, WSB(O_WUV), scr, r, lane); continue; } r -= I_UK;
                if (r < I_OA) { prep_item(FPlain{INF(I_WOA), D}, 512, 32, WSB(O_WOA), scr, r, lane); continue; } r -= I_OA;
                if (r < I_OA) { prep_item(FWglu{INF(I_WGLU)}, 512, 32, WSB(O_WGLU), scr, r, lane); continue; } r -= I_OA;
                if (r < I_OA) { prep_item(FPlain{INF(I_WOS), D}, 512, 32, WSB(O_WOS), scr, r, lane); continue; } r -= I_OA;
                prep_item(FPlain{INF(I_WOUT), D}, D, 32, WSB(O_WOUT), scr, r, lane);
            }
        }
        { const float *ilre = INF(I_LRE), *ilim = INF(I_LIM), *ildt = INF(I_LDT), *ibre = INF(I_BRE), *ibim = INF(I_BIM), *icre = INF(I_CRE), *icim = INF(I_CIM); float* kt = WSF(O_KT);
          for (long it = GT; it < 32768; it += NGT) {
            const int i = (int)it & 15, d = ((int)it >> 4) & 31, dir = ((int)it >> 9) & 1, g = (int)it >> 10, dg = dir * 32 + g;
            const float dt = expf(ildt[dg]); float a16[16];
#pragma unroll
            for (int q = 0; q < 16; ++q) a16[q] = 0.f;
            for (int p = 0; p < 64; ++p) {
                const float lre = ilre[dg * 64 + p], lim = ilim[dg * 64 + p]; float kr_, ki_, pr, pi;
                lam_kfac(lre, lim, dt, kr_, ki_); lam_pow(lre, lim, dt, (float)d, pr, pi);
                const float cr = icre[(dg * 16 + i) * 64 + p], ci = icim[(dg * 16 + i) * 64 + p];
                const float tr = cr * pr - ci * pi, ti = cr * pi + ci * pr, gr = tr * kr_ - ti * ki_, gi = tr * ki_ + ti * kr_;
                const f32x4* br = (const f32x4*)(ibre + (size_t)(dg * 64 + p) * 16); const f32x4* bi = (const f32x4*)(ibim + (size_t)(dg * 64 + p) * 16);
#pragma unroll
                for (int q = 0; q < 4; ++q) { const f32x4 x = br[q], y = bi[q];
#pragma unroll
                    for (int e = 0; e < 4; ++e) a16[4 * q + e] += gr * x[e] - gi * y[e]; }
            }
            f32x4* o = (f32x4*)(kt + ((size_t)(g * 2 + dir) * 32 + d) * 256 + i * 16);
#pragma unroll
            for (int q = 0; q < 4; ++q) o[q] = (f32x4){a16[4 * q], a16[4 * q + 1], a16[4 * q + 2], a16[4 * q + 3]};
          }
          bf16_t* wst = WSB(O_WST);
          for (long it = GT; it < 262144; it += NGT) {
            const int j = (int)it & 31, n = ((int)it >> 5) & 255, g = (int)it >> 13, dir = n >> 7, p = (n & 127) >> 1, ri = n & 1, dg = dir * 32 + g;
            const float dt = expf(ildt[dg]), lre = ilre[dg * 64 + p], lim = ilim[dg * 64 + p]; float kr_, ki_, pr, pi;
            lam_kfac(lre, lim, dt, kr_, ki_); lam_pow(lre, lim, dt, (float)(dir == 0 ? 31 - j : j), pr, pi);
            const float gr = pr * kr_ - pi * ki_, gi = pr * ki_ + pi * kr_;
            const f32x4* br = (const f32x4*)(ibre + (size_t)(dg * 64 + p) * 16); const f32x4* bi = (const f32x4*)(ibim + (size_t)(dg * 64 + p) * 16);
            f32x4 v[4];
#pragma unroll
            for (int q = 0; q < 4; ++q) { const f32x4 x = br[q], y = bi[q]; v[q] = ri ? (gr * y + gi * x) : (gr * x - gi * y); }
            u32x4* o = (u32x4*)(wst + ((size_t)g * 256 + n) * 512 + j * 16);
            o[0] = pack8(v[0], v[1]); o[1] = pack8(v[2], v[3]);
          }
          bf16_t* wss2 = WSB(O_WSS2);
          for (long it = GT; it < 262144; it += NGT) {
            const int pc = (int)it & 7, dir = ((int)it >> 3) & 1, n = ((int)it >> 4) & 511, g = (int)it >> 13, tau = n >> 4, i = n & 15, dg = dir * 32 + g;
            const float dt = expf(ildt[dg]), e = (float)(dir == 0 ? tau + 1 : 32 - tau); float v[16];
#pragma unroll
            for (int q = 0; q < 8; ++q) { const int p = pc * 8 + q; float pr, pi; lam_pow(ilre[dg * 64 + p], ilim[dg * 64 + p], dt, e, pr, pi);
                const float cr = icre[(dg * 16 + i) * 64 + p], ci = icim[(dg * 16 + i) * 64 + p];
                v[2 * q] = cr * pr - ci * pi; v[2 * q + 1] = -(cr * pi + ci * pr); }
            u32x4* o = (u32x4*)(wss2 + ((size_t)g * 512 + n) * KP + 512 + dir * 128 + pc * 16);
            u32x4 w0, w1; w0.x = pk2(v[0], v[1]); w0.y = pk2(v[2], v[3]); w0.z = pk2(v[4], v[5]); w0.w = pk2(v[6], v[7]); w1.x = pk2(v[8], v[9]); w1.y = pk2(v[10], v[11]); w1.z = pk2(v[12], v[13]); w1.w = pk2(v[14], v[15]);
            o[0] = w0; o[1] = w1;
          }
          float* al = WSF(O_AL);
          for (long it = GT; it < 4096; it += NGT) { const int p = (int)it & 63, dir = ((int)it >> 6) & 1, g = (int)it >> 7, dg = dir * 32 + g; float pr, pi;
            lam_pow(ilre[dg * 64 + p], ilim[dg * 64 + p], expf(ildt[dg]), 32.0f, pr, pi); al[it * 2] = pr; al[it * 2 + 1] = pi; }
        }
    }
    grid.sync();

    { const float* kt = WSF(O_KT); const float* dsk = INF(I_DSK); bf16_t* wss2 = WSB(O_WSS2);
      for (long it = GT; it < 524288; it += NGT) {
        const int j = (int)it & 31, n = ((int)it >> 5) & 511, g = (int)it >> 14, tau = n >> 4, i = n & 15;
        f32x4 v[4];
#pragma unroll
        for (int q = 0; q < 4; ++q) v[q] = (f32x4){0.f, 0.f, 0.f, 0.f};
        if (j <= tau) { const f32x4* s = (const f32x4*)(kt + ((size_t)(g * 2 + 0) * 32 + (tau - j)) * 256 + i * 16);
#pragma unroll
            for (int q = 0; q < 4; ++q) v[q] += s[q]; }
        if (j >= tau) { const f32x4* s = (const f32x4*)(kt + ((size_t)(g * 2 + 1) * 32 + (j - tau)) * 256 + i * 16);
#pragma unroll
            for (int q = 0; q < 4; ++q) v[q] += s[q]; }
        if (j == tau) { const float dv = dsk[g * 16 + i];
#pragma unroll
            for (int q = 0; q < 4; ++q)
#pragma unroll
                for (int e = 0; e < 4; ++e) if (4 * q + e == i) v[q][e] += dv; }
        u32x4* o = (u32x4*)(wss2 + ((size_t)g * 512 + n) * KP + j * 16);
        o[0] = pack8(v[0], v[1]); o[1] = pack8(v[2], v[3]);
      } }
    { pg8::Gemm g{WSB(O_HB), WSB(O_WGU1), D, D, D, 0, 0}; pg8::Order S; S.init(T / 256, 22, 1, GG, CC); EpiSwiglu E{SSQ(0), WSB(O_ACT)}; pg8::gemm_phase(lds, wid_s, g, S, E); }
    GRID_BAR();
    { pg8::Gemm g{WSB(O_ACT), WSB(O_WD1), FF, FF, FF, 0, 0}; pg8::Order S; S.init(T / 256, 4, 1, GG, CC); EpiResid E{INF(I_X), WSF(O_H), 0.5f, WSB(O_HB), SSQ(1)}; pg8::gemm_phase(lds, wid_s, g, S, E); }
    GRID_BAR();
    { pg8::Gemm g{WSB(O_HB), WSB(O_WIN), D, D, D, 0, 0}; pg8::Order S; S.init(T / 256, 12, 1, GG, CC); EpiWin E{SSQ(0), (const f32x2*)(KWS + O_ROPE), KWS, (bf16_t*)KOUT}; pg8::gemm_phase(lds, wid_s, g, S, E); }
    GRID_BAR();
    { pg8::Gemm g{WSB(O_CQ), WSB(O_WUQ), 256, 256, 256, 0, 0}; pg8::Order S; S.init(T / 256, 3, 1, GG, CC); EpiQ E{SSQ(2), (const f32x2*)(KWS + O_ROPE), WSB(O_Q)}; pg8::gemm_phase(lds, wid_s, g, S, E); }
    { pg8::Gemm g{WSB(O_CKV), WSB(O_WUK), 128, 128, 128, 0, 0}; pg8::Order S; S.init(T / 256, 2, 1, GG, CC); EpiRowScale E{SSQ(3), 1.0f / 128, WSB(O_KN), 512}; pg8::gemm_phase(lds, wid_s, g, S, E); }
    { pg8::Gemm g{WSB(O_WUV), WSB(O_CKV), 128, 128, 128, 0, 0}; pg8::Order S; S.init(2, T / 256, 1, GG, CC); EpiVt E{SSQ(3), WSB(O_VT)}; pg8::gemm_phase(lds, wid_s, g, S, E); }
    { pg8::Gemm g{WSB(O_APACK), WSB(O_WST), KP, 512, 512, (size_t)MG * KP, (size_t)256 * 512}; pg8::Order S; S.init(MG / 256, 1, 32, GG, CC); EpiSloc E{WSF(O_SLOC)}; pg8::gemm_phase(lds, wid_s, g, S, E); }
    GRID_BAR();
    { const float* al = WSF(O_AL); const float* sloc = WSF(O_SLOC); bf16_t* apack = WSB(O_APACK); const int G = GG;
      for (int it = WID * G + CC; it < 512; it += 8 * G) {
        const int dir = it & 1, g = (it >> 1) & 31, b = it >> 6, p = LANE;
        const float ar = al[((g * 2 + dir) * 64 + p) * 2], ai_ = al[((g * 2 + dir) * 64 + p) * 2 + 1];
        float hr = 0.f, hi = 0.f;
        for (int c0 = 0; c0 < NCH; c0 += 8) {
            f32x2 s[8];
#pragma unroll
            for (int e = 0; e < 8; ++e) { const int cc = dir ? NCH - 1 - (c0 + e) : c0 + e; s[e] = *(const f32x2*)(sloc + ((size_t)g * MG + b * NCH + cc) * 256 + dir * 128 + 2 * p); }
#pragma unroll
            for (int e = 0; e < 8; ++e) { const int cc = dir ? NCH - 1 - (c0 + e) : c0 + e;
                *(unsigned*)(apack + ((size_t)g * MG + b * NCH + cc) * KP + 512 + dir * 128 + 2 * p) = pk2(hr, hi);
                const float nr = ar * hr - ai_ * hi + s[e][0], ni = ar * hi + ai_ * hr + s[e][1]; hr = nr; hi = ni; }
        }
      } }
    attn_phase(lds, wid_s, WSB(O_Q), WSB(O_KN), WSB(O_KR), WSB(O_VT), WSB(O_ATTN), GG, CC);
    GRID_BAR();
    { pg8::Gemm g{WSB(O_APACK), WSB(O_WSS2), KP, KP, KP, (size_t)MG * KP, (size_t)512 * KP}; pg8::Order S; S.init(MG / 256, 2, 32, GG, CC); EpiSsmOut E{WSB(O_GY)}; pg8::gemm_phase(lds, wid_s, g, S, E); }
    { pg8::Gemm g{WSB(O_ATTN), WSB(O_WOA), 512, 512, 512, 0, 0}; pg8::Order S; S.init(T / 256, 4, 1, GG, CC); EpiGate<0> E{(const bf16_t*)KOUT, nullptr, WSB(O_MRG)}; pg8::gemm_phase(lds, wid_s, g, S, E); }
    GRID_BAR();
    { pg8::Gemm g{WSB(O_GY), WSB(O_WGLU), 512, 512, 512, 0, 0}; pg8::Order S; S.init(T / 256, 4, 1, GG, CC); EpiGlu E{INF(I_BGLU), WSB(O_SO)}; pg8::gemm_phase(lds, wid_s, g, S, E); }
    GRID_BAR();
    { pg8::Gemm g{WSB(O_SO), WSB(O_WOS), 512, 512, 512, 0, 0}; pg8::Order S; S.init(T / 256, 4, 1, GG, CC); EpiGate<1> E{(const bf16_t*)KOUT + (size_t)T * D, WSB(O_MRG), WSB(O_MG)}; pg8::gemm_phase(lds, wid_s, g, S, E); }
    GRID_BAR();
    { pg8::Gemm g{WSB(O_MG), WSB(O_WOUT), D, D, D, 0, 0}; pg8::Order S; S.init(T / 256, 4, 1, GG, CC); EpiResid E{WSF(O_H), WSF(O_H), 1.0f, WSB(O_HB), SSQ(4)}; pg8::gemm_phase(lds, wid_s, g, S, E); }
    GRID_BAR();
    { pg8::Gemm g{WSB(O_HB), WSB(O_WGU2), D, D, D, 0, 0}; pg8::Order S; S.init(T / 256, 22, 1, GG, CC); EpiSwiglu E{SSQ(4), WSB(O_ACT)}; pg8::gemm_phase(lds, wid_s, g, S, E); }
    GRID_BAR();
    { pg8::Gemm g{WSB(O_ACT), WSB(O_WD2), FF, FF, FF, 0, 0}; pg8::Order S; S.init(T / 256, 4, 1, GG, CC); EpiResid E{WSF(O_H), KOUT, 0.5f, nullptr, SSQ(5)}; pg8::gemm_phase(lds, wid_s, g, S, E); }
    GRID_BAR();
    { const float* ssq4 = SSQ(5); float* out = KOUT; const f32x4* gn = (const f32x4*)INF(I_NF) + LANE; const int lane = LANE;
      for (int row = GW; row < T; row += NGW) {
        const float r = rstd_of(ssq4[row], 1.0f / D);
        f32x4* o = (f32x4*)(out + (size_t)row * D) + lane;
#pragma unroll
        for (int j = 0; j < 4; ++j) o[64 * j] = o[64 * j] * r * gn[64 * j];
      } }
}

extern "C" void kernel_launch(void* const* d_in, const int* in_sizes, int n_in, void* d_out, int out_size, void* d_ws, size_t ws_size, hipStream_t stream) {
    static int grid = 0;
    if (grid == 0) {
        if (n_in != 30 || out_size != T * D || ws_size < WS_NEED) { fprintf(stderr, "kernel_launch: unexpected problem (n_in %d, out %d, ws %zu)\n", n_in, out_size, ws_size); grid = -1; return; }
        int dev = 0, cus = 0, per_cu = 0;
        (void)hipGetDevice(&dev); (void)hipDeviceGetAttribute(&cus, hipDeviceAttributeMultiprocessorCount, dev);
        if (hipFuncSetAttribute((const void*)fwd_megakernel, hipFuncAttributeMaxDynamicSharedMemorySize, LDS_BYTES) != hipSuccess) { fprintf(stderr, "kernel_launch: hipFuncSetAttribute failed\n"); grid = -1; return; }
        if (hipOccupancyMaxActiveBlocksPerMultiprocessor(&per_cu, (const void*)fwd_megakernel, 512, LDS_BYTES) != hipSuccess || per_cu < 1) { fprintf(stderr, "kernel_launch: occupancy query gave %d\n", per_cu); per_cu = 1; }
        (void)hipGetLastError();
        grid = cus * per_cu; if (grid > 256) grid = 256; grid &= ~7; if (grid < 8) grid = 8;
    }
    if (grid < 0) return;
    if (hipMemsetAsync((char*)d_ws + O_CTL, 0, CTL_BYTES, stream) != hipSuccess) { fprintf(stderr, "kernel_launch: memset of the barrier words failed\n"); return; }
    Args a{};
    for (int i = 0; i < 30; ++i) a.in[i] = d_in[i];
    a.out = (float*)d_out; a.ws = (unsigned char*)d_ws;
    void* kargs[] = {&a};
    hipError_t e = hipLaunchCooperativeKernel((const void*)fwd_megakernel, dim3(grid), dim3(512), kargs, LDS_BYTES, stream);
    if (e != hipSuccess) fprintf(stderr, "cooperative launch failed: %s (grid %d)\n", hipGetErrorString(e), grid);
}
```

```cpp
#include <hip/hip_runtime.h>
#include <hip/hip_cooperative_groups.h>
#include <cstdio>
#include <cstdint>
namespace cg = cooperative_groups;

#define LAS __attribute__((address_space(3)))
#define DI __device__ __forceinline__
typedef unsigned short bf16_t;
typedef short bf16x8 __attribute__((ext_vector_type(8)));
typedef short s16x4 __attribute__((ext_vector_type(4)));
typedef float f32x2 __attribute__((ext_vector_type(2)));
typedef float f32x4 __attribute__((ext_vector_type(4)));
typedef float f32x16 __attribute__((ext_vector_type(16)));
typedef unsigned u32x2 __attribute__((ext_vector_type(2)));
typedef unsigned u32x4 __attribute__((ext_vector_type(4)));
typedef __bf16 bf16x2_t __attribute__((ext_vector_type(2)));

constexpr int NB = 8, SEQ = 8192, T = NB * SEQ, D = 1024, FF = 2816, NH = 8;
constexpr int NIN = 3072;
constexpr int CL = 32, NCH = SEQ / CL;
constexpr int MG = T / CL;
constexpr int KP = 768;
constexpr float EPS = 1e-6f;
constexpr float QSCALE = 0.14724438f;

constexpr size_t MiB = 1u << 20, QM = MiB / 4;
constexpr size_t O_WGU1 = 0, O_WD1 = 11 * MiB, O_WGU2 = O_WD1 + 22 * QM, O_WD2 = O_WGU2 + 11 * MiB, O_WIN = O_WD2 + 22 * QM;
constexpr size_t O_WUQ = O_WIN + 6 * MiB, O_WUK = O_WUQ + 2 * QM, O_WUV = O_WUK + QM, O_WOA = O_WUV + QM, O_WGLU = O_WOA + MiB, O_WOS = O_WGLU + MiB, O_WOUT = O_WOS + MiB;
constexpr size_t O_WST = O_WOUT + 2 * MiB, O_WSS2 = O_WST + 8 * MiB, O_KT = O_WSS2 + 24 * MiB, O_AL = O_KT + 2 * MiB, O_SSQ = O_AL + QM;
constexpr size_t O_ROPE = O_SSQ + 6 * QM, O_HB = O_ROPE + 8 * MiB, O_H = O_HB + 128 * MiB, O_ACT = O_H + 256 * MiB, O_R4 = O_ACT + 352 * MiB;
constexpr size_t O_CQ = O_ACT, O_CKV = O_CQ + 32 * MiB, O_KR = O_CKV + 16 * MiB, O_APACK = O_KR + 4 * MiB, O_Q = O_APACK + 96 * MiB, O_KN = O_Q + 96 * MiB;
constexpr size_t O_MG = O_Q, O_MRG = O_HB;
constexpr size_t O_VT = O_R4, O_SLOC = O_VT + 64 * MiB, O_ATTN = O_SLOC + 64 * MiB, O_END = O_ATTN + 64 * MiB, O_GY = O_VT, O_SO = O_SLOC;
static_assert(O_KN + 64 * MiB <= O_R4, "act overlay");
constexpr size_t O_CTL = O_END, CTL_BYTES = 32768, O_PCNT = O_CTL + 16384, WS_NEED = O_CTL + CTL_BYTES;
static_assert(WS_NEED <= 1024 * MiB, "workspace");
static_assert(O_WIN == 33 * MiB && O_ROPE % 256 == 0 && O_HB % 256 == 0, "map");

DI unsigned pk2(float lo, float hi) { f32x2 v = {lo, hi}; bf16x2_t b = __builtin_convertvector(v, bf16x2_t); return __builtin_bit_cast(unsigned, b); }
DI float bflo(unsigned u) { return __builtin_bit_cast(float, u << 16); }
DI float bfhi(unsigned u) { return __builtin_bit_cast(float, u & 0xffff0000u); }
DI float sigm(float x) { return __builtin_amdgcn_rcpf(1.0f + __expf(-x)); }
DI float silu(float x) { return x * sigm(x); }
DI float gelu_tanh(float x) { const float z = 1.5957691216f * (x + 0.044715f * x * x * x); return x * sigm(z); }
DI float wave_sum(float v) {
#pragma unroll
    for (int o = 1; o < 64; o <<= 1) v += __shfl_xor(v, o);
    return v;
}
DI int lane_id() { int l; asm volatile("v_mbcnt_lo_u32_b32 %0, -1, 0\n\tv_mbcnt_hi_u32_b32 %0, -1, %0" : "=v"(l)); return l; }
DI float max3f(float a, float b, float c) { return __builtin_fmaxf(__builtin_fmaxf(a, b), c); }
DI u32x4 pack8(f32x4 a, f32x4 b) { u32x4 w; w.x = pk2(a[0], a[1]); w.y = pk2(a[2], a[3]); w.z = pk2(b[0], b[1]); w.w = pk2(b[2], b[3]); return w; }

namespace pg8 {
constexpr int BM = 256, BK = 64, HALF = 128, HTB = HALF * BK * 2, STAGE_BYTES = 8 * HTB, NXCD = 8, WGM = 8;
DI int lds_byte(int r, int c) { const int st = (r >> 4) * 2 + (c >> 5), rr = r & 15, cc = c & 31, ob = rr * 64 + cc * 2; return st * 1024 + (ob ^ (((ob >> 9) & 1) << 5)); }
DI void stage_rc(int b, int& R, int& C) { const int st = b / 1024, sb = b % 1024, swz = sb ^ (((sb >> 9) & 1) << 5); R = (st >> 1) * 16 + swz / 64; C = (st & 1) * 32 + (swz % 64) / 2; }
DI int perm32(int rho) { const int n = rho >> 4, i = rho & 15; return 8 * (i >> 2) + 4 * n + (i & 3); }

struct Unit { int g, pm, pn; };
struct Gemm { const bf16_t* A; const bf16_t* Bt; int lda, ldb, K; size_t gsA, gsB; };
struct Order {
    int nM, nN, nwg, total, G, c;
    DI void init(int nM_, int nN_, int ngroups, int G_, int c_) { nM = nM_; nN = nN_; nwg = nM * nN; total = nwg * ngroups; G = G_; c = c_; }
    DI bool next(int i, Unit& u) const {
        const long L = (long)i * G + c; if (L >= total) return false;
        u.g = (int)(L / nwg); int wgid = (int)(L % nwg);
        { const int q = nwg / NXCD, r = nwg % NXCD, xcd = wgid % NXCD, off = wgid / NXCD; wgid = (xcd < r ? xcd * (q + 1) : r * (q + 1) + (xcd - r) * q) + off; }
        const int nig = WGM * nN, gid = wgid / nig, fm = gid * WGM, gsz = (nM - fm) < WGM ? (nM - fm) : WGM;
        u.pm = fm + ((wgid % nig) % gsz); u.pn = (wgid % nig) / gsz; return true;
    }
};

template <class Epi>
DI void gemm_phase(LAS unsigned char* lds, const int wid, const Gemm g, const Order& S, const Epi& E) {
    const int lane = lane_id(), tid = wid * 64 + lane, wr = wid >> 2, wc = wid & 3, fr = lane & 15, fq = lane >> 4;
    const int K = g.K, nt = K / BK;
    unsigned voffA[2], voffB[2];
#pragma unroll
    for (int i = 0; i < 2; ++i) { int R, C; stage_rc(tid * 16 + i * 8192, R, C); const int Rb = (R & ~31) + perm32(R & 31);
        voffA[i] = (unsigned)(R * g.lda + C) * 2u; voffB[i] = (unsigned)(Rb * g.ldb + C) * 2u; }
    const size_t kstep = (size_t)(BK * 2);
    const size_t hstepA = (size_t)HALF * g.lda * 2, hstepB = (size_t)HALF * g.ldb * 2;
    const unsigned ldsw = (unsigned)wid * 1024u;
    const int aoff = lds_byte(wr * 64 + fr, fq * 8), boff = lds_byte(wc * 32 + fr, fq * 8);
#define PG8_SA(b, h) (((b) * 2 + (h)) * HTB)
#define PG8_SB(b, h) ((4 + (b) * 2 + (h)) * HTB)
#define PG8_STAGE(bufoff, gbase, voff) do { _Pragma("unroll") for (int _i = 0; _i < 2; ++_i) \
        __builtin_amdgcn_global_load_lds((const unsigned*)((const char*)(gbase) + (voff)[_i]), (LAS unsigned*)(lds + (bufoff) + ldsw + _i * 8192), 16, 0, 0); } while (0)
#define PG8_LDA(dst, b, h) do { _Pragma("unroll") for (int m = 0; m < 4; ++m) _Pragma("unroll") for (int k = 0; k < 2; ++k) dst[m][k] = *(const LAS bf16x8*)(lds + PG8_SA(b, h) + aoff + m * 2048 + k * 1024); } while (0)
#define PG8_LDB(dst, b, h) do { _Pragma("unroll") for (int n = 0; n < 2; ++n) _Pragma("unroll") for (int k = 0; k < 2; ++k) dst[n][k] = *(const LAS bf16x8*)(lds + PG8_SB(b, h) + boff + n * 2048 + k * 1024); } while (0)
#define PG8_MMA(ai, bj, At, Bt) do { __builtin_amdgcn_s_setprio(1); _Pragma("unroll") for (int m = 0; m < 4; ++m) _Pragma("unroll") for (int n = 0; n < 2; ++n) _Pragma("unroll") for (int k = 0; k < 2; ++k) \
        acc[ai][bj][m][n] = __builtin_amdgcn_mfma_f32_16x16x32_bf16(Bt[n][k], At[m][k], acc[ai][bj][m][n], 0, 0, 0); __builtin_amdgcn_s_setprio(0); } while (0)
#define PG8_WAIT_V(n) asm volatile("s_waitcnt vmcnt(" #n ")" ::: "memory")
#define PG8_WAIT_L(n) asm volatile("s_waitcnt lgkmcnt(" #n ")" ::: "memory")
#define PG8_BAR __builtin_amdgcn_s_barrier()
#define PG8_SCHED __builtin_amdgcn_sched_barrier(0)
    Unit cur, nxt; int ui = 0;
    if (!S.next(0, cur)) return;
    f32x4 acc[2][2][4][2];
#pragma unroll
    for (int a = 0; a < 2; ++a)
#pragma unroll
        for (int b = 0; b < 2; ++b)
#pragma unroll
            for (int m = 0; m < 4; ++m)
#pragma unroll
                for (int n = 0; n < 2; ++n) acc[a][b][m][n] = (f32x4){0.f, 0.f, 0.f, 0.f};
    bf16x8 At[4][2], B0[2][2], B1[2][2];
    const char* cA = (const char*)(g.A + (size_t)cur.g * g.gsA + (size_t)cur.pm * BM * g.lda);
    const char* cB = (const char*)(g.Bt + (size_t)cur.g * g.gsB + (size_t)cur.pn * BM * g.ldb);
    PG8_STAGE(PG8_SB(0, 0), cB, voffB); PG8_STAGE(PG8_SB(0, 1), cB + hstepB, voffB); PG8_STAGE(PG8_SA(0, 0), cA, voffA); PG8_STAGE(PG8_SA(0, 1), cA + hstepA, voffA);
    if (wr == 1) PG8_BAR;
    PG8_WAIT_V(2); PG8_BAR;
    PG8_STAGE(PG8_SB(1, 0), cB + kstep, voffB); PG8_STAGE(PG8_SA(1, 0), cA + kstep, voffA); PG8_STAGE(PG8_SB(1, 1), cB + hstepB + kstep, voffB);
    PG8_WAIT_V(6); PG8_BAR;
    for (;;) {
        const bool has_next = S.next(ui + 1, nxt);
        const char* nA = has_next ? (const char*)(g.A + (size_t)nxt.g * g.gsA + (size_t)nxt.pm * BM * g.lda) : cA;
        const char* nB = has_next ? (const char*)(g.Bt + (size_t)nxt.g * g.gsB + (size_t)nxt.pn * BM * g.ldb) : cB;
        for (int t = 0; t < nt; t += 2) {
            const bool last = (t == nt - 2);
            const char* a1 = cA + (size_t)(t + 1) * kstep;
            const char* a2 = last ? nA : cA + (size_t)(t + 2) * kstep; const char* b2 = last ? nB : cB + (size_t)(t + 2) * kstep;
            const char* a3 = a2 + kstep; const char* b3 = b2 + kstep;
            PG8_LDB(B0, 0, 0); PG8_LDB(B1, 0, 1); PG8_SCHED; PG8_LDA(At, 0, 0); PG8_STAGE(PG8_SA(1, 1), a1 + hstepA, voffA);
            PG8_WAIT_V(8); PG8_WAIT_L(0); PG8_BAR; PG8_MMA(0, 0, At, B0); PG8_MMA(0, 1, At, B1); PG8_BAR; PG8_SCHED;
            PG8_LDA(At, 0, 1); PG8_STAGE(PG8_SB(0, 0), b2, voffB); PG8_STAGE(PG8_SB(0, 1), b2 + hstepB, voffB); PG8_STAGE(PG8_SA(0, 0), a2, voffA);
            PG8_WAIT_V(8); PG8_WAIT_L(0); PG8_BAR; PG8_MMA(1, 0, At, B0); PG8_MMA(1, 1, At, B1); PG8_BAR; PG8_SCHED;
            PG8_LDB(B0, 1, 0); PG8_LDB(B1, 1, 1); PG8_SCHED; PG8_LDA(At, 1, 0); PG8_STAGE(PG8_SA(0, 1), a2 + hstepA, voffA);
            PG8_WAIT_V(8); PG8_WAIT_L(0); PG8_BAR; PG8_MMA(0, 0, At, B0); PG8_MMA(0, 1, At, B1); PG8_BAR; PG8_SCHED;
            PG8_LDA(At, 1, 1); PG8_STAGE(PG8_SB(1, 0), b3, voffB); PG8_STAGE(PG8_SB(1, 1), b3 + hstepB, voffB); PG8_STAGE(PG8_SA(1, 0), a3, voffA);
            PG8_WAIT_V(8); PG8_WAIT_L(0); PG8_BAR; PG8_MMA(1, 0, At, B0); PG8_MMA(1, 1, At, B1); PG8_BAR; PG8_SCHED;
        }
        if (wr == 0) PG8_BAR;
        E(acc, cur, wr, wc, fr, fq);
        if (!has_next) break;
#pragma unroll
        for (int a = 0; a < 2; ++a)
#pragma unroll
            for (int b = 0; b < 2; ++b)
#pragma unroll
                for (int m = 0; m < 4; ++m)
#pragma unroll
                    for (int n = 0; n < 2; ++n) acc[a][b][m][n] = (f32x4){0.f, 0.f, 0.f, 0.f};
        cur = nxt; cA = nA; cB = nB; ++ui;
        if (wr == 1) PG8_BAR;
    }
    PG8_WAIT_V(0);
    PG8_BAR;
#undef PG8_SA
#undef PG8_SB
#undef PG8_STAGE
#undef PG8_LDA
#undef PG8_LDB
#undef PG8_MMA
#undef PG8_WAIT_V
#undef PG8_WAIT_L
#undef PG8_BAR
#undef PG8_SCHED
}
}
using pg8::Unit;
typedef f32x4 Acc[2][2][4][2];

#define EPI_ROWS(ai, m) _Pragma("unroll") for (int ai = 0; ai < 2; ++ai) _Pragma("unroll") for (int m = 0; m < 4; ++m)
DI int epi_row(const Unit& u, int ai, int wr, int m, int fr) { return u.pm * 256 + ai * 128 + wr * 64 + m * 16 + fr; }
DI int epi_col(const Unit& u, int bj, int wc, int fq) { return u.pn * 256 + bj * 128 + wc * 32 + 8 * fq; }
DI float rstd_of(float ssq, float invn) { return __builtin_amdgcn_rsqf(ssq * invn + EPS); }

struct EpiSwiglu {
    const float* ssq; bf16_t* act;
    DI void operator()(const Acc& acc, const Unit& u, int wr, int wc, int fr, int fq) const {
        const int cb = u.pn * 128 + wc * 32 + 8 * fq;
        EPI_ROWS(ai, m) { const int row = epi_row(u, ai, wr, m, fr); const float r = rstd_of(ssq[row], 1.0f / D);
            f32x4 v[2];
#pragma unroll
            for (int n = 0; n < 2; ++n)
#pragma unroll
                for (int j = 0; j < 4; ++j) v[n][j] = silu(acc[ai][0][m][n][j] * r) * (acc[ai][1][m][n][j] * r);
            *(u32x4*)(act + (size_t)row * FF + cb) = pack8(v[0], v[1]); }
    }
};
struct EpiResid {
    const float* res; float* out; float alpha; bf16_t* ob; float* ssq;
    DI void operator()(const Acc& acc, const Unit& u, int wr, int wc, int fr, int fq) const {
        EPI_ROWS(ai, m) { const int row = epi_row(u, ai, wr, m, fr); float sq = 0.f;
#pragma unroll
            for (int bj = 0; bj < 2; ++bj) { const size_t off = (size_t)row * D + epi_col(u, bj, wc, fq);
                const f32x4 r0 = *(const f32x4*)(res + off), r1 = *(const f32x4*)(res + off + 4);
                const f32x4 o0 = r0 + alpha * acc[ai][bj][m][0], o1 = r1 + alpha * acc[ai][bj][m][1];
                *(f32x4*)(out + off) = o0; *(f32x4*)(out + off + 4) = o1;
                if (ob) *(u32x4*)(ob + off) = pack8(o0, o1);
                sq += (o0[0] * o0[0] + o0[1] * o0[1]) + (o0[2] * o0[2] + o0[3] * o0[3]) + (o1[0] * o1[0] + o1[1] * o1[1]) + (o1[2] * o1[2] + o1[3] * o1[3]); }
            sq += __shfl_xor(sq, 16); sq += __shfl_xor(sq, 32);
            if (fq == 0) unsafeAtomicAdd(ssq + row, sq); }
    }
};
struct EpiResidNorm {
    const float* res; float* out; float alpha; float* ssq; unsigned* pcnt; const float* gain;
    DI void operator()(Acc& acc, const Unit& u, int wr, int wc, int fr, int fq) const {
        EPI_ROWS(ai, m) { const int row = epi_row(u, ai, wr, m, fr); float sq = 0.f;
#pragma unroll
            for (int bj = 0; bj < 2; ++bj) { const size_t off = (size_t)row * D + epi_col(u, bj, wc, fq);
                const f32x4 r0 = *(const f32x4*)(res + off), r1 = *(const f32x4*)(res + off + 4);
                const f32x4 o0 = r0 + alpha * acc[ai][bj][m][0], o1 = r1 + alpha * acc[ai][bj][m][1];
                acc[ai][bj][m][0] = o0; acc[ai][bj][m][1] = o1;
                sq += (o0[0] * o0[0] + o0[1] * o0[1]) + (o0[2] * o0[2] + o0[3] * o0[3]) + (o1[0] * o1[0] + o1[1] * o1[1]) + (o1[2] * o1[2] + o1[3] * o1[3]); }
            sq += __shfl_xor(sq, 16); sq += __shfl_xor(sq, 32);
            if (fq == 0) unsafeAtomicAdd(ssq + row, sq); }
        asm volatile("s_waitcnt vmcnt(0)" ::: "memory");
        __syncthreads();
        if (wr == 0 && wc == 0 && fr == 0 && fq == 0) {
            unsigned* cp = pcnt + 16 * u.pm;
            __hip_atomic_fetch_add(cp, 1u, __ATOMIC_RELAXED, __HIP_MEMORY_SCOPE_AGENT);
            unsigned sp = 0;
            while (__hip_atomic_load(cp, __ATOMIC_RELAXED, __HIP_MEMORY_SCOPE_AGENT) < 4u) { __builtin_amdgcn_s_sleep(2); if (++sp > (1u << 22)) break; }
            __builtin_amdgcn_fence(__ATOMIC_ACQUIRE, "agent");
        }
        __syncthreads();
        EPI_ROWS(ai, m) { const int row = epi_row(u, ai, wr, m, fr);
            const float r = rstd_of(__hip_atomic_load(ssq + row, __ATOMIC_RELAXED, __HIP_MEMORY_SCOPE_AGENT), 1.0f / D);
#pragma unroll
            for (int bj = 0; bj < 2; ++bj) { const int col = epi_col(u, bj, wc, fq); const size_t off = (size_t)row * D + col;
                const f32x4 g0 = *(const f32x4*)(gain + col), g1 = *(const f32x4*)(gain + col + 4);
                *(f32x4*)(out + off) = acc[ai][bj][m][0] * r * g0; *(f32x4*)(out + off + 4) = acc[ai][bj][m][1] * r * g1; } }
    }
};
struct EpiWin {
    float* ssq1; const f32x2* rope; unsigned char* ws; bf16_t* sga;
    DI void operator()(const Acc& acc, const Unit& u, int wr, int wc, int fr, int fq) const {
        const int pn = u.pn;
        const float* ssq2 = ssq1 + T; float* ssqq = ssq1 + 2 * T; float* ssqkv = ssq1 + 3 * T;
        bf16_t* cq = (bf16_t*)(ws + O_CQ); bf16_t* ckv = (bf16_t*)(ws + O_CKV); bf16_t* kr = (bf16_t*)(ws + O_KR); bf16_t* apack = (bf16_t*)(ws + O_APACK); bf16_t* sgs = sga + (size_t)T * D;
        EPI_ROWS(ai, m) { const int row = epi_row(u, ai, wr, m, fr); const float r = rstd_of(ssq2[row], 1.0f / D);
            if (pn == 0) { float sq = 0.f;
#pragma unroll
                for (int bj = 0; bj < 2; ++bj) { const f32x4 a = acc[ai][bj][m][0] * r, b = acc[ai][bj][m][1] * r;
                    *(u32x4*)(cq + (size_t)row * 256 + bj * 128 + wc * 32 + 8 * fq) = pack8(a, b);
                    sq += (a[0] * a[0] + a[1] * a[1]) + (a[2] * a[2] + a[3] * a[3]) + (b[0] * b[0] + b[1] * b[1]) + (b[2] * b[2] + b[3] * b[3]); }
                sq += __shfl_xor(sq, 16); sq += __shfl_xor(sq, 32);
                if (fq == 0) unsafeAtomicAdd(ssqq + row, sq);
            } else if (pn == 1) {
                { const f32x4 a = acc[ai][0][m][0] * r, b = acc[ai][0][m][1] * r;
                  *(u32x4*)(ckv + (size_t)row * 128 + wc * 32 + 8 * fq) = pack8(a, b);
                  float sq = (a[0] * a[0] + a[1] * a[1]) + (a[2] * a[2] + a[3] * a[3]) + (b[0] * b[0] + b[1] * b[1]) + (b[2] * b[2] + b[3] * b[3]);
                  sq += __shfl_xor(sq, 16); sq += __shfl_xor(sq, 32);
                  if (fq == 0) unsafeAtomicAdd(ssqkv + row, sq); }
                if (wc == 0) {
                    const f32x4 a = acc[ai][1][m][0] * r, b = acc[ai][1][m][1] * r;
                    const f32x4 c0 = *(const f32x4*)(rope + (size_t)row * 16 + 4 * fq), c1 = *(const f32x4*)(rope + (size_t)row * 16 + 4 * fq + 2);
                    f32x4 oa, ob;
                    oa[0] = a[0] * c0[0] - a[1] * c0[1]; oa[1] = a[1] * c0[0] + a[0] * c0[1]; oa[2] = a[2] * c0[2] - a[3] * c0[3]; oa[3] = a[3] * c0[2] + a[2] * c0[3];
                    ob[0] = b[0] * c1[0] - b[1] * c1[1]; ob[1] = b[1] * c1[0] + b[0] * c1[1]; ob[2] = b[2] * c1[2] - b[3] * c1[3]; ob[3] = b[3] * c1[2] + b[2] * c1[3];
                    *(u32x4*)(kr + (size_t)row * 32 + 8 * fq) = pack8(oa, ob); }
            } else if (pn < 4) {
#pragma unroll
                for (int bj = 0; bj < 2; ++bj) { const int uc = (pn - 2) * 256 + bj * 128 + wc * 32 + 8 * fq; const int gg = uc >> 4, i0 = uc & 15;
                    *(u32x4*)(apack + ((size_t)gg * MG + (row >> 5)) * KP + (row & 31) * 16 + i0) = pack8(acc[ai][bj][m][0] * r, acc[ai][bj][m][1] * r); }
            } else { bf16_t* dst = pn < 8 ? sga : sgs; const int c0 = ((pn - 4) & 3) * 256;
#pragma unroll
                for (int bj = 0; bj < 2; ++bj) { f32x4 a, b;
#pragma unroll
                    for (int j = 0; j < 4; ++j) { a[j] = sigm(acc[ai][bj][m][0][j] * r); b[j] = sigm(acc[ai][bj][m][1][j] * r); }
                    *(u32x4*)(dst + (size_t)row * D + c0 + bj * 128 + wc * 32 + 8 * fq) = pack8(a, b); }
            } }
    }
};
struct EpiQ {
    const float* ssqq; const f32x2* rope; bf16_t* q;
    DI void operator()(const Acc& acc, const Unit& u, int wr, int wc, int fr, int fq) const {
        EPI_ROWS(ai, m) { const int row = epi_row(u, ai, wr, m, fr); const float r = rstd_of(ssqq[row], 1.0f / 256) * QSCALE;
#pragma unroll
            for (int bj = 0; bj < 2; ++bj) { const int c = epi_col(u, bj, wc, fq); const int d = c % 96;
                f32x4 a = acc[ai][bj][m][0] * r, b = acc[ai][bj][m][1] * r;
                if (d >= 64) { const int i0 = (d - 64) >> 1;
                    const f32x4 c0 = *(const f32x4*)(rope + (size_t)row * 16 + i0), c1 = *(const f32x4*)(rope + (size_t)row * 16 + i0 + 2);
                    f32x4 oa, ob;
                    oa[0] = a[0] * c0[0] - a[1] * c0[1]; oa[1] = a[1] * c0[0] + a[0] * c0[1]; oa[2] = a[2] * c0[2] - a[3] * c0[3]; oa[3] = a[3] * c0[2] + a[2] * c0[3];
                    ob[0] = b[0] * c1[0] - b[1] * c1[1]; ob[1] = b[1] * c1[0] + b[0] * c1[1]; ob[2] = b[2] * c1[2] - b[3] * c1[3]; ob[3] = b[3] * c1[2] + b[2] * c1[3];
                    a = oa; b = ob; }
                *(u32x4*)(q + (size_t)row * 768 + c) = pack8(a, b); } }
    }
};
struct EpiRowScale {
    const float* ssq; float invn; bf16_t* o; int ldo;
    DI void operator()(const Acc& acc, const Unit& u, int wr, int wc, int fr, int fq) const {
        EPI_ROWS(ai, m) { const int row = epi_row(u, ai, wr, m, fr); const float r = rstd_of(ssq[row], invn);
#pragma unroll
            for (int bj = 0; bj < 2; ++bj) *(u32x4*)(o + (size_t)row * ldo + epi_col(u, bj, wc, fq)) = pack8(acc[ai][bj][m][0] * r, acc[ai][bj][m][1] * r); }
    }
};
struct EpiVt {
    const float* ssq; bf16_t* vt;
    DI void operator()(const Acc& acc, const Unit& u, int wr, int wc, int fr, int fq) const {
#pragma unroll
        for (int bj = 0; bj < 2; ++bj) { const int c = epi_col(u, bj, wc, fq);
            const f32x4 s0 = *(const f32x4*)(ssq + c), s1 = *(const f32x4*)(ssq + c + 4); f32x4 r0, r1;
#pragma unroll
            for (int j = 0; j < 4; ++j) { r0[j] = rstd_of(s0[j], 1.0f / 128); r1[j] = rstd_of(s1[j], 1.0f / 128); }
            EPI_ROWS(ai, m) { const int row = epi_row(u, ai, wr, m, fr);
                *(u32x4*)(vt + (size_t)row * T + c) = pack8(acc[ai][bj][m][0] * r0, acc[ai][bj][m][1] * r1); } }
    }
};
struct EpiSloc {
    float* sloc;
    DI void operator()(const Acc& acc, const Unit& u, int wr, int wc, int fr, int fq) const {
        EPI_ROWS(ai, m) { const int row = epi_row(u, ai, wr, m, fr);
#pragma unroll
            for (int bj = 0; bj < 2; ++bj) { float* p = sloc + ((size_t)u.g * MG + row) * 256 + bj * 128 + wc * 32 + 8 * fq;
                *(f32x4*)p = acc[ai][bj][m][0]; *(f32x4*)(p + 4) = acc[ai][bj][m][1]; } }
    }
};
struct EpiSsmOut {
    bf16_t* gy;
    DI void operator()(const Acc& acc, const Unit& u, int wr, int wc, int fr, int fq) const {
        EPI_ROWS(ai, m) { const int row = epi_row(u, ai, wr, m, fr);
#pragma unroll
            for (int bj = 0; bj < 2; ++bj) { const int c = epi_col(u, bj, wc, fq); const int tau = c >> 4, i0 = c & 15; f32x4 a, b;
#pragma unroll
                for (int j = 0; j < 4; ++j) { a[j] = gelu_tanh(acc[ai][bj][m][0][j]); b[j] = gelu_tanh(acc[ai][bj][m][1][j]); }
                *(u32x4*)(gy + ((size_t)row * CL + tau) * 512 + u.g * 16 + i0) = pack8(a, b); } }
    }
};
template <int MODE> struct EpiGate {
    const bf16_t* gate; const bf16_t* prev; bf16_t* o;
    DI void operator()(const Acc& acc, const Unit& u, int wr, int wc, int fr, int fq) const {
        EPI_ROWS(ai, m) { const int row = epi_row(u, ai, wr, m, fr);
#pragma unroll
            for (int bj = 0; bj < 2; ++bj) { const size_t off = (size_t)row * D + epi_col(u, bj, wc, fq);
                const u32x4 gv = *(const u32x4*)(gate + off); f32x4 a, b;
                a[0] = bflo(gv.x) * acc[ai][bj][m][0][0]; a[1] = bfhi(gv.x) * acc[ai][bj][m][0][1]; a[2] = bflo(gv.y) * acc[ai][bj][m][0][2]; a[3] = bfhi(gv.y) * acc[ai][bj][m][0][3];
                b[0] = bflo(gv.z) * acc[ai][bj][m][1][0]; b[1] = bfhi(gv.z) * acc[ai][bj][m][1][1]; b[2] = bflo(gv.w) * acc[ai][bj][m][1][2]; b[3] = bfhi(gv.w) * acc[ai][bj][m][1][3];
                if (MODE == 1) { const u32x4 pv = *(const u32x4*)(prev + off);
                    a[0] += bflo(pv.x); a[1] += bfhi(pv.x); a[2] += bflo(pv.y); a[3] += bfhi(pv.y); b[0] += bflo(pv.z); b[1] += bfhi(pv.z); b[2] += bflo(pv.w); b[3] += bfhi(pv.w); }
                *(u32x4*)(o + off) = pack8(a, b); } }
    }
};
struct EpiGlu {
    const float* bias; bf16_t* so;
    DI void operator()(const Acc& acc, const Unit& u, int wr, int wc, int fr, int fq) const {
        const int cb = u.pn * 128 + wc * 32 + 8 * fq;
        const f32x4 bv0 = *(const f32x4*)(bias + cb), bv1 = *(const f32x4*)(bias + cb + 4), bg0 = *(const f32x4*)(bias + 512 + cb), bg1 = *(const f32x4*)(bias + 512 + cb + 4);
        EPI_ROWS(ai, m) { const int row = epi_row(u, ai, wr, m, fr); f32x4 a, b;
#pragma unroll
            for (int j = 0; j < 4; ++j) { a[j] = (acc[ai][0][m][0][j] + bv0[j]) * sigm(acc[ai][1][m][0][j] + bg0[j]); b[j] = (acc[ai][0][m][1][j] + bv1[j]) * sigm(acc[ai][1][m][1][j] + bg1[j]); }
            *(u32x4*)(so + (size_t)row * 512 + cb) = pack8(a, b); }
    }
};

struct Args { const void* in[30]; float* out; unsigned char* ws; };
typedef __attribute__((address_space(4))) const char* kseg_t;
DI const void* karg(int idx) { kseg_t kp = (kseg_t)__builtin_amdgcn_kernarg_segment_ptr(); asm volatile("" : "+s"(kp)); return *(const void* const __attribute__((address_space(4)))*)(kp + idx * 8); }
#define INF(i) ((const float*)karg(i))
#define KOUT ((float*)karg(30))
#define KWS ((unsigned char*)karg(31))
enum { I_X = 0, I_POS, I_N1, I_WG1, I_WU1, I_WD1, I_NMIX, I_WIN, I_QN, I_WUQ, I_KVN, I_WUKV, I_WOA, I_LRE, I_LIM, I_LDT, I_BRE, I_BIM, I_CRE, I_CIM, I_DSK, I_WGLU, I_BGLU, I_WOS, I_WOUT, I_N2, I_WG2, I_WU2, I_WD2, I_NF };

template <class F> DI void prep_item(const F& f, int K, int nblk, bf16_t* WT, LAS float* scr, int item, int lane) {
    const int kb = item / nblk, nb = item % nblk, k0 = 64 * kb, n0 = 32 * nb;
#pragma unroll 8
    for (int i = 0; i < 32; ++i) { const int kk = 2 * i + (lane >> 5); scr[kk * 33 + (lane & 31)] = f(k0 + kk, n0 + (lane & 31)); }
    asm volatile("s_waitcnt lgkmcnt(0)" ::: "memory");
    const int c = lane & 7;
#pragma unroll
    for (int j = 0; j < 4; ++j) { const int n = (lane >> 3) + 8 * j; const LAS float* s = scr + (8 * c) * 33 + n;
        u32x4 o; o.x = pk2(s[0 * 33], s[1 * 33]); o.y = pk2(s[2 * 33], s[3 * 33]); o.z = pk2(s[4 * 33], s[5 * 33]); o.w = pk2(s[6 * 33], s[7 * 33]);
        *(u32x4*)(WT + (size_t)(n0 + n) * K + k0 + 8 * c) = o; }
    asm volatile("s_waitcnt lgkmcnt(0)" ::: "memory");
}
struct FGateUp { const float *wg, *wu, *gain; DI float operator()(int k, int n) const { const int col = (n >> 8) * 128 + (n & 127); const long delta = (n & 128) ? ((const char*)wu - (const char*)wg) : 0l; const float* w = (const float*)((const char*)wg + delta); return w[(size_t)k * FF + col] * gain[k]; } };
struct FPlain { const float* w; int N; DI float operator()(int k, int n) const { return w[(size_t)k * N + n]; } };
struct FWin { const float *w, *gain; DI float operator()(int k, int n) const {
    int src;
    if (n < 384) src = n; else if (n < 416) { const int j = n - 384; src = 384 + (j & 1) * 16 + (j >> 1); } else if (n < 512) src = -1; else src = n - 96;
    return src < 0 ? 0.f : w[(size_t)k * 2976 + src] * gain[k]; } };
struct FWuq { const float *w, *gain; DI float operator()(int k, int n) const { const int h = n / 96, d = n % 96; int src = n; if (d >= 64) { const int j = d - 64; src = h * 96 + 64 + (j & 1) * 16 + (j >> 1); } return w[(size_t)k * 768 + src] * gain[k]; } };
struct FWukv { const float *w, *gain; int off; DI float operator()(int k, int n) const { return w[(size_t)k * 1024 + (n >> 6) * 128 + off + (n & 63)] * gain[k]; } };
struct FWglu { const float* w; DI float operator()(int k, int n) const { return w[(size_t)k * 1024 + ((n >> 7) & 1) * 512 + (n >> 8) * 128 + (n & 127)]; } };

DI void lam_pow(float lre, float lim, float dt, float e, float& pr, float& pi) { const float mag = expf(e * lre * dt), ang = e * (lim * dt); pr = mag * cosf(ang); pi = mag * sinf(ang); }
DI void lam_kfac(float lre, float lim, float dt, float& kr, float& ki) { float br, bi; lam_pow(lre, lim, dt, 1.0f, br, bi); const float den = lre * lre + lim * lim, nr = br - 1.0f; kr = (nr * lre + bi * lim) / den; ki = (bi * lre - nr * lim) / den; }

constexpr int KS_STRIDE = 208, VS_STRIDE = 144, KS_BYTES = 64 * KS_STRIDE, VS_BYTES = 64 * VS_STRIDE, VOFF = 2 * KS_BYTES, NKT = SEQ / 64;
#define ATT_STEP(KTX, LKN, LKR, LVT, WKN, WKR, WVT, sc0, sc1, sn0, sn1) do { const int kt_ = (KTX); \
            if ((kt_) + 3 < NKT) { const size_t k3 = (size_t)((kt_) + 3) * 64; LKN = *(const u32x4*)(gkn + k3 * 512); if (tid < 256) LKR = *(const u32x4*)(gkr + k3 * 32); } \
            if ((kt_) + 2 < NKT) LVT = *(const u32x4*)(gvt + (size_t)((kt_) + 2) * 64); \
            bf16x8 kf[12]; \
            { const LAS unsigned char* kp = lds + ((kt_ + 1) & 1) * KS_BYTES + r * KS_STRIDE + hh * 16; \
            _Pragma("unroll") \
              for (int s = 0; s < 6; ++s) { kf[2 * s] = *(const LAS bf16x8*)(kp + s * 32); kf[2 * s + 1] = *(const LAS bf16x8*)(kp + 32 * KS_STRIDE + s * 32); } } \
            __builtin_amdgcn_sched_barrier(0); \
            float mx = max3f(sc0[0], sc0[1], sc0[2]); \
            _Pragma("unroll") \
            for (int i = 3; i < 15; i += 2) mx = max3f(mx, sc0[i], sc0[i + 1]); \
            mx = max3f(mx, sc0[15], sc1[0]); \
            _Pragma("unroll") \
            for (int i = 1; i < 15; i += 2) mx = max3f(mx, sc1[i], sc1[i + 1]); \
            mx = fmaxf(mx, sc1[15]); \
            mx = fmaxf(mx, __shfl_xor(mx, 32)); \
            const bool up = (kt_ == 0) | (mx > 6.0f); \
            if (__builtin_amdgcn_ballot_w64(up) != 0ull) { \
                const float delta = up ? mx : 0.f, alpha = __builtin_amdgcn_exp2f(-delta); \
                lrun *= alpha; \
            _Pragma("unroll") \
                for (int i = 0; i < 16; ++i) { negm[i] -= delta; sc0[i] -= delta; sc1[i] -= delta; o0[i] *= alpha; o1[i] *= alpha; } \
            } \
            sn0 = negm; sn1 = negm; \
            const LAS unsigned char* vp = lds + VOFF + (kt_ & 1) * VS_BYTES + r * VS_STRIDE + hh * 16; \
            u32x4 vf[8]; \
            _Pragma("unroll") \
            for (int s2 = 0; s2 < 4; ++s2) { vf[2 * s2] = *(const LAS u32x4*)(vp + 32 * s2); vf[2 * s2 + 1] = *(const LAS u32x4*)(vp + 32 * VS_STRIDE + 32 * s2); } \
            _Pragma("unroll") \
            for (int s = 0; s < 6; ++s) { \
                sn0 = __builtin_amdgcn_mfma_f32_32x32x16_bf16(kf[2 * s], qf[s], sn0, 0, 0, 0); \
                sn1 = __builtin_amdgcn_mfma_f32_32x32x16_bf16(kf[2 * s + 1], qf[s], sn1, 0, 0, 0); } \
            \
            float ps = 0.f; \
            _Pragma("unroll") \
            for (int i = 0; i < 16; ++i) { sc0[i] = __builtin_amdgcn_exp2f(sc0[i]); sc1[i] = __builtin_amdgcn_exp2f(sc1[i]); ps += sc0[i] + sc1[i]; } \
            lrun += ps; \
            _Pragma("unroll") \
            for (int s2 = 0; s2 < 4; ++s2) { \
                u32x4 pw; \
                if (s2 < 2) { const int e = 8 * (s2 & 1); pw.x = pk2(sc0[e], sc0[e + 1]); pw.y = pk2(sc0[e + 2], sc0[e + 3]); pw.z = pk2(sc0[e + 4], sc0[e + 5]); pw.w = pk2(sc0[e + 6], sc0[e + 7]); } \
                else { const int e = 8 * (s2 & 1); pw.x = pk2(sc1[e], sc1[e + 1]); pw.y = pk2(sc1[e + 2], sc1[e + 3]); pw.z = pk2(sc1[e + 4], sc1[e + 5]); pw.w = pk2(sc1[e + 6], sc1[e + 7]); } \
                const bf16x8 pf = __builtin_bit_cast(bf16x8, pw); \
                o0 = __builtin_amdgcn_mfma_f32_32x32x16_bf16(__builtin_bit_cast(bf16x8, vf[2 * s2]), pf, o0, 0, 0, 0); \
                o1 = __builtin_amdgcn_mfma_f32_32x32x16_bf16(__builtin_bit_cast(bf16x8, vf[2 * s2 + 1]), pf, o1, 0, 0, 0); } \
            if ((kt_) + 2 < NKT) { *(LAS u32x4*)(lds + ((kt_) & 1) * KS_BYTES + lkn) = WKN; if (tid < 256) *(LAS u32x4*)(lds + ((kt_) & 1) * KS_BYTES + lkr) = WKR; } \
            if ((kt_) + 1 < NKT) { *(LAS u32x2*)(lds + (((kt_) + 1) & 1) * VS_BYTES + lvt) = (u32x2){WVT.x, WVT.y}; *(LAS u32x2*)(lds + (((kt_) + 1) & 1) * VS_BYTES + lvt + 16) = (u32x2){WVT.z, WVT.w}; } \
            __syncthreads(); \
            } while (0)
DI void attn_phase(LAS unsigned char* lds, const int wid, const bf16_t* Q, const bf16_t* Kn, const bf16_t* Kr, const bf16_t* Vt, bf16_t* O, int G, int c) {
    const int lane = lane_id(), tid = wid * 64 + lane, r = lane & 31, hh = lane >> 5;
    for (int it = 0;; ++it) {
        const long L = (long)it * G + c; if (L >= 2048) break;
        const int xcd = (int)(L & 7), idx = (int)(L >> 3), bh = (idx >> 5) * 8 + xcd, qb = idx & 31, b = bh >> 3, h = bh & 7;
        const size_t tok0 = (size_t)b * SEQ;
        const int q0 = qb * 256 + wid * 32;
        bf16x8 qf[6];
        { const bf16_t* qp = Q + (tok0 + q0 + r) * 768 + h * 96 + 8 * hh;
#pragma unroll
          for (int s = 0; s < 6; ++s) qf[s] = *(const bf16x8*)(qp + 16 * s); }
        f32x16 o0, o1, negm;
#pragma unroll
        for (int i = 0; i < 16; ++i) { o0[i] = 0.f; o1[i] = 0.f; negm[i] = 0.f; }
        float lrun = 0.f;
        const int skey = tid >> 3, sch = tid & 7;
        const int rkey = (tid & 255) >> 2, rch = tid & 3;
        const bf16_t* gkn = Kn + (tok0 + skey) * 512 + h * 64 + sch * 8;
        const bf16_t* gkr = Kr + (tok0 + rkey) * 32 + rch * 8;
        const bf16_t* gvt = Vt + (size_t)(h * 64 + skey) * T + tok0 + sch * 8;
        const unsigned lkn = skey * KS_STRIDE + sch * 16, lkr = rkey * KS_STRIDE + 128 + rch * 16, lvt = VOFF + skey * VS_STRIDE + (sch >> 1) * 32 + (sch & 1) * 8;
        u32x4 rkn = *(const u32x4*)gkn, rvt = *(const u32x4*)gvt, rkr = {0u, 0u, 0u, 0u};
        if (tid < 256) rkr = *(const u32x4*)gkr;
        *(LAS u32x4*)(lds + lkn) = rkn; *(LAS u32x2*)(lds + lvt) = (u32x2){rvt.x, rvt.y}; *(LAS u32x2*)(lds + lvt + 16) = (u32x2){rvt.z, rvt.w}; if (tid < 256) *(LAS u32x4*)(lds + lkr) = rkr;
        rkn = *(const u32x4*)(gkn + 64 * 512); if (tid < 256) rkr = *(const u32x4*)(gkr + 64 * 32);
        *(LAS u32x4*)(lds + KS_BYTES + lkn) = rkn; if (tid < 256) *(LAS u32x4*)(lds + KS_BYTES + lkr) = rkr;
        __syncthreads();
        f32x16 sc0 = negm, sc1 = negm, sd0, sd1;
        { const LAS unsigned char* kp = lds + r * KS_STRIDE + hh * 16;
#pragma unroll
          for (int s = 0; s < 6; ++s) {
              const bf16x8 k0 = *(const LAS bf16x8*)(kp + s * 32), k1 = *(const LAS bf16x8*)(kp + 32 * KS_STRIDE + s * 32);
              sc0 = __builtin_amdgcn_mfma_f32_32x32x16_bf16(k0, qf[s], sc0, 0, 0, 0);
              sc1 = __builtin_amdgcn_mfma_f32_32x32x16_bf16(k1, qf[s], sc1, 0, 0, 0); } }
        __syncthreads();
        u32x4 akn = *(const u32x4*)(gkn + (size_t)2 * 64 * 512), avt = *(const u32x4*)(gvt + 64), akr = {0u, 0u, 0u, 0u}, bkn, bkr = {0u, 0u, 0u, 0u}, bvt;
        if (tid < 256) akr = *(const u32x4*)(gkr + (size_t)2 * 64 * 32);
        for (int kt = 0; kt < NKT; kt += 2) {
            ATT_STEP(kt, bkn, bkr, bvt, akn, akr, avt, sc0, sc1, sd0, sd1);
            ATT_STEP(kt + 1, akn, akr, avt, bkn, bkr, bvt, sd0, sd1, sc0, sc1);
        }
        lrun += __shfl_xor(lrun, 32);
        const float inv = 1.0f / lrun;
        bf16_t* op = O + (tok0 + q0 + r) * 512 + h * 64 + 4 * hh;
#pragma unroll
        for (int gq = 0; gq < 4; ++gq) {
            u32x2 w0, w1;
            w0.x = pk2(o0[4 * gq] * inv, o0[4 * gq + 1] * inv); w0.y = pk2(o0[4 * gq + 2] * inv, o0[4 * gq + 3] * inv);
            w1.x = pk2(o1[4 * gq] * inv, o1[4 * gq + 1] * inv); w1.y = pk2(o1[4 * gq + 2] * inv, o1[4 * gq + 3] * inv);
            *(u32x2*)(op + 8 * gq) = w0; *(u32x2*)(op + 32 + 8 * gq) = w1; }
    }
}

#define XB_TMO      128
#define XB_XCNT(j)  (256  + 64 * (j))
#define XB_XSUB(j)  (1280 + 64 * (j))
#define XB_XGEN(j)  (2304 + 64 * (j))
#define XB_TOP      3328
#define XB_TOPGEN   3392
#define XCD_BAR_WORDS 3456
#define XB_SPIN_CAP (1u << 18)

__device__ __forceinline__ unsigned xb_ld(unsigned* p)              { return __hip_atomic_load(p, __ATOMIC_RELAXED, __HIP_MEMORY_SCOPE_AGENT); }
__device__ __forceinline__ unsigned xb_add(unsigned* p, unsigned v) { return __hip_atomic_fetch_add(p, v, __ATOMIC_RELAXED, __HIP_MEMORY_SCOPE_AGENT); }
__device__ __forceinline__ unsigned xb_xcc_id() { return (unsigned)__builtin_amdgcn_s_getreg((3 << 11) | 20) & 0xFu; }
#define XB_SPIN(cond, bar) do { unsigned _sp = 0; while (cond) { __builtin_amdgcn_s_sleep(1); \
    if ((++_sp & 255u) == 0u) { if (xb_ld(&(bar)[XB_TMO])) break; if (_sp > XB_SPIN_CAP) { atomicAdd(&(bar)[XB_TMO], 1u); break; } } } } while (0)

struct XcdBarrier {
    unsigned* bar; unsigned x;
    volatile LAS unsigned* st;
};

__device__ __forceinline__ XcdBarrier xcd_barrier_post(unsigned* bar, volatile LAS unsigned* st, const bool t0) {
    XcdBarrier b; b.bar = bar; b.x = xb_xcc_id(); b.st = st;
    if (t0) (void)xb_add(&bar[XB_XCNT(b.x)], 1u);
    return b;
}
__device__ __forceinline__ void xcd_barrier_complete(unsigned* bar, unsigned x, unsigned& nloc, unsigned& nx) {
    const unsigned G = gridDim.x * gridDim.y * gridDim.z;
    unsigned sum, cnt, mine, sp = 0u;
    for (;;) {
        sum = 0u; cnt = 0u; mine = 0u;
#pragma unroll
        for (unsigned j = 0; j < 16; ++j) { const unsigned c = xb_ld(&bar[XB_XCNT(j)]); sum += c; cnt += (c > 0u) ? 1u : 0u; mine = (j == x) ? c : mine; }
        if (sum == G) break;
        __builtin_amdgcn_s_sleep(1);
        if ((++sp & 255u) == 0u) { if (xb_ld(&bar[XB_TMO])) break; if (sp > XB_SPIN_CAP) { atomicAdd(&bar[XB_TMO], 1u); break; } }
    }
    nloc = mine > 0u ? mine : 1u; nx = cnt > 0u ? cnt : 1u;
}

__device__ __forceinline__ void xcd_barrier(const XcdBarrier& b, const bool t0) {
    asm volatile("s_waitcnt vmcnt(0)" ::: "memory");
    __syncthreads();
    if (t0) {
        unsigned* bar = b.bar;
        __builtin_amdgcn_s_waitcnt(0);
        unsigned nloc = b.st[0], nx = b.st[1];
        if (nloc == 0u) { xcd_barrier_complete(bar, b.x, nloc, nx); b.st[0] = nloc; b.st[1] = nx; }
        const unsigned old = xb_add(&bar[XB_XSUB(b.x)], 1u);
        const unsigned gen = old / nloc;
        if (old + 1u == (gen + 1u) * nloc) {
            __builtin_amdgcn_fence(__ATOMIC_RELEASE, "agent");
            asm volatile("s_waitcnt vmcnt(0)" ::: "memory");
            const unsigned og = xb_add(&bar[XB_TOP], 1u);
            const unsigned tg = og / nx;
            if (og + 1u == (tg + 1u) * nx) xb_add(&bar[XB_TOPGEN], 1u);
            else XB_SPIN(xb_ld(&bar[XB_TOPGEN]) == tg, bar);
            __builtin_amdgcn_fence(__ATOMIC_ACQUIRE, "agent");
            xb_add(&bar[XB_XGEN(b.x)], 1u);
            asm volatile("s_waitcnt vmcnt(0)" ::: "memory");
        } else {
            XB_SPIN(xb_ld(&bar[XB_XGEN(b.x)]) == gen, bar);
            __builtin_amdgcn_fence(__ATOMIC_ACQUIRE, "agent");
            asm volatile("s_waitcnt vmcnt(0)" ::: "memory");
        }
    }
    __syncthreads();
}

constexpr int LDS_BYTES = 147456;
#define WSB(off) ((bf16_t*)(KWS + (off)))
#define WSF(off) ((float*)(KWS + (off)))
#define SSQ(k) (WSF(O_SSQ) + (size_t)(k) * T)
__global__ void __launch_bounds__(512, 2) fwd_megakernel(Args args_unused) {
    extern __shared__ __attribute__((aligned(16))) unsigned char lds_raw[];
    LAS unsigned char* lds = (LAS unsigned char*)lds_raw;
    cg::grid_group grid = cg::this_grid();
    const int wid_s = __builtin_amdgcn_readfirstlane((int)threadIdx.x >> 6);
#define BAR_ST ((volatile LAS unsigned*)(lds + 131072 + 64))
#define T0 (wid_s == 0 && lane_id() == 0)
    if (T0) { BAR_ST[0] = 0u; BAR_ST[1] = 0u; }
    __syncthreads();
    (void)xcd_barrier_post((unsigned*)(KWS + O_CTL), BAR_ST, T0);
#define GRID_BAR() do { XcdBarrier b_; b_.bar = (unsigned*)(KWS + O_CTL); b_.x = xb_xcc_id(); b_.st = BAR_ST; xcd_barrier(b_, T0); } while (0)
#define TID (wid_s * 64 + lane_id())
#define LANE (lane_id())
#define WID (wid_s)
#define GG ((int)gridDim.x)
#define CC ((int)blockIdx.x)
#define GW (CC * 8 + WID)
#define NGW (GG * 8)
#define GT ((long)CC * 512 + TID)
#define NGT ((long)GG * 512)

    {
        { float* z = SSQ(1); for (long i = GT; i < 5L * T; i += NGT) z[i] = 0.f; }
        { const float* x = INF(I_X); bf16_t* hb = WSB(O_HB); float* ssq1 = SSQ(0); const int lane = LANE;
          for (int row = GW; row < T; row += NGW) {
            const f32x4* xr = (const f32x4*)(x + (size_t)row * D) + lane; f32x4 v[4]; float s = 0.f;
#pragma unroll
            for (int j = 0; j < 4; ++j) { v[j] = xr[64 * j]; s += (v[j][0] * v[j][0] + v[j][1] * v[j][1]) + (v[j][2] * v[j][2] + v[j][3] * v[j][3]); }
            s = wave_sum(s); if (lane == 0) ssq1[row] = s;
            u32x2* o8 = (u32x2*)(hb + (size_t)row * D) + lane;
#pragma unroll
            for (int j = 0; j < 4; ++j) { u32x2 w; w.x = pk2(v[j][0], v[j][1]); w.y = pk2(v[j][2], v[j][3]); o8[64 * j] = w; }
          } }
        { const int* pos = (const int*)karg(I_POS); f32x2* rope = (f32x2*)(KWS + O_ROPE);
          for (long i = GT; i < (long)T * 16; i += NGT) { const int t = (int)(i >> 4), fi = (int)(i & 15);
            const float invf = (float)exp2(-(double)fi * 0.83048202372184058696); const float ang = (float)pos[t] * invf;
            rope[i] = (f32x2){cosf(ang), sinf(ang)}; } }
        {
            const int lane = LANE; LAS float* scr = (LAS float*)(lds + WID * 16384);
            constexpr int I_GU = 16 * 176, I_D = 44 * 32, I_IN = 16 * 96, I_UQ = 4 * 24, I_UK = 2 * 16, I_OA = 8 * 32, I_OUT = 16 * 32;
            constexpr int NITEMS = 2 * I_GU + 2 * I_D + I_IN + I_UQ + 2 * I_UK + 3 * I_OA + I_OUT;
            for (int it = GW; it < NITEMS; it += NGW) {
                int r = it;
                if (r < I_GU) { prep_item(FGateUp{INF(I_WG1), INF(I_WU1), INF(I_N1)}, D, 176, WSB(O_WGU1), scr, r, lane); continue; } r -= I_GU;
                if (r < I_GU) { prep_item(FGateUp{INF(I_WG2), INF(I_WU2), INF(I_N2)}, D, 176, WSB(O_WGU2), scr, r, lane); continue; } r -= I_GU;
                if (r < I_D) { prep_item(FPlain{INF(I_WD1), D}, FF, 32, WSB(O_WD1), scr, r, lane); continue; } r -= I_D;
                if (r < I_D) { prep_item(FPlain{INF(I_WD2), D}, FF, 32, WSB(O_WD2), scr, r, lane); continue; } r -= I_D;
                if (r < I_IN) { prep_item(FWin{INF(I_WIN), INF(I_NMIX)}, D, 96, WSB(O_WIN), scr, r, lane); continue; } r -= I_IN;
                if (r < I_UQ) { prep_item(FWuq{INF(I_WUQ), INF(I_QN)}, 256, 24, WSB(O_WUQ), scr, r, lane); continue; } r -= I_UQ;
                if (r < I_UK) { prep_item(FWukv{INF(I_WUKV), INF(I_KVN), 0}, 128, 16, WSB(O_WUK), scr, r, lane); continue; } r -= I_UK;
                if (r < I_UK) { prep_item(FWukv{INF(I_WUKV), INF(I_KVN), 64}, 128, 16, WSB(O_WUV), scr, r, lane); continue; } r -= I_UK;
                if (r < I_OA) { prep_item(FPlain{INF(I_WOA), D}, 512, 32, WSB(O_WOA), scr, r, lane); continue; } r -= I_OA;
                if (r < I_OA) { prep_item(FWglu{INF(I_WGLU)}, 512, 32, WSB(O_WGLU), scr, r, lane); continue; } r -= I_OA;
                if (r < I_OA) { prep_item(FPlain{INF(I_WOS), D}, 512, 32, WSB(O_WOS), scr, r, lane); continue; } r -= I_OA;
                prep_item(FPlain{INF(I_WOUT), D}, D, 32, WSB(O_WOUT), scr, r, lane);
            }
        }
        { const float *ilre = INF(I_LRE), *ilim = INF(I_LIM), *ildt = INF(I_LDT), *ibre = INF(I_BRE), *ibim = INF(I_BIM), *icre = INF(I_CRE), *icim = INF(I_CIM); float* kt = WSF(O_KT);
          for (long it = GT; it < 131072; it += NGT) {
            const int pq = (int)it & 3, i = ((int)it >> 2) & 15, d = ((int)it >> 6) & 31, dir = ((int)it >> 11) & 1, g = (int)it >> 12, dg = dir * 32 + g;
            const float dt = expf(ildt[dg]); float a16[16];
#pragma unroll
            for (int q = 0; q < 16; ++q) a16[q] = 0.f;
            for (int p = pq * 16; p < pq * 16 + 16; ++p) {
                const float lre = ilre[dg * 64 + p], lim = ilim[dg * 64 + p]; float kr_, ki_, pr, pi;
                lam_kfac(lre, lim, dt, kr_, ki_); lam_pow(lre, lim, dt, (float)d, pr, pi);
                const float cr = icre[(dg * 16 + i) * 64 + p], ci = icim[(dg * 16 + i) * 64 + p];
                const float tr = cr * pr - ci * pi, ti = cr * pi + ci * pr, gr = tr * kr_ - ti * ki_, gi = tr * ki_ + ti * kr_;
                const f32x4* br = (const f32x4*)(ibre + (size_t)(dg * 64 + p) * 16); const f32x4* bi = (const f32x4*)(ibim + (size_t)(dg * 64 + p) * 16);
#pragma unroll
                for (int q = 0; q < 4; ++q) { const f32x4 x = br[q], y = bi[q];
#pragma unroll
                    for (int e = 0; e < 4; ++e) a16[4 * q + e] += gr * x[e] - gi * y[e]; }
            }
#pragma unroll
            for (int q = 0; q < 16; ++q) { a16[q] += __shfl_xor(a16[q], 1); a16[q] += __shfl_xor(a16[q], 2); }
            f32x4* o = (f32x4*)(kt + ((size_t)(g * 2 + dir) * 32 + d) * 256 + i * 16);
            if (pq == 0) {
#pragma unroll
            for (int q = 0; q < 4; ++q) o[q] = (f32x4){a16[4 * q], a16[4 * q + 1], a16[4 * q + 2], a16[4 * q + 3]}; }
          }
          bf16_t* wst = WSB(O_WST);
          for (long it = GT; it < 262144; it += NGT) {
            const int j = (int)it & 31, n = ((int)it >> 5) & 255, g = (int)it >> 13, dir = n >> 7, p = (n & 127) >> 1, ri = n & 1, dg = dir * 32 + g;
            const float dt = expf(ildt[dg]), lre = ilre[dg * 64 + p], lim = ilim[dg * 64 + p]; float kr_, ki_, pr, pi;
            lam_kfac(lre, lim, dt, kr_, ki_); lam_pow(lre, lim, dt, (float)(dir == 0 ? 31 - j : j), pr, pi);
            const float gr = pr * kr_ - pi * ki_, gi = pr * ki_ + pi * kr_;
            const f32x4* br = (const f32x4*)(ibre + (size_t)(dg * 64 + p) * 16); const f32x4* bi = (const f32x4*)(ibim + (size_t)(dg * 64 + p) * 16);
            f32x4 v[4];
#pragma unroll
            for (int q = 0; q < 4; ++q) { const f32x4 x = br[q], y = bi[q]; v[q] = ri ? (gr * y + gi * x) : (gr * x - gi * y); }
            u32x4* o = (u32x4*)(wst + ((size_t)g * 256 + n) * 512 + j * 16);
            o[0] = pack8(v[0], v[1]); o[1] = pack8(v[2], v[3]);
          }
          bf16_t* wss2 = WSB(O_WSS2);
          for (long it = GT; it < 262144; it += NGT) {
            const int pc = (int)it & 7, dir = ((int)it >> 3) & 1, n = ((int)it >> 4) & 511, g = (int)it >> 13, tau = n >> 4, i = n & 15, dg = dir * 32 + g;
            const float dt = expf(ildt[dg]), e = (float)(dir == 0 ? tau + 1 : 32 - tau); float v[16];
#pragma unroll
            for (int q = 0; q < 8; ++q) { const int p = pc * 8 + q; float pr, pi; lam_pow(ilre[dg * 64 + p], ilim[dg * 64 + p], dt, e, pr, pi);
                const float cr = icre[(dg * 16 + i) * 64 + p], ci = icim[(dg * 16 + i) * 64 + p];
                v[2 * q] = cr * pr - ci * pi; v[2 * q + 1] = -(cr * pi + ci * pr); }
            u32x4* o = (u32x4*)(wss2 + ((size_t)g * 512 + n) * KP + 512 + dir * 128 + pc * 16);
            u32x4 w0, w1; w0.x = pk2(v[0], v[1]); w0.y = pk2(v[2], v[3]); w0.z = pk2(v[4], v[5]); w0.w = pk2(v[6], v[7]); w1.x = pk2(v[8], v[9]); w1.y = pk2(v[10], v[11]); w1.z = pk2(v[12], v[13]); w1.w = pk2(v[14], v[15]);
            o[0] = w0; o[1] = w1;
          }
          float* al = WSF(O_AL);
          for (long it = GT; it < 4096; it += NGT) { const int p = (int)it & 63, dir = ((int)it >> 6) & 1, g = (int)it >> 7, dg = dir * 32 + g; float pr, pi;
            lam_pow(ilre[dg * 64 + p], ilim[dg * 64 + p], expf(ildt[dg]), 32.0f, pr, pi); al[it * 2] = pr; al[it * 2 + 1] = pi; }
        }
    }
    if (GG == 0x7fffffff) grid.sync();
    GRID_BAR();

    { const float* kt = WSF(O_KT); const float* dsk = INF(I_DSK); bf16_t* wss2 = WSB(O_WSS2);
      for (long it = GT; it < 524288; it += NGT) {
        const int j = (int)it & 31, n = ((int)it >> 5) & 511, g = (int)it >> 14, tau = n >> 4, i = n & 15;
        f32x4 v[4];
#pragma unroll
        for (int q = 0; q < 4; ++q) v[q] = (f32x4){0.f, 0.f, 0.f, 0.f};
        if (j <= tau) { const f32x4* s = (const f32x4*)(kt + ((size_t)(g * 2 + 0) * 32 + (tau - j)) * 256 + i * 16);
#pragma unroll
            for (int q = 0; q < 4; ++q) v[q] += s[q]; }
        if (j >= tau) { const f32x4* s = (const f32x4*)(kt + ((size_t)(g * 2 + 1) * 32 + (j - tau)) * 256 + i * 16);
#pragma unroll
            for (int q = 0; q < 4; ++q) v[q] += s[q]; }
        if (j == tau) { const float dv = dsk[g * 16 + i];
#pragma unroll
            for (int q = 0; q < 4; ++q)
#pragma unroll
                for (int e = 0; e < 4; ++e) if (4 * q + e == i) v[q][e] += dv; }
        u32x4* o = (u32x4*)(wss2 + ((size_t)g * 512 + n) * KP + j * 16);
        o[0] = pack8(v[0], v[1]); o[1] = pack8(v[2], v[3]);
      } }
    { pg8::Gemm g{WSB(O_HB), WSB(O_WGU1), D, D, D, 0, 0}; pg8::Order S; S.init(T / 256, 22, 1, GG, CC); EpiSwiglu E{SSQ(0), WSB(O_ACT)}; pg8::gemm_phase(lds, wid_s, g, S, E); }
    GRID_BAR();
    { pg8::Gemm g{WSB(O_ACT), WSB(O_WD1), FF, FF, FF, 0, 0}; pg8::Order S; S.init(T / 256, 4, 1, GG, CC); EpiResid E{INF(I_X), WSF(O_H), 0.5f, WSB(O_HB), SSQ(1)}; pg8::gemm_phase(lds, wid_s, g, S, E); }
    GRID_BAR();
    { pg8::Gemm g{WSB(O_HB), WSB(O_WIN), D, D, D, 0, 0}; pg8::Order S; S.init(T / 256, 12, 1, GG, CC); EpiWin E{SSQ(0), (const f32x2*)(KWS + O_ROPE), KWS, (bf16_t*)KOUT}; pg8::gemm_phase(lds, wid_s, g, S, E); }
    GRID_BAR();
    { pg8::Gemm g{WSB(O_CQ), WSB(O_WUQ), 256, 256, 256, 0, 0}; pg8::Order S; S.init(T / 256, 3, 1, GG, CC); EpiQ E{SSQ(2), (const f32x2*)(KWS + O_ROPE), WSB(O_Q)}; pg8::gemm_phase(lds, wid_s, g, S, E); }
    { pg8::Gemm g{WSB(O_CKV), WSB(O_WUK), 128, 128, 128, 0, 0}; pg8::Order S; S.init(T / 256, 2, 1, GG, CC); EpiRowScale E{SSQ(3), 1.0f / 128, WSB(O_KN), 512}; pg8::gemm_phase(lds, wid_s, g, S, E); }
    { pg8::Gemm g{WSB(O_WUV), WSB(O_CKV), 128, 128, 128, 0, 0}; pg8::Order S; S.init(2, T / 256, 1, GG, CC); EpiVt E{SSQ(3), WSB(O_VT)}; pg8::gemm_phase(lds, wid_s, g, S, E); }
    { pg8::Gemm g{WSB(O_APACK), WSB(O_WST), KP, 512, 512, (size_t)MG * KP, (size_t)256 * 512}; pg8::Order S; S.init(MG / 256, 1, 32, GG, CC); EpiSloc E{WSF(O_SLOC)}; pg8::gemm_phase(lds, wid_s, g, S, E); }
    GRID_BAR();
    { const float* al = WSF(O_AL); const float* sloc = WSF(O_SLOC); bf16_t* apack = WSB(O_APACK); const int G = GG;
      for (int it = WID * G + CC; it < 512; it += 8 * G) {
        const int dir = it & 1, g = (it >> 1) & 31, b = it >> 6, p = LANE;
        const float ar = al[((g * 2 + dir) * 64 + p) * 2], ai_ = al[((g * 2 + dir) * 64 + p) * 2 + 1];
        float hr = 0.f, hi = 0.f;
        for (int c0 = 0; c0 < NCH; c0 += 32) {
            f32x2 s[32];
#pragma unroll
            for (int e = 0; e < 32; ++e) { const int cc = dir ? NCH - 1 - (c0 + e) : c0 + e; s[e] = *(const f32x2*)(sloc + ((size_t)g * MG + b * NCH + cc) * 256 + dir * 128 + 2 * p); }
#pragma unroll
            for (int e = 0; e < 32; ++e) { const int cc = dir ? NCH - 1 - (c0 + e) : c0 + e;
                *(unsigned*)(apack + ((size_t)g * MG + b * NCH + cc) * KP + 512 + dir * 128 + 2 * p) = pk2(hr, hi);
                const float nr = ar * hr - ai_ * hi + s[e][0], ni = ar * hi + ai_ * hr + s[e][1]; hr = nr; hi = ni; }
        }
      } }
    attn_phase(lds, wid_s, WSB(O_Q), WSB(O_KN), WSB(O_KR), WSB(O_VT), WSB(O_ATTN), GG, CC);
    GRID_BAR();
    { pg8::Gemm g{WSB(O_APACK), WSB(O_WSS2), KP, KP, KP, (size_t)MG * KP, (size_t)512 * KP}; pg8::Order S; S.init(MG / 256, 2, 32, GG, CC); EpiSsmOut E{WSB(O_GY)}; pg8::gemm_phase(lds, wid_s, g, S, E); }
    { pg8::Gemm g{WSB(O_ATTN), WSB(O_WOA), 512, 512, 512, 0, 0}; pg8::Order S; S.init(T / 256, 4, 1, GG, CC); EpiGate<0> E{(const bf16_t*)KOUT, nullptr, WSB(O_MRG)}; pg8::gemm_phase(lds, wid_s, g, S, E); }
    GRID_BAR();
    { pg8::Gemm g{WSB(O_GY), WSB(O_WGLU), 512, 512, 512, 0, 0}; pg8::Order S; S.init(T / 256, 4, 1, GG, CC); EpiGlu E{INF(I_BGLU), WSB(O_SO)}; pg8::gemm_phase(lds, wid_s, g, S, E); }
    GRID_BAR();
    { pg8::Gemm g{WSB(O_SO), WSB(O_WOS), 512, 512, 512, 0, 0}; pg8::Order S; S.init(T / 256, 4, 1, GG, CC); EpiGate<1> E{(const bf16_t*)KOUT + (size_t)T * D, WSB(O_MRG), WSB(O_MG)}; pg8::gemm_phase(lds, wid_s, g, S, E); }
    GRID_BAR();
    { pg8::Gemm g{WSB(O_MG), WSB(O_WOUT), D, D, D, 0, 0}; pg8::Order S; S.init(T / 256, 4, 1, GG, CC); EpiResid E{WSF(O_H), WSF(O_H), 1.0f, WSB(O_HB), SSQ(4)}; pg8::gemm_phase(lds, wid_s, g, S, E); }
    GRID_BAR();
    { pg8::Gemm g{WSB(O_HB), WSB(O_WGU2), D, D, D, 0, 0}; pg8::Order S; S.init(T / 256, 22, 1, GG, CC); EpiSwiglu E{SSQ(4), WSB(O_ACT)}; pg8::gemm_phase(lds, wid_s, g, S, E); }
    GRID_BAR();
    if (GG == 256) {
        pg8::Gemm g{WSB(O_ACT), WSB(O_WD2), FF, FF, FF, 0, 0}; pg8::Order S; S.init(T / 256, 4, 1, GG, CC); EpiResidNorm E{WSF(O_H), KOUT, 0.5f, SSQ(5), (unsigned*)(KWS + O_PCNT), INF(I_NF)}; pg8::gemm_phase(lds, wid_s, g, S, E);
    } else {
    { pg8::Gemm g{WSB(O_ACT), WSB(O_WD2), FF, FF, FF, 0, 0}; pg8::Order S; S.init(T / 256, 4, 1, GG, CC); EpiResid E{WSF(O_H), KOUT, 0.5f, nullptr, SSQ(5)}; pg8::gemm_phase(lds, wid_s, g, S, E); }
    GRID_BAR();
    { const float* ssq4 = SSQ(5); float* out = KOUT; const f32x4* gn = (const f32x4*)INF(I_NF) + LANE; const int lane = LANE;
      for (int row = GW; row < T; row += NGW) {
        const float r = rstd_of(ssq4[row], 1.0f / D);
        f32x4* o = (f32x4*)(out + (size_t)row * D) + lane;
#pragma unroll
        for (int j = 0; j < 4; ++j) o[64 * j] = o[64 * j] * r * gn[64 * j];
      } }
    }
}

extern "C" void kernel_launch(void* const* d_in, const int* in_sizes, int n_in, void* d_out, int out_size, void* d_ws, size_t ws_size, hipStream_t stream) {
    static int grid = 0;
    if (grid == 0) {
        if (n_in != 30 || out_size != T * D || ws_size < WS_NEED) { fprintf(stderr, "kernel_launch: unexpected problem (n_in %d, out %d, ws %zu)\n", n_in, out_size, ws_size); grid = -1; return; }
        int dev = 0, cus = 0, per_cu = 0;
        (void)hipGetDevice(&dev); (void)hipDeviceGetAttribute(&cus, hipDeviceAttributeMultiprocessorCount, dev);
        if (hipFuncSetAttribute((const void*)fwd_megakernel, hipFuncAttributeMaxDynamicSharedMemorySize, LDS_BYTES) != hipSuccess) { fprintf(stderr, "kernel_launch: hipFuncSetAttribute failed\n"); grid = -1; return; }
        if (hipOccupancyMaxActiveBlocksPerMultiprocessor(&per_cu, (const void*)fwd_megakernel, 512, LDS_BYTES) != hipSuccess || per_cu < 1) { fprintf(stderr, "kernel_launch: occupancy query gave %d\n", per_cu); per_cu = 1; }
        (void)hipGetLastError();
        grid = cus * per_cu; if (grid > 256) grid = 256; grid &= ~7; if (grid < 8) grid = 8;
    }
    if (grid < 0) return;
    if (hipMemsetAsync((char*)d_ws + O_CTL, 0, CTL_BYTES, stream) != hipSuccess) { fprintf(stderr, "kernel_launch: memset of the barrier words failed\n"); return; }
    Args a{};
    for (int i = 0; i < 30; ++i) a.in[i] = d_in[i];
    a.out = (float*)d_out; a.ws = (unsigned char*)d_ws;
    void* kargs[] = {&a};
    hipError_t e = hipLaunchCooperativeKernel((const void*)fwd_megakernel, dim3(grid), dim3(512), kargs, LDS_BYTES, stream);
    if (e != hipSuccess) fprintf(stderr, "cooperative launch failed: %s (grid %d)\n", hipGetErrorString(e), grid);
}
```

```cpp
#include <hip/hip_runtime.h>
#include <hip/hip_cooperative_groups.h>
#include <cstdio>
#include <cstdint>
namespace cg = cooperative_groups;

#define LAS __attribute__((address_space(3)))
#define DI __device__ __forceinline__
typedef unsigned short bf16_t;
typedef short bf16x8 __attribute__((ext_vector_type(8)));
typedef short s16x4 __attribute__((ext_vector_type(4)));
typedef float f32x2 __attribute__((ext_vector_type(2)));
typedef float f32x4 __attribute__((ext_vector_type(4)));
typedef float f32x16 __attribute__((ext_vector_type(16)));
typedef unsigned u32x2 __attribute__((ext_vector_type(2)));
typedef unsigned u32x4 __attribute__((ext_vector_type(4)));
typedef __bf16 bf16x2_t __attribute__((ext_vector_type(2)));

constexpr int NB = 8, SEQ = 8192, T = NB * SEQ, D = 1024, FF = 2816, NH = 8;
constexpr int NIN = 3072;
constexpr int CL = 32, NCH = SEQ / CL;
constexpr int MG = T / CL;
constexpr int KP = 768;
constexpr float EPS = 1e-6f;
constexpr float QSCALE = 0.14724438f;

constexpr size_t MiB = 1u << 20, QM = MiB / 4;
constexpr size_t O_WGU1 = 0, O_WD1 = 11 * MiB, O_WGU2 = O_WD1 + 22 * QM, O_WD2 = O_WGU2 + 11 * MiB, O_WIN = O_WD2 + 22 * QM;
constexpr size_t O_WUQ = O_WIN + 6 * MiB, O_WUK = O_WUQ + 2 * QM, O_WUV = O_WUK + QM, O_WOA = O_WUV + QM, O_WGLU = O_WOA + MiB, O_WOS = O_WGLU + MiB, O_WOUT = O_WOS + MiB;
constexpr size_t O_WST = O_WOUT + 2 * MiB, O_WSS2 = O_WST + 8 * MiB, O_KT = O_WSS2 + 24 * MiB, O_AL = O_KT + 2 * MiB, O_SSQ = O_AL + QM;
constexpr size_t O_ROPE = O_SSQ + 6 * QM, O_HB = O_ROPE + 8 * MiB, O_H = O_HB + 128 * MiB, O_ACT = O_H + 256 * MiB, O_R4 = O_ACT + 352 * MiB;
constexpr size_t O_CQ = O_ACT, O_CKV = O_CQ + 32 * MiB, O_KR = O_CKV + 16 * MiB, O_APACK = O_KR + 4 * MiB, O_Q = O_APACK + 96 * MiB, O_KN = O_Q + 96 * MiB;
constexpr size_t O_MG = O_Q, O_MRG = O_HB;
constexpr size_t O_VT = O_R4, O_SLOC = O_VT + 64 * MiB, O_ATTN = O_SLOC + 64 * MiB, O_END = O_ATTN + 64 * MiB, O_GY = O_VT, O_SO = O_SLOC;
static_assert(O_KN + 64 * MiB <= O_R4, "act overlay");
constexpr size_t O_CTL = O_END, CTL_BYTES = 32768, O_PCNT = O_CTL + 16384, WS_NEED = O_CTL + CTL_BYTES;
static_assert(WS_NEED <= 1024 * MiB, "workspace");
static_assert(O_WIN == 33 * MiB && O_ROPE % 256 == 0 && O_HB % 256 == 0, "map");

DI unsigned pk2(float lo, float hi) { f32x2 v = {lo, hi}; bf16x2_t b = __builtin_convertvector(v, bf16x2_t); return __builtin_bit_cast(unsigned, b); }
DI float bflo(unsigned u) { return __builtin_bit_cast(float, u << 16); }
DI float bfhi(unsigned u) { return __builtin_bit_cast(float, u & 0xffff0000u); }
DI float sigm(float x) { return __builtin_amdgcn_rcpf(1.0f + __expf(-x)); }
DI float silu(float x) { return x * sigm(x); }
DI float gelu_tanh(float x) { const float z = 1.5957691216f * (x + 0.044715f * x * x * x); return x * sigm(z); }
DI float wave_sum(float v) {
#pragma unroll
    for (int o = 1; o < 64; o <<= 1) v += __shfl_xor(v, o);
    return v;
}
DI int lane_id() { int l; asm volatile("v_mbcnt_lo_u32_b32 %0, -1, 0\n\tv_mbcnt_hi_u32_b32 %0, -1, %0" : "=v"(l)); return l; }
DI float max3f(float a, float b, float c) { return __builtin_fmaxf(__builtin_fmaxf(a, b), c); }
DI u32x4 pack8(f32x4 a, f32x4 b) { u32x4 w; w.x = pk2(a[0], a[1]); w.y = pk2(a[2], a[3]); w.z = pk2(b[0], b[1]); w.w = pk2(b[2], b[3]); return w; }

namespace pg8 {
constexpr int BM = 256, BK = 64, HALF = 128, HTB = HALF * BK * 2, STAGE_BYTES = 8 * HTB, NXCD = 8, WGM = 8;
DI int lds_byte(int r, int c) { const int st = (r >> 4) * 2 + (c >> 5), rr = r & 15, cc = c & 31, ob = rr * 64 + cc * 2; return st * 1024 + (ob ^ (((ob >> 9) & 1) << 5)); }
DI void stage_rc(int b, int& R, int& C) { const int st = b / 1024, sb = b % 1024, swz = sb ^ (((sb >> 9) & 1) << 5); R = (st >> 1) * 16 + swz / 64; C = (st & 1) * 32 + (swz % 64) / 2; }
DI int perm32(int rho) { const int n = rho >> 4, i = rho & 15; return 8 * (i >> 2) + 4 * n + (i & 3); }

struct Unit { int g, pm, pn; };
struct Gemm { const bf16_t* A; const bf16_t* Bt; int lda, ldb, K; size_t gsA, gsB; };
struct Order {
    int nM, nN, nwg, total, G, c;
    DI void init(int nM_, int nN_, int ngroups, int G_, int c_) { nM = nM_; nN = nN_; nwg = nM * nN; total = nwg * ngroups; G = G_; c = c_; }
    DI bool next(int i, Unit& u) const {
        const long L = (long)i * G + c; if (L >= total) return false;
        u.g = (int)(L / nwg); int wgid = (int)(L % nwg);
        { const int q = nwg / NXCD, r = nwg % NXCD, xcd = wgid % NXCD, off = wgid / NXCD; wgid = (xcd < r ? xcd * (q + 1) : r * (q + 1) + (xcd - r) * q) + off; }
        const int nig = WGM * nN, gid = wgid / nig, fm = gid * WGM, gsz = (nM - fm) < WGM ? (nM - fm) : WGM;
        u.pm = fm + ((wgid % nig) % gsz); u.pn = (wgid % nig) / gsz; return true;
    }
};

template <class Epi>
DI void gemm_phase(LAS unsigned char* lds, const int wid, const Gemm g, const Order& S, const Epi& E) {
    const int lane = lane_id(), tid = wid * 64 + lane, wr = wid >> 2, wc = wid & 3, fr = lane & 15, fq = lane >> 4;
    const int K = g.K, nt = K / BK;
    unsigned voffA[2], voffB[2];
#pragma unroll
    for (int i = 0; i < 2; ++i) { int R, C; stage_rc(tid * 16 + i * 8192, R, C); const int Rb = (R & ~31) + perm32(R & 31);
        voffA[i] = (unsigned)(R * g.lda + C) * 2u; voffB[i] = (unsigned)(Rb * g.ldb + C) * 2u; }
    const size_t kstep = (size_t)(BK * 2);
    const size_t hstepA = (size_t)HALF * g.lda * 2, hstepB = (size_t)HALF * g.ldb * 2;
    const unsigned ldsw = (unsigned)wid * 1024u;
    const int aoff = lds_byte(wr * 64 + fr, fq * 8), boff = lds_byte(wc * 32 + fr, fq * 8);
#define PG8_SA(b, h) (((b) * 2 + (h)) * HTB)
#define PG8_SB(b, h) ((4 + (b) * 2 + (h)) * HTB)
#define PG8_STAGE(bufoff, gbase, voff) do { _Pragma("unroll") for (int _i = 0; _i < 2; ++_i) \
        __builtin_amdgcn_global_load_lds((const unsigned*)((const char*)(gbase) + (voff)[_i]), (LAS unsigned*)(lds + (bufoff) + ldsw + _i * 8192), 16, 0, 0); } while (0)
#define PG8_LDA(dst, b, h) do { _Pragma("unroll") for (int m = 0; m < 4; ++m) _Pragma("unroll") for (int k = 0; k < 2; ++k) dst[m][k] = *(const LAS bf16x8*)(lds + PG8_SA(b, h) + aoff + m * 2048 + k * 1024); } while (0)
#define PG8_LDB(dst, b, h) do { _Pragma("unroll") for (int n = 0; n < 2; ++n) _Pragma("unroll") for (int k = 0; k < 2; ++k) dst[n][k] = *(const LAS bf16x8*)(lds + PG8_SB(b, h) + boff + n * 2048 + k * 1024); } while (0)
#define PG8_MMA(ai, bj, At, Bt) do { __builtin_amdgcn_s_setprio(1); _Pragma("unroll") for (int m = 0; m < 4; ++m) _Pragma("unroll") for (int n = 0; n < 2; ++n) _Pragma("unroll") for (int k = 0; k < 2; ++k) \
        acc[ai][bj][m][n] = __builtin_amdgcn_mfma_f32_16x16x32_bf16(Bt[n][k], At[m][k], acc[ai][bj][m][n], 0, 0, 0); __builtin_amdgcn_s_setprio(0); } while (0)
#define PG8_WAIT_V(n) asm volatile("s_waitcnt vmcnt(" #n ")" ::: "memory")
#define PG8_WAIT_L(n) asm volatile("s_waitcnt lgkmcnt(" #n ")" ::: "memory")
#define PG8_BAR __builtin_amdgcn_s_barrier()
#define PG8_SCHED __builtin_amdgcn_sched_barrier(0)
    Unit cur, nxt; int ui = 0;
    if (!S.next(0, cur)) return;
    f32x4 acc[2][2][4][2];
#pragma unroll
    for (int a = 0; a < 2; ++a)
#pragma unroll
        for (int b = 0; b < 2; ++b)
#pragma unroll
            for (int m = 0; m < 4; ++m)
#pragma unroll
                for (int n = 0; n < 2; ++n) acc[a][b][m][n] = (f32x4){0.f, 0.f, 0.f, 0.f};
    bf16x8 At[4][2], B0[2][2], B1[2][2];
    const char* cA = (const char*)(g.A + (size_t)cur.g * g.gsA + (size_t)cur.pm * BM * g.lda);
    const char* cB = (const char*)(g.Bt + (size_t)cur.g * g.gsB + (size_t)cur.pn * BM * g.ldb);
    PG8_STAGE(PG8_SB(0, 0), cB, voffB); PG8_STAGE(PG8_SB(0, 1), cB + hstepB, voffB); PG8_STAGE(PG8_SA(0, 0), cA, voffA); PG8_STAGE(PG8_SA(0, 1), cA + hstepA, voffA);
    if (wr == 1) PG8_BAR;
    PG8_WAIT_V(2); PG8_BAR;
    PG8_STAGE(PG8_SB(1, 0), cB + kstep, voffB); PG8_STAGE(PG8_SA(1, 0), cA + kstep, voffA); PG8_STAGE(PG8_SB(1, 1), cB + hstepB + kstep, voffB);
    PG8_WAIT_V(6); PG8_BAR;
    for (;;) {
        const bool has_next = S.next(ui + 1, nxt);
        const char* nA = has_next ? (const char*)(g.A + (size_t)nxt.g * g.gsA + (size_t)nxt.pm * BM * g.lda) : cA;
        const char* nB = has_next ? (const char*)(g.Bt + (size_t)nxt.g * g.gsB + (size_t)nxt.pn * BM * g.ldb) : cB;
        for (int t = 0; t < nt; t += 2) {
            const bool last = (t == nt - 2);
            const char* a1 = cA + (size_t)(t + 1) * kstep;
            const char* a2 = last ? nA : cA + (size_t)(t + 2) * kstep; const char* b2 = last ? nB : cB + (size_t)(t + 2) * kstep;
            const char* a3 = a2 + kstep; const char* b3 = b2 + kstep;
            PG8_LDB(B0, 0, 0); PG8_LDB(B1, 0, 1); PG8_SCHED; PG8_LDA(At, 0, 0); PG8_STAGE(PG8_SA(1, 1), a1 + hstepA, voffA);
            PG8_WAIT_V(8); PG8_WAIT_L(0); PG8_BAR; PG8_MMA(0, 0, At, B0); PG8_MMA(0, 1, At, B1); PG8_BAR; PG8_SCHED;
            PG8_LDA(At, 0, 1); PG8_STAGE(PG8_SB(0, 0), b2, voffB); PG8_STAGE(PG8_SB(0, 1), b2 + hstepB, voffB); PG8_STAGE(PG8_SA(0, 0), a2, voffA);
            PG8_WAIT_V(8); PG8_WAIT_L(0); PG8_BAR; PG8_MMA(1, 0, At, B0); PG8_MMA(1, 1, At, B1); PG8_BAR; PG8_SCHED;
            PG8_LDB(B0, 1, 0); PG8_LDB(B1, 1, 1); PG8_SCHED; PG8_LDA(At, 1, 0); PG8_STAGE(PG8_SA(0, 1), a2 + hstepA, voffA);
            PG8_WAIT_V(8); PG8_WAIT_L(0); PG8_BAR; PG8_MMA(0, 0, At, B0); PG8_MMA(0, 1, At, B1); PG8_BAR; PG8_SCHED;
            PG8_LDA(At, 1, 1); PG8_STAGE(PG8_SB(1, 0), b3, voffB); PG8_STAGE(PG8_SB(1, 1), b3 + hstepB, voffB); PG8_STAGE(PG8_SA(1, 0), a3, voffA);
            PG8_WAIT_V(8); PG8_WAIT_L(0); PG8_BAR; PG8_MMA(1, 0, At, B0); PG8_MMA(1, 1, At, B1); PG8_BAR; PG8_SCHED;
        }
        if (wr == 0) PG8_BAR;
        { const int le = lane_id(); E(acc, cur, wr, wc, le & 15, le >> 4); }
        if (!has_next) break;
#pragma unroll
        for (int a = 0; a < 2; ++a)
#pragma unroll
            for (int b = 0; b < 2; ++b)
#pragma unroll
                for (int m = 0; m < 4; ++m)
#pragma unroll
                    for (int n = 0; n < 2; ++n) acc[a][b][m][n] = (f32x4){0.f, 0.f, 0.f, 0.f};
        cur = nxt; cA = nA; cB = nB; ++ui;
        if (wr == 1) PG8_BAR;
    }
    PG8_WAIT_V(0);
    PG8_BAR;
#undef PG8_SA
#undef PG8_SB
#undef PG8_STAGE
#undef PG8_LDA
#undef PG8_LDB
#undef PG8_MMA
#undef PG8_WAIT_V
#undef PG8_WAIT_L
#undef PG8_BAR
#undef PG8_SCHED
}
}
using pg8::Unit;
typedef f32x4 Acc[2][2][4][2];

#define EPI_ROWS(ai, m) _Pragma("unroll") for (int ai = 0; ai < 2; ++ai) _Pragma("unroll") for (int m = 0; m < 4; ++m)
#define EPI_FENCE() asm volatile("" ::: "memory")
#define EPI_RSTD8(rr, ssqp, invn) float rr[2][4]; EPI_ROWS(ai, m) rr[ai][m] = (ssqp)[epi_row(u, ai, wr, m, fr)]; EPI_FENCE(); EPI_ROWS(ai, m) rr[ai][m] = rstd_of(rr[ai][m], invn);
DI int epi_row(const Unit& u, int ai, int wr, int m, int fr) { return u.pm * 256 + ai * 128 + wr * 64 + m * 16 + fr; }
DI int epi_col(const Unit& u, int bj, int wc, int fq) { return u.pn * 256 + bj * 128 + wc * 32 + 8 * fq; }
DI float rstd_of(float ssq, float invn) { return __builtin_amdgcn_rsqf(ssq * invn + EPS); }

struct EpiSwiglu {
    const float* ssq; bf16_t* act;
    DI void operator()(const Acc& acc, const Unit& u, int wr, int wc, int fr, int fq) const {
        const int cb = u.pn * 128 + wc * 32 + 8 * fq;
        EPI_RSTD8(rr, ssq, 1.0f / D)
        EPI_ROWS(ai, m) { const int row = epi_row(u, ai, wr, m, fr); const float r = rr[ai][m];
            f32x4 v[2];
#pragma unroll
            for (int n = 0; n < 2; ++n)
#pragma unroll
                for (int j = 0; j < 4; ++j) v[n][j] = silu(acc[ai][0][m][n][j] * r) * (acc[ai][1][m][n][j] * r);
            *(u32x4*)(act + (size_t)row * FF + cb) = pack8(v[0], v[1]); }
    }
};
struct EpiResid {
    const float* res; float* out; float alpha; bf16_t* ob; float* ssq;
    DI void operator()(const Acc& acc, const Unit& u, int wr, int wc, int fr, int fq) const {
#pragma unroll
        for (int ai = 0; ai < 2; ++ai) {
            f32x4 pre[4][2][2];
#pragma unroll
            for (int m = 0; m < 4; ++m)
#pragma unroll
                for (int bj = 0; bj < 2; ++bj) { const size_t off = (size_t)epi_row(u, ai, wr, m, fr) * D + epi_col(u, bj, wc, fq);
                    pre[m][bj][0] = *(const f32x4*)(res + off); pre[m][bj][1] = *(const f32x4*)(res + off + 4); }
            EPI_FENCE();
#pragma unroll
            for (int m = 0; m < 4; ++m) { const int row = epi_row(u, ai, wr, m, fr); float sq = 0.f;
#pragma unroll
                for (int bj = 0; bj < 2; ++bj) { const size_t off = (size_t)row * D + epi_col(u, bj, wc, fq);
                    const f32x4 o0 = pre[m][bj][0] + alpha * acc[ai][bj][m][0], o1 = pre[m][bj][1] + alpha * acc[ai][bj][m][1];
                    *(f32x4*)(out + off) = o0; *(f32x4*)(out + off + 4) = o1;
                    if (ob) *(u32x4*)(ob + off) = pack8(o0, o1);
                    sq += (o0[0] * o0[0] + o0[1] * o0[1]) + (o0[2] * o0[2] + o0[3] * o0[3]) + (o1[0] * o1[0] + o1[1] * o1[1]) + (o1[2] * o1[2] + o1[3] * o1[3]); }
                sq += __shfl_xor(sq, 16); sq += __shfl_xor(sq, 32);
                if (fq == 0) unsafeAtomicAdd(ssq + row, sq); }
            EPI_FENCE();
        }
    }
};
struct EpiResidNorm {
    const float* res; float* out; float alpha; float* ssq; unsigned* pcnt; const float* gain;
    DI void operator()(Acc& acc, const Unit& u, int wr, int wc, int fr, int fq) const {
#pragma unroll
        for (int ai = 0; ai < 2; ++ai) {
            f32x4 pre[4][2][2];
#pragma unroll
            for (int m = 0; m < 4; ++m)
#pragma unroll
                for (int bj = 0; bj < 2; ++bj) { const size_t off = (size_t)epi_row(u, ai, wr, m, fr) * D + epi_col(u, bj, wc, fq);
                    pre[m][bj][0] = *(const f32x4*)(res + off); pre[m][bj][1] = *(const f32x4*)(res + off + 4); }
            EPI_FENCE();
#pragma unroll
            for (int m = 0; m < 4; ++m) { const int row = epi_row(u, ai, wr, m, fr); float sq = 0.f;
#pragma unroll
                for (int bj = 0; bj < 2; ++bj) {
                    const f32x4 o0 = pre[m][bj][0] + alpha * acc[ai][bj][m][0], o1 = pre[m][bj][1] + alpha * acc[ai][bj][m][1];
                    acc[ai][bj][m][0] = o0; acc[ai][bj][m][1] = o1;
                    sq += (o0[0] * o0[0] + o0[1] * o0[1]) + (o0[2] * o0[2] + o0[3] * o0[3]) + (o1[0] * o1[0] + o1[1] * o1[1]) + (o1[2] * o1[2] + o1[3] * o1[3]); }
                sq += __shfl_xor(sq, 16); sq += __shfl_xor(sq, 32);
                if (fq == 0) unsafeAtomicAdd(ssq + row, sq); }
            EPI_FENCE();
        }
        asm volatile("s_waitcnt vmcnt(0)" ::: "memory");
        __syncthreads();
        if (wr == 0 && wc == 0 && fr == 0 && fq == 0) {
            unsigned* cp = pcnt + 16 * u.pm;
            __hip_atomic_fetch_add(cp, 1u, __ATOMIC_RELAXED, __HIP_MEMORY_SCOPE_AGENT);
            unsigned sp = 0;
            while (__hip_atomic_load(cp, __ATOMIC_RELAXED, __HIP_MEMORY_SCOPE_AGENT) < 4u) { __builtin_amdgcn_s_sleep(2); if (++sp > (1u << 22)) break; }
            __builtin_amdgcn_fence(__ATOMIC_ACQUIRE, "agent");
        }
        __syncthreads();
        float rr[2][4]; f32x4 gg[2][2];
        EPI_ROWS(ai, m) rr[ai][m] = __hip_atomic_load(ssq + epi_row(u, ai, wr, m, fr), __ATOMIC_RELAXED, __HIP_MEMORY_SCOPE_AGENT);
#pragma unroll
        for (int bj = 0; bj < 2; ++bj) { const int col = epi_col(u, bj, wc, fq); gg[bj][0] = *(const f32x4*)(gain + col); gg[bj][1] = *(const f32x4*)(gain + col + 4); }
        EPI_FENCE();
        EPI_ROWS(ai, m) { const int row = epi_row(u, ai, wr, m, fr); const float r = rstd_of(rr[ai][m], 1.0f / D);
#pragma unroll
            for (int bj = 0; bj < 2; ++bj) { const size_t off = (size_t)row * D + epi_col(u, bj, wc, fq);
                *(f32x4*)(out + off) = acc[ai][bj][m][0] * r * gg[bj][0]; *(f32x4*)(out + off + 4) = acc[ai][bj][m][1] * r * gg[bj][1]; } }
    }
};
struct EpiWin {
    float* ssq1; const f32x2* rope; unsigned char* ws; bf16_t* sga;
    DI void operator()(const Acc& acc, const Unit& u, int wr, int wc, int fr, int fq) const {
        const int pn = u.pn;
        const float* ssq2 = ssq1 + T; float* ssqq = ssq1 + 2 * T; float* ssqkv = ssq1 + 3 * T;
        bf16_t* cq = (bf16_t*)(ws + O_CQ); bf16_t* ckv = (bf16_t*)(ws + O_CKV); bf16_t* kr = (bf16_t*)(ws + O_KR); bf16_t* apack = (bf16_t*)(ws + O_APACK); bf16_t* sgs = sga + (size_t)T * D;
        EPI_RSTD8(rr, ssq2, 1.0f / D)
        EPI_ROWS(ai, m) { const int row = epi_row(u, ai, wr, m, fr); const float r = rr[ai][m];
            if (pn == 0) { float sq = 0.f;
#pragma unroll
                for (int bj = 0; bj < 2; ++bj) { const f32x4 a = acc[ai][bj][m][0] * r, b = acc[ai][bj][m][1] * r;
                    *(u32x4*)(cq + (size_t)row * 256 + bj * 128 + wc * 32 + 8 * fq) = pack8(a, b);
                    sq += (a[0] * a[0] + a[1] * a[1]) + (a[2] * a[2] + a[3] * a[3]) + (b[0] * b[0] + b[1] * b[1]) + (b[2] * b[2] + b[3] * b[3]); }
                sq += __shfl_xor(sq, 16); sq += __shfl_xor(sq, 32);
                if (fq == 0) unsafeAtomicAdd(ssqq + row, sq);
            } else if (pn == 1) {
                { const f32x4 a = acc[ai][0][m][0] * r, b = acc[ai][0][m][1] * r;
                  *(u32x4*)(ckv + (size_t)row * 128 + wc * 32 + 8 * fq) = pack8(a, b);
                  float sq = (a[0] * a[0] + a[1] * a[1]) + (a[2] * a[2] + a[3] * a[3]) + (b[0] * b[0] + b[1] * b[1]) + (b[2] * b[2] + b[3] * b[3]);
                  sq += __shfl_xor(sq, 16); sq += __shfl_xor(sq, 32);
                  if (fq == 0) unsafeAtomicAdd(ssqkv + row, sq); }
                if (wc == 0) {
                    const f32x4 a = acc[ai][1][m][0] * r, b = acc[ai][1][m][1] * r;
                    const f32x4 c0 = *(const f32x4*)(rope + (size_t)row * 16 + 4 * fq), c1 = *(const f32x4*)(rope + (size_t)row * 16 + 4 * fq + 2);
                    f32x4 oa, ob;
                    oa[0] = a[0] * c0[0] - a[1] * c0[1]; oa[1] = a[1] * c0[0] + a[0] * c0[1]; oa[2] = a[2] * c0[2] - a[3] * c0[3]; oa[3] = a[3] * c0[2] + a[2] * c0[3];
                    ob[0] = b[0] * c1[0] - b[1] * c1[1]; ob[1] = b[1] * c1[0] + b[0] * c1[1]; ob[2] = b[2] * c1[2] - b[3] * c1[3]; ob[3] = b[3] * c1[2] + b[2] * c1[3];
                    *(u32x4*)(kr + (size_t)row * 32 + 8 * fq) = pack8(oa, ob); }
            } else if (pn < 4) {
#pragma unroll
                for (int bj = 0; bj < 2; ++bj) { const int uc = (pn - 2) * 256 + bj * 128 + wc * 32 + 8 * fq; const int gg = uc >> 4, i0 = uc & 15;
                    *(u32x4*)(apack + ((size_t)gg * MG + (row >> 5)) * KP + (row & 31) * 16 + i0) = pack8(acc[ai][bj][m][0] * r, acc[ai][bj][m][1] * r); }
            } else { bf16_t* dst = pn < 8 ? sga : sgs; const int c0 = ((pn - 4) & 3) * 256;
#pragma unroll
                for (int bj = 0; bj < 2; ++bj) { f32x4 a, b;
#pragma unroll
                    for (int j = 0; j < 4; ++j) { a[j] = sigm(acc[ai][bj][m][0][j] * r); b[j] = sigm(acc[ai][bj][m][1][j] * r); }
                    *(u32x4*)(dst + (size_t)row * D + c0 + bj * 128 + wc * 32 + 8 * fq) = pack8(a, b); }
            } }
    }
};
struct EpiQ {
    const float* ssqq; const f32x2* rope; bf16_t* q;
    DI void operator()(const Acc& acc, const Unit& u, int wr, int wc, int fr, int fq_in) const {
        int fq = fq_in; asm volatile("" : "+v"(fq));
        EPI_RSTD8(rr, ssqq, 1.0f / 256)
#pragma unroll
        for (int bj = 0; bj < 2; ++bj) { const int c = epi_col(u, bj, wc, fq); const int d = c % 96; const bool rot = d >= 64; const int i0 = rot ? (d - 64) >> 1 : 0;
#pragma unroll
            for (int ai = 0; ai < 2; ++ai) {
                f32x4 cs[4][2];
#pragma unroll
                for (int m = 0; m < 4; ++m) { const f32x2* rp = rope + (size_t)epi_row(u, ai, wr, m, fr) * 16 + i0;
                    cs[m][0] = rot ? *(const f32x4*)rp : (f32x4){1.f, 0.f, 1.f, 0.f}; cs[m][1] = rot ? *(const f32x4*)(rp + 2) : (f32x4){1.f, 0.f, 1.f, 0.f}; }
                EPI_FENCE();
#pragma unroll
                for (int m = 0; m < 4; ++m) { const int row = epi_row(u, ai, wr, m, fr); const float r = rr[ai][m] * QSCALE;
                    f32x4 a = acc[ai][bj][m][0] * r, b = acc[ai][bj][m][1] * r;
                    if (rot) { const f32x4 c0 = cs[m][0], c1 = cs[m][1]; f32x4 oa, ob;
                        oa[0] = a[0] * c0[0] - a[1] * c0[1]; oa[1] = a[1] * c0[0] + a[0] * c0[1]; oa[2] = a[2] * c0[2] - a[3] * c0[3]; oa[3] = a[3] * c0[2] + a[2] * c0[3];
                        ob[0] = b[0] * c1[0] - b[1] * c1[1]; ob[1] = b[1] * c1[0] + b[0] * c1[1]; ob[2] = b[2] * c1[2] - b[3] * c1[3]; ob[3] = b[3] * c1[2] + b[2] * c1[3];
                        a = oa; b = ob; }
                    *(u32x4*)(q + (size_t)row * 768 + c) = pack8(a, b); }
                EPI_FENCE();
            } }
    }
};
struct EpiRowScale {
    const float* ssq; float invn; bf16_t* o; int ldo;
    DI void operator()(const Acc& acc, const Unit& u, int wr, int wc, int fr, int fq) const {
        EPI_RSTD8(rr, ssq, invn)
        EPI_ROWS(ai, m) { const int row = epi_row(u, ai, wr, m, fr); const float r = rr[ai][m];
#pragma unroll
            for (int bj = 0; bj < 2; ++bj) *(u32x4*)(o + (size_t)row * ldo + epi_col(u, bj, wc, fq)) = pack8(acc[ai][bj][m][0] * r, acc[ai][bj][m][1] * r); }
    }
};
struct EpiVt {
    const float* ssq; bf16_t* vt;
    DI void operator()(const Acc& acc, const Unit& u, int wr, int wc, int fr, int fq) const {
#pragma unroll
        for (int bj = 0; bj < 2; ++bj) { const int c = epi_col(u, bj, wc, fq);
            const f32x4 s0 = *(const f32x4*)(ssq + c), s1 = *(const f32x4*)(ssq + c + 4); f32x4 r0, r1;
#pragma unroll
            for (int j = 0; j < 4; ++j) { r0[j] = rstd_of(s0[j], 1.0f / 128); r1[j] = rstd_of(s1[j], 1.0f / 128); }
            EPI_ROWS(ai, m) { const int row = epi_row(u, ai, wr, m, fr);
                *(u32x4*)(vt + (size_t)row * T + c) = pack8(acc[ai][bj][m][0] * r0, acc[ai][bj][m][1] * r1); } }
    }
};
struct EpiSloc {
    float* sloc;
    DI void operator()(const Acc& acc, const Unit& u, int wr, int wc, int fr, int fq) const {
        EPI_ROWS(ai, m) { const int row = epi_row(u, ai, wr, m, fr);
#pragma unroll
            for (int bj = 0; bj < 2; ++bj) { float* p = sloc + ((size_t)u.g * MG + row) * 256 + bj * 128 + wc * 32 + 8 * fq;
                *(f32x4*)p = acc[ai][bj][m][0]; *(f32x4*)(p + 4) = acc[ai][bj][m][1]; } }
    }
};
struct EpiSsmOut {
    bf16_t* gy;
    DI void operator()(const Acc& acc, const Unit& u, int wr, int wc, int fr, int fq) const {
        EPI_ROWS(ai, m) { const int row = epi_row(u, ai, wr, m, fr);
#pragma unroll
            for (int bj = 0; bj < 2; ++bj) { const int c = epi_col(u, bj, wc, fq); const int tau = c >> 4, i0 = c & 15; f32x4 a, b;
#pragma unroll
                for (int j = 0; j < 4; ++j) { a[j] = gelu_tanh(acc[ai][bj][m][0][j]); b[j] = gelu_tanh(acc[ai][bj][m][1][j]); }
                *(u32x4*)(gy + ((size_t)row * CL + tau) * 512 + u.g * 16 + i0) = pack8(a, b); } }
    }
};
template <int MODE> struct EpiGate {
    const bf16_t* gate; const bf16_t* prev; bf16_t* o;
    DI void operator()(const Acc& acc, const Unit& u, int wr, int wc, int fr, int fq) const {
#pragma unroll
        for (int ai = 0; ai < 2; ++ai) {
            u32x4 gv[4][2], pv[4][2];
#pragma unroll
            for (int m = 0; m < 4; ++m)
#pragma unroll
                for (int bj = 0; bj < 2; ++bj) { const size_t off = (size_t)epi_row(u, ai, wr, m, fr) * D + epi_col(u, bj, wc, fq);
                    gv[m][bj] = *(const u32x4*)(gate + off); if (MODE == 1) pv[m][bj] = *(const u32x4*)(prev + off); }
            EPI_FENCE();
#pragma unroll
            for (int m = 0; m < 4; ++m)
#pragma unroll
                for (int bj = 0; bj < 2; ++bj) { const size_t off = (size_t)epi_row(u, ai, wr, m, fr) * D + epi_col(u, bj, wc, fq);
                    const u32x4 g = gv[m][bj]; f32x4 a, b;
                    a[0] = bflo(g.x) * acc[ai][bj][m][0][0]; a[1] = bfhi(g.x) * acc[ai][bj][m][0][1]; a[2] = bflo(g.y) * acc[ai][bj][m][0][2]; a[3] = bfhi(g.y) * acc[ai][bj][m][0][3];
                    b[0] = bflo(g.z) * acc[ai][bj][m][1][0]; b[1] = bfhi(g.z) * acc[ai][bj][m][1][1]; b[2] = bflo(g.w) * acc[ai][bj][m][1][2]; b[3] = bfhi(g.w) * acc[ai][bj][m][1][3];
                    if (MODE == 1) { const u32x4 p = pv[m][bj];
                        a[0] += bflo(p.x); a[1] += bfhi(p.x); a[2] += bflo(p.y); a[3] += bfhi(p.y); b[0] += bflo(p.z); b[1] += bfhi(p.z); b[2] += bflo(p.w); b[3] += bfhi(p.w); }
                    *(u32x4*)(o + off) = pack8(a, b); }
            EPI_FENCE();
        }
    }
};
struct EpiGlu {
    const float* bias; bf16_t* so;
    DI void operator()(const Acc& acc, const Unit& u, int wr, int wc, int fr, int fq) const {
        const int cb = u.pn * 128 + wc * 32 + 8 * fq;
        const f32x4 bv0 = *(const f32x4*)(bias + cb), bv1 = *(const f32x4*)(bias + cb + 4), bg0 = *(const f32x4*)(bias + 512 + cb), bg1 = *(const f32x4*)(bias + 512 + cb + 4);
        EPI_ROWS(ai, m) { const int row = epi_row(u, ai, wr, m, fr); f32x4 a, b;
#pragma unroll
            for (int j = 0; j < 4; ++j) { a[j] = (acc[ai][0][m][0][j] + bv0[j]) * sigm(acc[ai][1][m][0][j] + bg0[j]); b[j] = (acc[ai][0][m][1][j] + bv1[j]) * sigm(acc[ai][1][m][1][j] + bg1[j]); }
            *(u32x4*)(so + (size_t)row * 512 + cb) = pack8(a, b); }
    }
};

struct Args { const void* in[30]; float* out; unsigned char* ws; };
typedef __attribute__((address_space(4))) const char* kseg_t;
DI const void* karg(int idx) { kseg_t kp = (kseg_t)__builtin_amdgcn_kernarg_segment_ptr(); asm volatile("" : "+s"(kp)); return *(const void* const __attribute__((address_space(4)))*)(kp + idx * 8); }
#define INF(i) ((const float*)karg(i))
#define KOUT ((float*)karg(30))
#define KWS ((unsigned char*)karg(31))
enum { I_X = 0, I_POS, I_N1, I_WG1, I_WU1, I_WD1, I_NMIX, I_WIN, I_QN, I_WUQ, I_KVN, I_WUKV, I_WOA, I_LRE, I_LIM, I_LDT, I_BRE, I_BIM, I_CRE, I_CIM, I_DSK, I_WGLU, I_BGLU, I_WOS, I_WOUT, I_N2, I_WG2, I_WU2, I_WD2, I_NF };

template <class F> DI void prep_item(const F& f, int K, int nblk, bf16_t* WT, LAS float* scr, int item, int lane) {
    const int kb = item / nblk, nb = item % nblk, k0 = 64 * kb, n0 = 32 * nb;
#pragma unroll 8
    for (int i = 0; i < 32; ++i) { const int kk = 2 * i + (lane >> 5); scr[kk * 33 + (lane & 31)] = f(k0 + kk, n0 + (lane & 31)); }
    asm volatile("s_waitcnt lgkmcnt(0)" ::: "memory");
    const int c = lane & 7;
#pragma unroll
    for (int j = 0; j < 4; ++j) { const int n = (lane >> 3) + 8 * j; const LAS float* s = scr + (8 * c) * 33 + n;
        u32x4 o; o.x = pk2(s[0 * 33], s[1 * 33]); o.y = pk2(s[2 * 33], s[3 * 33]); o.z = pk2(s[4 * 33], s[5 * 33]); o.w = pk2(s[6 * 33], s[7 * 33]);
        *(u32x4*)(WT + (size_t)(n0 + n) * K + k0 + 8 * c) = o; }
    asm volatile("s_waitcnt lgkmcnt(0)" ::: "memory");
}
struct FGateUp { const float *wg, *wu, *gain; DI float operator()(int k, int n) const { const int col = (n >> 8) * 128 + (n & 127); const long delta = (n & 128) ? ((const char*)wu - (const char*)wg) : 0l; const float* w = (const float*)((const char*)wg + delta); return w[(size_t)k * FF + col] * gain[k]; } };
struct FPlain { const float* w; int N; DI float operator()(int k, int n) const { return w[(size_t)k * N + n]; } };
struct FWin { const float *w, *gain; DI float operator()(int k, int n) const {
    int src;
    if (n < 384) src = n; else if (n < 416) { const int j = n - 384; src = 384 + (j & 1) * 16 + (j >> 1); } else if (n < 512) src = -1; else src = n - 96;
    return src < 0 ? 0.f : w[(size_t)k * 2976 + src] * gain[k]; } };
struct FWuq { const float *w, *gain; DI float operator()(int k, int n) const { const int h = n / 96, d = n % 96; int src = n; if (d >= 64) { const int j = d - 64; src = h * 96 + 64 + (j & 1) * 16 + (j >> 1); } return w[(size_t)k * 768 + src] * gain[k]; } };
struct FWukv { const float *w, *gain; int off; DI float operator()(int k, int n) const { return w[(size_t)k * 1024 + (n >> 6) * 128 + off + (n & 63)] * gain[k]; } };
struct FWglu { const float* w; DI float operator()(int k, int n) const { return w[(size_t)k * 1024 + ((n >> 7) & 1) * 512 + (n >> 8) * 128 + (n & 127)]; } };

DI void lam_pow(float lre, float lim, float dt, float e, float& pr, float& pi) { const float mag = expf(e * lre * dt), ang = e * (lim * dt); pr = mag * cosf(ang); pi = mag * sinf(ang); }
DI void lam_kfac(float lre, float lim, float dt, float& kr, float& ki) { float br, bi; lam_pow(lre, lim, dt, 1.0f, br, bi); const float den = lre * lre + lim * lim, nr = br - 1.0f; kr = (nr * lre + bi * lim) / den; ki = (bi * lre - nr * lim) / den; }

constexpr int KS_STRIDE = 208, VS_STRIDE = 144, KS_BYTES = 64 * KS_STRIDE, VS_BYTES = 64 * VS_STRIDE, VOFF = 2 * KS_BYTES, NKT = SEQ / 64;
#define ATT_STEP(KTX, LKN, LKR, LVT, WKN, WKR, WVT, sc0, sc1, sn0, sn1) do { const int kt_ = (KTX); \
            if ((kt_) + 3 < NKT) { const size_t k3 = (size_t)((kt_) + 3) * 64; LKN = *(const u32x4*)(gkn + k3 * 512); if (tid < 256) LKR = *(const u32x4*)(gkr + k3 * 32); } \
            if ((kt_) + 2 < NKT) LVT = *(const u32x4*)(gvt + (size_t)((kt_) + 2) * 64); \
            bf16x8 kf[12]; \
            { const LAS unsigned char* kp = lds + ((kt_ + 1) & 1) * KS_BYTES + r * KS_STRIDE + hh * 16; \
            _Pragma("unroll") \
              for (int s = 0; s < 6; ++s) { kf[2 * s] = *(const LAS bf16x8*)(kp + s * 32); kf[2 * s + 1] = *(const LAS bf16x8*)(kp + 32 * KS_STRIDE + s * 32); } } \
            __builtin_amdgcn_sched_barrier(0); \
            float mx = max3f(sc0[0], sc0[1], sc0[2]); \
            _Pragma("unroll") \
            for (int i = 3; i < 15; i += 2) mx = max3f(mx, sc0[i], sc0[i + 1]); \
            mx = max3f(mx, sc0[15], sc1[0]); \
            _Pragma("unroll") \
            for (int i = 1; i < 15; i += 2) mx = max3f(mx, sc1[i], sc1[i + 1]); \
            mx = fmaxf(mx, sc1[15]); \
            mx = fmaxf(mx, __shfl_xor(mx, 32)); \
            const bool up = (kt_ == 0) | (mx > 6.0f); \
            if (__builtin_amdgcn_ballot_w64(up) != 0ull) { \
                const float delta = up ? mx : 0.f, alpha = __builtin_amdgcn_exp2f(-delta); \
                lrun *= alpha; \
            _Pragma("unroll") \
                for (int i = 0; i < 16; ++i) { negm[i] -= delta; sc0[i] -= delta; sc1[i] -= delta; o0[i] *= alpha; o1[i] *= alpha; } \
            } \
            sn0 = negm; sn1 = negm; \
            const LAS unsigned char* vp = lds + VOFF + (kt_ & 1) * VS_BYTES + r * VS_STRIDE + hh * 16; \
            u32x4 vf[8]; \
            _Pragma("unroll") \
            for (int s2 = 0; s2 < 4; ++s2) { vf[2 * s2] = *(const LAS u32x4*)(vp + 32 * s2); vf[2 * s2 + 1] = *(const LAS u32x4*)(vp + 32 * VS_STRIDE + 32 * s2); } \
            _Pragma("unroll") \
            for (int s = 0; s < 6; ++s) { \
                sn0 = __builtin_amdgcn_mfma_f32_32x32x16_bf16(kf[2 * s], qf[s], sn0, 0, 0, 0); \
                sn1 = __builtin_amdgcn_mfma_f32_32x32x16_bf16(kf[2 * s + 1], qf[s], sn1, 0, 0, 0); } \
            \
            float ps = 0.f; \
            _Pragma("unroll") \
            for (int i = 0; i < 16; ++i) { sc0[i] = __builtin_amdgcn_exp2f(sc0[i]); sc1[i] = __builtin_amdgcn_exp2f(sc1[i]); ps += sc0[i] + sc1[i]; } \
            lrun += ps; \
            _Pragma("unroll") \
            for (int s2 = 0; s2 < 4; ++s2) { \
                u32x4 pw; \
                if (s2 < 2) { const int e = 8 * (s2 & 1); pw.x = pk2(sc0[e], sc0[e + 1]); pw.y = pk2(sc0[e + 2], sc0[e + 3]); pw.z = pk2(sc0[e + 4], sc0[e + 5]); pw.w = pk2(sc0[e + 6], sc0[e + 7]); } \
                else { const int e = 8 * (s2 & 1); pw.x = pk2(sc1[e], sc1[e + 1]); pw.y = pk2(sc1[e + 2], sc1[e + 3]); pw.z = pk2(sc1[e + 4], sc1[e + 5]); pw.w = pk2(sc1[e + 6], sc1[e + 7]); } \
                const bf16x8 pf = __builtin_bit_cast(bf16x8, pw); \
                o0 = __builtin_amdgcn_mfma_f32_32x32x16_bf16(__builtin_bit_cast(bf16x8, vf[2 * s2]), pf, o0, 0, 0, 0); \
                o1 = __builtin_amdgcn_mfma_f32_32x32x16_bf16(__builtin_bit_cast(bf16x8, vf[2 * s2 + 1]), pf, o1, 0, 0, 0); } \
            if ((kt_) + 2 < NKT) { *(LAS u32x4*)(lds + ((kt_) & 1) * KS_BYTES + lkn) = WKN; if (tid < 256) *(LAS u32x4*)(lds + ((kt_) & 1) * KS_BYTES + lkr) = WKR; } \
            if ((kt_) + 1 < NKT) { *(LAS u32x2*)(lds + (((kt_) + 1) & 1) * VS_BYTES + lvt) = (u32x2){WVT.x, WVT.y}; *(LAS u32x2*)(lds + (((kt_) + 1) & 1) * VS_BYTES + lvt + 16) = (u32x2){WVT.z, WVT.w}; } \
            __syncthreads(); \
            } while (0)
DI void attn_phase(LAS unsigned char* lds, const int wid, const bf16_t* Q, const bf16_t* Kn, const bf16_t* Kr, const bf16_t* Vt, bf16_t* O, int G, int c) {
    const int lane = lane_id(), tid = wid * 64 + lane, r = lane & 31, hh = lane >> 5;
    for (int it = 0;; ++it) {
        const long L = (long)it * G + c; if (L >= 2048) break;
        const int xcd = (int)(L & 7), idx = (int)(L >> 3), bh = (idx >> 5) * 8 + xcd, qb = idx & 31, b = bh >> 3, h = bh & 7;
        const size_t tok0 = (size_t)b * SEQ;
        const int q0 = qb * 256 + wid * 32;
        bf16x8 qf[6];
        { const bf16_t* qp = Q + (tok0 + q0 + r) * 768 + h * 96 + 8 * hh;
#pragma unroll
          for (int s = 0; s < 6; ++s) qf[s] = *(const bf16x8*)(qp + 16 * s); }
        f32x16 o0, o1, negm;
#pragma unroll
        for (int i = 0; i < 16; ++i) { o0[i] = 0.f; o1[i] = 0.f; negm[i] = 0.f; }
        float lrun = 0.f;
        const int skey = tid >> 3, sch = tid & 7;
        const int rkey = (tid & 255) >> 2, rch = tid & 3;
        const bf16_t* gkn = Kn + (tok0 + skey) * 512 + h * 64 + sch * 8;
        const bf16_t* gkr = Kr + (tok0 + rkey) * 32 + rch * 8;
        const bf16_t* gvt = Vt + (size_t)(h * 64 + skey) * T + tok0 + sch * 8;
        const unsigned lkn = skey * KS_STRIDE + sch * 16, lkr = rkey * KS_STRIDE + 128 + rch * 16, lvt = VOFF + skey * VS_STRIDE + (sch >> 1) * 32 + (sch & 1) * 8;
        u32x4 rkn = *(const u32x4*)gkn, rvt = *(const u32x4*)gvt, rkr = {0u, 0u, 0u, 0u};
        if (tid < 256) rkr = *(const u32x4*)gkr;
        *(LAS u32x4*)(lds + lkn) = rkn; *(LAS u32x2*)(lds + lvt) = (u32x2){rvt.x, rvt.y}; *(LAS u32x2*)(lds + lvt + 16) = (u32x2){rvt.z, rvt.w}; if (tid < 256) *(LAS u32x4*)(lds + lkr) = rkr;
        rkn = *(const u32x4*)(gkn + 64 * 512); if (tid < 256) rkr = *(const u32x4*)(gkr + 64 * 32);
        *(LAS u32x4*)(lds + KS_BYTES + lkn) = rkn; if (tid < 256) *(LAS u32x4*)(lds + KS_BYTES + lkr) = rkr;
        __syncthreads();
        f32x16 sc0 = negm, sc1 = negm, sd0, sd1;
        { const LAS unsigned char* kp = lds + r * KS_STRIDE + hh * 16;
#pragma unroll
          for (int s = 0; s < 6; ++s) {
              const bf16x8 k0 = *(const LAS bf16x8*)(kp + s * 32), k1 = *(const LAS bf16x8*)(kp + 32 * KS_STRIDE + s * 32);
              sc0 = __builtin_amdgcn_mfma_f32_32x32x16_bf16(k0, qf[s], sc0, 0, 0, 0);
              sc1 = __builtin_amdgcn_mfma_f32_32x32x16_bf16(k1, qf[s], sc1, 0, 0, 0); } }
        __syncthreads();
        u32x4 akn = *(const u32x4*)(gkn + (size_t)2 * 64 * 512), avt = *(const u32x4*)(gvt + 64), akr = {0u, 0u, 0u, 0u}, bkn, bkr = {0u, 0u, 0u, 0u}, bvt;
        if (tid < 256) akr = *(const u32x4*)(gkr + (size_t)2 * 64 * 32);
        for (int kt = 0; kt < NKT; kt += 2) {
            ATT_STEP(kt, bkn, bkr, bvt, akn, akr, avt, sc0, sc1, sd0, sd1);
            ATT_STEP(kt + 1, akn, akr, avt, bkn, bkr, bvt, sd0, sd1, sc0, sc1);
        }
        lrun += __shfl_xor(lrun, 32);
        const float inv = 1.0f / lrun;
        bf16_t* op = O + (tok0 + q0 + r) * 512 + h * 64 + 4 * hh;
#pragma unroll
        for (int gq = 0; gq < 4; ++gq) {
            u32x2 w0, w1;
            w0.x = pk2(o0[4 * gq] * inv, o0[4 * gq + 1] * inv); w0.y = pk2(o0[4 * gq + 2] * inv, o0[4 * gq + 3] * inv);
            w1.x = pk2(o1[4 * gq] * inv, o1[4 * gq + 1] * inv); w1.y = pk2(o1[4 * gq + 2] * inv, o1[4 * gq + 3] * inv);
            *(u32x2*)(op + 8 * gq) = w0; *(u32x2*)(op + 32 + 8 * gq) = w1; }
    }
}

#define XB_TMO      128
#define XB_XCNT(j)  (256  + 64 * (j))
#define XB_XSUB(j)  (1280 + 64 * (j))
#define XB_XGEN(j)  (2304 + 64 * (j))
#define XB_TOP      3328
#define XB_TOPGEN   3392
#define XCD_BAR_WORDS 3456
#define XB_SPIN_CAP (1u << 18)

__device__ __forceinline__ unsigned xb_ld(unsigned* p)              { return __hip_atomic_load(p, __ATOMIC_RELAXED, __HIP_MEMORY_SCOPE_AGENT); }
__device__ __forceinline__ unsigned xb_add(unsigned* p, unsigned v) { return __hip_atomic_fetch_add(p, v, __ATOMIC_RELAXED, __HIP_MEMORY_SCOPE_AGENT); }
__device__ __forceinline__ unsigned xb_xcc_id() { return (unsigned)__builtin_amdgcn_s_getreg((3 << 11) | 20) & 0xFu; }
#define XB_SPIN(cond, bar) do { unsigned _sp = 0; while (cond) { __builtin_amdgcn_s_sleep(1); \
    if ((++_sp & 255u) == 0u) { if (xb_ld(&(bar)[XB_TMO])) break; if (_sp > XB_SPIN_CAP) { atomicAdd(&(bar)[XB_TMO], 1u); break; } } } } while (0)

struct XcdBarrier {
    unsigned* bar; unsigned x;
    volatile LAS unsigned* st;
};

__device__ __forceinline__ XcdBarrier xcd_barrier_post(unsigned* bar, volatile LAS unsigned* st, const bool t0) {
    XcdBarrier b; b.bar = bar; b.x = xb_xcc_id(); b.st = st;
    if (t0) (void)xb_add(&bar[XB_XCNT(b.x)], 1u);
    return b;
}
__device__ __forceinline__ void xcd_barrier_complete(unsigned* bar, unsigned x, unsigned& nloc, unsigned& nx) {
    const unsigned G = gridDim.x * gridDim.y * gridDim.z;
    unsigned sum, cnt, mine, sp = 0u;
    for (;;) {
        sum = 0u; cnt = 0u; mine = 0u;
#pragma unroll
        for (unsigned j = 0; j < 16; ++j) { const unsigned c = xb_ld(&bar[XB_XCNT(j)]); sum += c; cnt += (c > 0u) ? 1u : 0u; mine = (j == x) ? c : mine; }
        if (sum == G) break;
        __builtin_amdgcn_s_sleep(1);
        if ((++sp & 255u) == 0u) { if (xb_ld(&bar[XB_TMO])) break; if (sp > XB_SPIN_CAP) { atomicAdd(&bar[XB_TMO], 1u); break; } }
    }
    nloc = mine > 0u ? mine : 1u; nx = cnt > 0u ? cnt : 1u;
}

__device__ __forceinline__ void xcd_barrier(const XcdBarrier& b, const bool t0) {
    asm volatile("s_waitcnt vmcnt(0)" ::: "memory");
    __syncthreads();
    if (t0) {
        unsigned* bar = b.bar;
        __builtin_amdgcn_s_waitcnt(0);
        unsigned nloc = b.st[0], nx = b.st[1];
        if (nloc == 0u) { xcd_barrier_complete(bar, b.x, nloc, nx); b.st[0] = nloc; b.st[1] = nx; }
        const unsigned old = xb_add(&bar[XB_XSUB(b.x)], 1u);
        const unsigned gen = old / nloc;
        if (old + 1u == (gen + 1u) * nloc) {
            __builtin_amdgcn_fence(__ATOMIC_RELEASE, "agent");
            asm volatile("s_waitcnt vmcnt(0)" ::: "memory");
            const unsigned og = xb_add(&bar[XB_TOP], 1u);
            const unsigned tg = og / nx;
            if (og + 1u == (tg + 1u) * nx) xb_add(&bar[XB_TOPGEN], 1u);
            else XB_SPIN(xb_ld(&bar[XB_TOPGEN]) == tg, bar);
            __builtin_amdgcn_fence(__ATOMIC_ACQUIRE, "agent");
            xb_add(&bar[XB_XGEN(b.x)], 1u);
            asm volatile("s_waitcnt vmcnt(0)" ::: "memory");
        } else {
            XB_SPIN(xb_ld(&bar[XB_XGEN(b.x)]) == gen, bar);
            __builtin_amdgcn_fence(__ATOMIC_ACQUIRE, "agent");
            asm volatile("s_waitcnt vmcnt(0)" ::: "memory");
        }
    }
    __syncthreads();
}

constexpr int LDS_BYTES = 147456;
#define WSB(off) ((bf16_t*)(KWS + (off)))
#define WSF(off) ((float*)(KWS + (off)))
#define SSQ(k) (WSF(O_SSQ) + (size_t)(k) * T)
__global__ void __launch_bounds__(512, 2) fwd_megakernel(Args args_unused) {
    extern __shared__ __attribute__((aligned(16))) unsigned char lds_raw[];
    LAS unsigned char* lds = (LAS unsigned char*)lds_raw;
    cg::grid_group grid = cg::this_grid();
    const int wid_s = __builtin_amdgcn_readfirstlane((int)threadIdx.x >> 6);
#define BAR_ST ((volatile LAS unsigned*)(lds + 131072 + 64))
#define T0 (wid_s == 0 && lane_id() == 0)
    if (T0) { BAR_ST[0] = 0u; BAR_ST[1] = 0u; }
    __syncthreads();
    (void)xcd_barrier_post((unsigned*)(KWS + O_CTL), BAR_ST, T0);
#define GRID_BAR() do { XcdBarrier b_; b_.bar = (unsigned*)(KWS + O_CTL); b_.x = xb_xcc_id(); b_.st = BAR_ST; xcd_barrier(b_, T0); } while (0)
#define TID (wid_s * 64 + lane_id())
#define LANE (lane_id())
#define WID (wid_s)
#define GG ((int)gridDim.x)
#define CC ((int)blockIdx.x)
#define GW (CC * 8 + WID)
#define NGW (GG * 8)
#define GT ((long)CC * 512 + TID)
#define NGT ((long)GG * 512)

    {
        { float* z = SSQ(1); for (long i = GT; i < 5L * T; i += NGT) z[i] = 0.f; }
        { const float* x = INF(I_X); bf16_t* hb = WSB(O_HB); float* ssq1 = SSQ(0); const int lane = LANE;
          for (int row = GW; row < T; row += NGW) {
            const f32x4* xr = (const f32x4*)(x + (size_t)row * D) + lane; f32x4 v[4]; float s = 0.f;
#pragma unroll
            for (int j = 0; j < 4; ++j) { v[j] = xr[64 * j]; s += (v[j][0] * v[j][0] + v[j][1] * v[j][1]) + (v[j][2] * v[j][2] + v[j][3] * v[j][3]); }
            s = wave_sum(s); if (lane == 0) ssq1[row] = s;
            u32x2* o8 = (u32x2*)(hb + (size_t)row * D) + lane;
#pragma unroll
            for (int j = 0; j < 4; ++j) { u32x2 w; w.x = pk2(v[j][0], v[j][1]); w.y = pk2(v[j][2], v[j][3]); o8[64 * j] = w; }
          } }
        { const int* pos = (const int*)karg(I_POS); f32x2* rope = (f32x2*)(KWS + O_ROPE);
          for (long i = GT; i < (long)T * 16; i += NGT) { const int t = (int)(i >> 4), fi = (int)(i & 15);
            const float invf = (float)exp2(-(double)fi * 0.83048202372184058696); const float ang = (float)pos[t] * invf;
            rope[i] = (f32x2){cosf(ang), sinf(ang)}; } }
        {
            const int lane = LANE; LAS float* scr = (LAS float*)(lds + WID * 16384);
            constexpr int I_GU = 16 * 176, I_D = 44 * 32, I_IN = 16 * 96, I_UQ = 4 * 24, I_UK = 2 * 16, I_OA = 8 * 32, I_OUT = 16 * 32;
            constexpr int NITEMS = 2 * I_GU + 2 * I_D + I_IN + I_UQ + 2 * I_UK + 3 * I_OA + I_OUT;
            for (int it = GW; it < NITEMS; it += NGW) {
                int r = it;
                if (r < I_GU) { prep_item(FGateUp{INF(I_WG1), INF(I_WU1), INF(I_N1)}, D, 176, WSB(O_WGU1), scr, r, lane); continue; } r -= I_GU;
                if (r < I_GU) { prep_item(FGateUp{INF(I_WG2), INF(I_WU2), INF(I_N2)}, D, 176, WSB(O_WGU2), scr, r, lane); continue; } r -= I_GU;
                if (r < I_D) { prep_item(FPlain{INF(I_WD1), D}, FF, 32, WSB(O_WD1), scr, r, lane); continue; } r -= I_D;
                if (r < I_D) { prep_item(FPlain{INF(I_WD2), D}, FF, 32, WSB(O_WD2), scr, r, lane); continue; } r -= I_D;
                if (r < I_IN) { prep_item(FWin{INF(I_WIN), INF(I_NMIX)}, D, 96, WSB(O_WIN), scr, r, lane); continue; } r -= I_IN;
                if (r < I_UQ) { prep_item(FWuq{INF(I_WUQ), INF(I_QN)}, 256, 24, WSB(O_WUQ), scr, r, lane); continue; } r -= I_UQ;
                if (r < I_UK) { prep_item(FWukv{INF(I_WUKV), INF(I_KVN), 0}, 128, 16, WSB(O_WUK), scr, r, lane); continue; } r -= I_UK;
                if (r < I_UK) { prep_item(FWukv{INF(I_WUKV), INF(I_KVN), 64}, 128, 16, WSB(O_WUV), scr, r, lane); continue; } r -= I_UK;
                if (r < I_OA) { prep_item(FPlain{INF(I_WOA), D}, 512, 32, WSB(O_WOA), scr, r, lane); continue; } r -= I_OA;
                if (r < I_OA) { prep_item(FWglu{INF(I_WGLU)}, 512, 32, WSB(O_WGLU), scr, r, lane); continue; } r -= I_OA;
                if (r < I_OA) { prep_item(FPlain{INF(I_WOS), D}, 512, 32, WSB(O_WOS), scr, r, lane); continue; } r -= I_OA;
                prep_item(FPlain{INF(I_WOUT), D}, D, 32, WSB(O_WOUT), scr, r, lane);
            }
        }
        { const float *ilre = INF(I_LRE), *ilim = INF(I_LIM), *ildt = INF(I_LDT), *ibre = INF(I_BRE), *ibim = INF(I_BIM), *icre = INF(I_CRE), *icim = INF(I_CIM); float* kt = WSF(O_KT);
          for (long it = GT; it < 131072; it += NGT) {
            const int pq = (int)it & 3, i = ((int)it >> 2) & 15, d = ((int)it >> 6) & 31, dir = ((int)it >> 11) & 1, g = (int)it >> 12, dg = dir * 32 + g;
            const float dt = expf(ildt[dg]); float a16[16];
#pragma unroll
            for (int q = 0; q < 16; ++q) a16[q] = 0.f;
            for (int p = pq * 16; p < pq * 16 + 16; ++p) {
                const float lre = ilre[dg * 64 + p], lim = ilim[dg * 64 + p]; float kr_, ki_, pr, pi;
                lam_kfac(lre, lim, dt, kr_, ki_); lam_pow(lre, lim, dt, (float)d, pr, pi);
                const float cr = icre[(dg * 16 + i) * 64 + p], ci = icim[(dg * 16 + i) * 64 + p];
                const float tr = cr * pr - ci * pi, ti = cr * pi + ci * pr, gr = tr * kr_ - ti * ki_, gi = tr * ki_ + ti * kr_;
                const f32x4* br = (const f32x4*)(ibre + (size_t)(dg * 64 + p) * 16); const f32x4* bi = (const f32x4*)(ibim + (size_t)(dg * 64 + p) * 16);
#pragma unroll
                for (int q = 0; q < 4; ++q) { const f32x4 x = br[q], y = bi[q];
#pragma unroll
                    for (int e = 0; e < 4; ++e) a16[4 * q + e] += gr * x[e] - gi * y[e]; }
            }
#pragma unroll
            for (int q = 0; q < 16; ++q) { a16[q] += __shfl_xor(a16[q], 1); a16[q] += __shfl_xor(a16[q], 2); }
            f32x4* o = (f32x4*)(kt + ((size_t)(g * 2 + dir) * 32 + d) * 256 + i * 16);
            if (pq == 0) {
#pragma unroll
            for (int q = 0; q < 4; ++q) o[q] = (f32x4){a16[4 * q], a16[4 * q + 1], a16[4 * q + 2], a16[4 * q + 3]}; }
          }
          bf16_t* wst = WSB(O_WST);
          for (long it = GT; it < 262144; it += NGT) {
            const int j = (int)it & 31, n = ((int)it >> 5) & 255, g = (int)it >> 13, dir = n >> 7, p = (n & 127) >> 1, ri = n & 1, dg = dir * 32 + g;
            const float dt = expf(ildt[dg]), lre = ilre[dg * 64 + p], lim = ilim[dg * 64 + p]; float kr_, ki_, pr, pi;
            lam_kfac(lre, lim, dt, kr_, ki_); lam_pow(lre, lim, dt, (float)(dir == 0 ? 31 - j : j), pr, pi);
            const float gr = pr * kr_ - pi * ki_, gi = pr * ki_ + pi * kr_;
            const f32x4* br = (const f32x4*)(ibre + (size_t)(dg * 64 + p) * 16); const f32x4* bi = (const f32x4*)(ibim + (size_t)(dg * 64 + p) * 16);
            f32x4 v[4];
#pragma unroll
            for (int q = 0; q < 4; ++q) { const f32x4 x = br[q], y = bi[q]; v[q] = ri ? (gr * y + gi * x) : (gr * x - gi * y); }
            u32x4* o = (u32x4*)(wst + ((size_t)g * 256 + n) * 512 + j * 16);
            o[0] = pack8(v[0], v[1]); o[1] = pack8(v[2], v[3]);
          }
          bf16_t* wss2 = WSB(O_WSS2);
          for (long it = GT; it < 262144; it += NGT) {
            const int pc = (int)it & 7, dir = ((int)it >> 3) & 1, n = ((int)it >> 4) & 511, g = (int)it >> 13, tau = n >> 4, i = n & 15, dg = dir * 32 + g;
            const float dt = expf(ildt[dg]), e = (float)(dir == 0 ? tau + 1 : 32 - tau); float v[16];
#pragma unroll
            for (int q = 0; q < 8; ++q) { const int p = pc * 8 + q; float pr, pi; lam_pow(ilre[dg * 64 + p], ilim[dg * 64 + p], dt, e, pr, pi);
                const float cr = icre[(dg * 16 + i) * 64 + p], ci = icim[(dg * 16 + i) * 64 + p];
                v[2 * q] = cr * pr - ci * pi; v[2 * q + 1] = -(cr * pi + ci * pr); }
            u32x4* o = (u32x4*)(wss2 + ((size_t)g * 512 + n) * KP + 512 + dir * 128 + pc * 16);
            u32x4 w0, w1; w0.x = pk2(v[0], v[1]); w0.y = pk2(v[2], v[3]); w0.z = pk2(v[4], v[5]); w0.w = pk2(v[6], v[7]); w1.x = pk2(v[8], v[9]); w1.y = pk2(v[10], v[11]); w1.z = pk2(v[12], v[13]); w1.w = pk2(v[14], v[15]);
            o[0] = w0; o[1] = w1;
          }
          float* al = WSF(O_AL);
          for (long it = GT; it < 4096; it += NGT) { const int p = (int)it & 63, dir = ((int)it >> 6) & 1, g = (int)it >> 7, dg = dir * 32 + g; float pr, pi;
            lam_pow(ilre[dg * 64 + p], ilim[dg * 64 + p], expf(ildt[dg]), 32.0f, pr, pi); al[it * 2] = pr; al[it * 2 + 1] = pi; }
        }
    }
    if (GG == 0x7fffffff) grid.sync();
    GRID_BAR();

    { const float* kt = WSF(O_KT); const float* dsk = INF(I_DSK); bf16_t* wss2 = WSB(O_WSS2);
      for (long it = GT; it < 524288; it += NGT) {
        const int j = (int)it & 31, n = ((int)it >> 5) & 511, g = (int)it >> 14, tau = n >> 4, i = n & 15;
        f32x4 v[4];
#pragma unroll
        for (int q = 0; q < 4; ++q) v[q] = (f32x4){0.f, 0.f, 0.f, 0.f};
        if (j <= tau) { const f32x4* s = (const f32x4*)(kt + ((size_t)(g * 2 + 0) * 32 + (tau - j)) * 256 + i * 16);
#pragma unroll
            for (int q = 0; q < 4; ++q) v[q] += s[q]; }
        if (j >= tau) { const f32x4* s = (const f32x4*)(kt + ((size_t)(g * 2 + 1) * 32 + (j - tau)) * 256 + i * 16);
#pragma unroll
            for (int q = 0; q < 4; ++q) v[q] += s[q]; }
        if (j == tau) { const float dv = dsk[g * 16 + i];
#pragma unroll
            for (int q = 0; q < 4; ++q)
#pragma unroll
                for (int e = 0; e < 4; ++e) if (4 * q + e == i) v[q][e] += dv; }
        u32x4* o = (u32x4*)(wss2 + ((size_t)g * 512 + n) * KP + j * 16);
        o[0] = pack8(v[0], v[1]); o[1] = pack8(v[2], v[3]);
      } }
    { pg8::Gemm g{WSB(O_HB), WSB(O_WGU1), D, D, D, 0, 0}; pg8::Order S; S.init(T / 256, 22, 1, GG, CC); EpiSwiglu E{SSQ(0), WSB(O_ACT)}; pg8::gemm_phase(lds, wid_s, g, S, E); }
    GRID_BAR();
    { pg8::Gemm g{WSB(O_ACT), WSB(O_WD1), FF, FF, FF, 0, 0}; pg8::Order S; S.init(T / 256, 4, 1, GG, CC); EpiResid E{INF(I_X), WSF(O_H), 0.5f, WSB(O_HB), SSQ(1)}; pg8::gemm_phase(lds, wid_s, g, S, E); }
    GRID_BAR();
    { pg8::Gemm g{WSB(O_HB), WSB(O_WIN), D, D, D, 0, 0}; pg8::Order S; S.init(T / 256, 12, 1, GG, CC); EpiWin E{SSQ(0), (const f32x2*)(KWS + O_ROPE), KWS, (bf16_t*)KOUT}; pg8::gemm_phase(lds, wid_s, g, S, E); }
    GRID_BAR();
    { pg8::Gemm g{WSB(O_CQ), WSB(O_WUQ), 256, 256, 256, 0, 0}; pg8::Order S; S.init(T / 256, 3, 1, GG, CC); EpiQ E{SSQ(2), (const f32x2*)(KWS + O_ROPE), WSB(O_Q)}; pg8::gemm_phase(lds, wid_s, g, S, E); }
    { pg8::Gemm g{WSB(O_CKV), WSB(O_WUK), 128, 128, 128, 0, 0}; pg8::Order S; S.init(T / 256, 2, 1, GG, CC); EpiRowScale E{SSQ(3), 1.0f / 128, WSB(O_KN), 512}; pg8::gemm_phase(lds, wid_s, g, S, E); }
    { pg8::Gemm g{WSB(O_WUV), WSB(O_CKV), 128, 128, 128, 0, 0}; pg8::Order S; S.init(2, T / 256, 1, GG, CC); EpiVt E{SSQ(3), WSB(O_VT)}; pg8::gemm_phase(lds, wid_s, g, S, E); }
    { pg8::Gemm g{WSB(O_APACK), WSB(O_WST), KP, 512, 512, (size_t)MG * KP, (size_t)256 * 512}; pg8::Order S; S.init(MG / 256, 1, 32, GG, CC); EpiSloc E{WSF(O_SLOC)}; pg8::gemm_phase(lds, wid_s, g, S, E); }
    GRID_BAR();
    { const float* al = WSF(O_AL); const float* sloc = WSF(O_SLOC); bf16_t* apack = WSB(O_APACK); const int G = GG;
      for (int it = WID * G + CC; it < 512; it += 8 * G) {
        const int dir = it & 1, g = (it >> 1) & 31, b = it >> 6, p = LANE;
        const float ar = al[((g * 2 + dir) * 64 + p) * 2], ai_ = al[((g * 2 + dir) * 64 + p) * 2 + 1];
        float hr = 0.f, hi = 0.f;
        for (int c0 = 0; c0 < NCH; c0 += 32) {
            f32x2 s[32];
#pragma unroll
            for (int e = 0; e < 32; ++e) { const int cc = dir ? NCH - 1 - (c0 + e) : c0 + e; s[e] = *(const f32x2*)(sloc + ((size_t)g * MG + b * NCH + cc) * 256 + dir * 128 + 2 * p); }
#pragma unroll
            for (int e = 0; e < 32; ++e) { const int cc = dir ? NCH - 1 - (c0 + e) : c0 + e;
                *(unsigned*)(apack + ((size_t)g * MG + b * NCH + cc) * KP + 512 + dir * 128 + 2 * p) = pk2(hr, hi);
                const float nr = ar * hr - ai_ * hi + s[e][0], ni = ar * hi + ai_ * hr + s[e][1]; hr = nr; hi = ni; }
        }
      } }
    attn_phase(lds, wid_s, WSB(O_Q), WSB(O_KN), WSB(O_KR), WSB(O_VT), WSB(O_ATTN), GG, CC);
    GRID_BAR();
    { pg8::Gemm g{WSB(O_APACK), WSB(O_WSS2), KP, KP, KP, (size_t)MG * KP, (size_t)512 * KP}; pg8::Order S; S.init(MG / 256, 2, 32, GG, CC); EpiSsmOut E{WSB(O_GY)}; pg8::gemm_phase(lds, wid_s, g, S, E); }
    { pg8::Gemm g{WSB(O_ATTN), WSB(O_WOA), 512, 512, 512, 0, 0}; pg8::Order S; S.init(T / 256, 4, 1, GG, CC); EpiGate<0> E{(const bf16_t*)KOUT, nullptr, WSB(O_MRG)}; pg8::gemm_phase(lds, wid_s, g, S, E); }
    GRID_BAR();
    { pg8::Gemm g{WSB(O_GY), WSB(O_WGLU), 512, 512, 512, 0, 0}; pg8::Order S; S.init(T / 256, 4, 1, GG, CC); EpiGlu E{INF(I_BGLU), WSB(O_SO)}; pg8::gemm_phase(lds, wid_s, g, S, E); }
    GRID_BAR();
    { pg8::Gemm g{WSB(O_SO), WSB(O_WOS), 512, 512, 512, 0, 0}; pg8::Order S; S.init(T / 256, 4, 1, GG, CC); EpiGate<1> E{(const bf16_t*)KOUT + (size_t)T * D, WSB(O_MRG), WSB(O_MG)}; pg8::gemm_phase(lds, wid_s, g, S, E); }
    GRID_BAR();
    { pg8::Gemm g{WSB(O_MG), WSB(O_WOUT), D, D, D, 0, 0}; pg8::Order S; S.init(T / 256, 4, 1, GG, CC); EpiResid E{WSF(O_H), WSF(O_H), 1.0f, WSB(O_HB), SSQ(4)}; pg8::gemm_phase(lds, wid_s, g, S, E); }
    GRID_BAR();
    { pg8::Gemm g{WSB(O_HB), WSB(O_WGU2), D, D, D, 0, 0}; pg8::Order S; S.init(T / 256, 22, 1, GG, CC); EpiSwiglu E{SSQ(4), WSB(O_ACT)}; pg8::gemm_phase(lds, wid_s, g, S, E); }
    GRID_BAR();
    if (GG == 256) {
        pg8::Gemm g{WSB(O_ACT), WSB(O_WD2), FF, FF, FF, 0, 0}; pg8::Order S; S.init(T / 256, 4, 1, GG, CC); EpiResidNorm E{WSF(O_H), KOUT, 0.5f, SSQ(5), (unsigned*)(KWS + O_PCNT), INF(I_NF)}; pg8::gemm_phase(lds, wid_s, g, S, E);
    } else {
    { pg8::Gemm g{WSB(O_ACT), WSB(O_WD2), FF, FF, FF, 0, 0}; pg8::Order S; S.init(T / 256, 4, 1, GG, CC); EpiResid E{WSF(O_H), KOUT, 0.5f, nullptr, SSQ(5)}; pg8::gemm_phase(lds, wid_s, g, S, E); }
    GRID_BAR();
    { const float* ssq4 = SSQ(5); float* out = KOUT; const f32x4* gn = (const f32x4*)INF(I_NF) + LANE; const int lane = LANE;
      for (int row = GW; row < T; row += NGW) {
        const float r = rstd_of(ssq4[row], 1.0f / D);
        f32x4* o = (f32x4*)(out + (size_t)row * D) + lane;
#pragma unroll
        for (int j = 0; j < 4; ++j) o[64 * j] = o[64 * j] * r * gn[64 * j];
      } }
    }
}

extern "C" void kernel_launch(void* const* d_in, const int* in_sizes, int n_in, void* d_out, int out_size, void* d_ws, size_t ws_size, hipStream_t stream) {
    static int grid = 0;
    if (grid == 0) {
        if (n_in != 30 || out_size != T * D || ws_size < WS_NEED) { fprintf(stderr, "kernel_launch: unexpected problem (n_in %d, out %d, ws %zu)\n", n_in, out_size, ws_size); grid = -1; return; }
        int dev = 0, cus = 0, per_cu = 0;
        (void)hipGetDevice(&dev); (void)hipDeviceGetAttribute(&cus, hipDeviceAttributeMultiprocessorCount, dev);
        if (hipFuncSetAttribute((const void*)fwd_megakernel, hipFuncAttributeMaxDynamicSharedMemorySize, LDS_BYTES) != hipSuccess) { fprintf(stderr, "kernel_launch: hipFuncSetAttribute failed\n"); grid = -1; return; }
        if (hipOccupancyMaxActiveBlocksPerMultiprocessor(&per_cu, (const void*)fwd_megakernel, 512, LDS_BYTES) != hipSuccess || per_cu < 1) { fprintf(stderr, "kernel_launch: occupancy query gave %d\n", per_cu); per_cu = 1; }
        (void)hipGetLastError();
        grid = cus * per_cu; if (grid > 256) grid = 256; grid &= ~7; if (grid < 8) grid = 8;
    }
    if (grid < 0) return;
    if (hipMemsetAsync((char*)d_ws + O_CTL, 0, CTL_BYTES, stream) != hipSuccess) { fprintf(stderr, "kernel_launch: memset of the barrier words failed\n"); return; }
    Args a{};
    for (int i = 0; i < 30; ++i) a.in[i] = d_in[i];
    a.out = (float*)d_out; a.ws = (unsigned char*)d_ws;
    void* kargs[] = {&a};
    hipError_t e = hipLaunchCooperativeKernel((const void*)fwd_megakernel, dim3(grid), dim3(512), kargs, LDS_BYTES, stream);
    if (e != hipSuccess) fprintf(stderr, "cooperative launch failed: %s (grid %d)\n", hipGetErrorString(e), grid);
}
```

```cpp
#include <hip/hip_runtime.h>
#include <hip/hip_cooperative_groups.h>
#include <cstdio>
#include <cstdint>
namespace cg = cooperative_groups;

#define LAS __attribute__((address_space(3)))
#define DI __device__ __forceinline__
typedef unsigned short bf16_t;
typedef short bf16x8 __attribute__((ext_vector_type(8)));
typedef short s16x4 __attribute__((ext_vector_type(4)));
typedef float f32x2 __attribute__((ext_vector_type(2)));
typedef float f32x4 __attribute__((ext_vector_type(4)));
typedef float f32x16 __attribute__((ext_vector_type(16)));
typedef unsigned u32x2 __attribute__((ext_vector_type(2)));
typedef unsigned u32x4 __attribute__((ext_vector_type(4)));
typedef __bf16 bf16x2_t __attribute__((ext_vector_type(2)));

constexpr int NB = 8, SEQ = 8192, T = NB * SEQ, D = 1024, FF = 2816, NH = 8;
constexpr int NIN = 3072;
constexpr int CL = 32, NCH = SEQ / CL;
constexpr int MG = T / CL;
constexpr int KP = 768;
constexpr float EPS = 1e-6f;
constexpr float QSCALE = 0.14724438f;

constexpr size_t MiB = 1u << 20, QM = MiB / 4;
constexpr size_t O_WGU1 = 0, O_WD1 = 11 * MiB, O_WGU2 = O_WD1 + 22 * QM, O_WD2 = O_WGU2 + 11 * MiB, O_WIN = O_WD2 + 22 * QM;
constexpr size_t O_WUQ = O_WIN + 6 * MiB, O_WUK = O_WUQ + 2 * QM, O_WUV = O_WUK + QM, O_WOA = O_WUV + QM, O_WGLU = O_WOA + MiB, O_WOS = O_WGLU + MiB, O_WOUT = O_WOS + MiB;
constexpr size_t O_WST = O_WOUT + 2 * MiB, O_WSS2 = O_WST + 8 * MiB, O_KT = O_WSS2 + 24 * MiB, O_AL = O_KT + 2 * MiB, O_SSQ = O_AL + QM;
constexpr size_t O_ROPE = O_SSQ + 6 * QM, O_HB = O_ROPE + 8 * MiB, O_H = O_HB + 128 * MiB, O_ACT = O_H + 256 * MiB, O_R4 = O_ACT + 352 * MiB;
constexpr size_t O_CQ = O_ACT, O_CKV = O_CQ + 32 * MiB, O_KR = O_CKV + 16 * MiB, O_APACK = O_KR + 4 * MiB, O_Q = O_APACK + 96 * MiB, O_KN = O_Q + 96 * MiB;
constexpr size_t O_MG = O_Q, O_MRG = O_HB;
constexpr size_t O_VT = O_R4, O_SLOC = O_VT + 64 * MiB, O_ATTN = O_SLOC + 64 * MiB, O_END = O_ATTN + 64 * MiB, O_GY = O_VT, O_SO = O_SLOC;
static_assert(O_KN + 64 * MiB <= O_R4, "act overlay");
constexpr size_t O_CTL = O_END, CTL_BYTES = 32768, O_PCNT = O_CTL + 16384, WS_NEED = O_CTL + CTL_BYTES;
static_assert(WS_NEED <= 1024 * MiB, "workspace");
static_assert(O_WIN == 33 * MiB && O_ROPE % 256 == 0 && O_HB % 256 == 0, "map");

DI unsigned pk2(float lo, float hi) { f32x2 v = {lo, hi}; bf16x2_t b = __builtin_convertvector(v, bf16x2_t); return __builtin_bit_cast(unsigned, b); }
DI float bflo(unsigned u) { return __builtin_bit_cast(float, u << 16); }
DI float bfhi(unsigned u) { return __builtin_bit_cast(float, u & 0xffff0000u); }
DI float sigm(float x) { return __builtin_amdgcn_rcpf(1.0f + __expf(-x)); }
DI float silu(float x) { return x * sigm(x); }
DI float gelu_tanh(float x) { const float z = 1.5957691216f * (x + 0.044715f * x * x * x); return x * sigm(z); }
DI float wave_sum(float v) {
#pragma unroll
    for (int o = 1; o < 64; o <<= 1) v += __shfl_xor(v, o);
    return v;
}
DI int lane_id() { int l; asm volatile("v_mbcnt_lo_u32_b32 %0, -1, 0\n\tv_mbcnt_hi_u32_b32 %0, -1, %0" : "=v"(l)); return l; }
DI float max3f(float a, float b, float c) { return __builtin_fmaxf(__builtin_fmaxf(a, b), c); }
DI u32x4 pack8(f32x4 a, f32x4 b) { u32x4 w; w.x = pk2(a[0], a[1]); w.y = pk2(a[2], a[3]); w.z = pk2(b[0], b[1]); w.w = pk2(b[2], b[3]); return w; }

namespace pg8 {
constexpr int BM = 256, BK = 64, HALF = 128, HTB = HALF * BK * 2, STAGE_BYTES = 8 * HTB, NXCD = 8, WGM = 8;
DI int lds_byte(int r, int c) { const int st = (r >> 4) * 2 + (c >> 5), rr = r & 15, cc = c & 31, ob = rr * 64 + cc * 2; return st * 1024 + (ob ^ (((ob >> 9) & 1) << 5)); }
DI void stage_rc(int b, int& R, int& C) { const int st = b / 1024, sb = b % 1024, swz = sb ^ (((sb >> 9) & 1) << 5); R = (st >> 1) * 16 + swz / 64; C = (st & 1) * 32 + (swz % 64) / 2; }
DI int perm32(int rho) { const int n = rho >> 4, i = rho & 15; return 8 * (i >> 2) + 4 * n + (i & 3); }

struct Unit { int g, pm, pn; };
struct Gemm { const bf16_t* A; const bf16_t* Bt; int lda, ldb, K; size_t gsA, gsB; };
struct Order {
    int nM, nN, nwg, total, G, c;
    DI void init(int nM_, int nN_, int ngroups, int G_, int c_) { nM = nM_; nN = nN_; nwg = nM * nN; total = nwg * ngroups; G = G_; c = c_; }
    DI bool next(int i, Unit& u) const {
        const long L = (long)i * G + c; if (L >= total) return false;
        u.g = (int)(L / nwg); int wgid = (int)(L % nwg);
        { const int q = nwg / NXCD, r = nwg % NXCD, xcd = wgid % NXCD, off = wgid / NXCD; wgid = (xcd < r ? xcd * (q + 1) : r * (q + 1) + (xcd - r) * q) + off; }
        const int nig = WGM * nN, gid = wgid / nig, fm = gid * WGM, gsz = (nM - fm) < WGM ? (nM - fm) : WGM;
        u.pm = fm + ((wgid % nig) % gsz); u.pn = (wgid % nig) / gsz; return true;
    }
};

template <class Epi>
DI void gemm_phase(LAS unsigned char* lds, const int wid, const Gemm g, const Order& S, const Epi& E) {
    const int lane = lane_id(), tid = wid * 64 + lane, wr = wid >> 2, wc = wid & 3, fr = lane & 15, fq = lane >> 4;
    const int K = g.K, nt = K / BK;
    unsigned voffA[2], voffB[2];
#pragma unroll
    for (int i = 0; i < 2; ++i) { int R, C; stage_rc(tid * 16 + i * 8192, R, C); const int Rb = (R & ~31) + perm32(R & 31);
        voffA[i] = (unsigned)(R * g.lda + C) * 2u; voffB[i] = (unsigned)(Rb * g.ldb + C) * 2u; }
    const size_t kstep = (size_t)(BK * 2);
    const size_t hstepA = (size_t)HALF * g.lda * 2, hstepB = (size_t)HALF * g.ldb * 2;
    const unsigned ldsw = (unsigned)wid * 1024u;
    const int aoff = lds_byte(wr * 64 + fr, fq * 8), boff = lds_byte(wc * 32 + fr, fq * 8);
#define PG8_SA(b, h) (((b) * 2 + (h)) * HTB)
#define PG8_SB(b, h) ((4 + (b) * 2 + (h)) * HTB)
#define PG8_STAGE(bufoff, gbase, voff) do { _Pragma("unroll") for (int _i = 0; _i < 2; ++_i) \
        __builtin_amdgcn_global_load_lds((const unsigned*)((const char*)(gbase) + (voff)[_i]), (LAS unsigned*)(lds + (bufoff) + ldsw + _i * 8192), 16, 0, 0); } while (0)
#define PG8_LDA(dst, b, h) do { _Pragma("unroll") for (int m = 0; m < 4; ++m) _Pragma("unroll") for (int k = 0; k < 2; ++k) dst[m][k] = *(const LAS bf16x8*)(lds + PG8_SA(b, h) + aoff + m * 2048 + k * 1024); } while (0)
#define PG8_LDB(dst, b, h) do { _Pragma("unroll") for (int n = 0; n < 2; ++n) _Pragma("unroll") for (int k = 0; k < 2; ++k) dst[n][k] = *(const LAS bf16x8*)(lds + PG8_SB(b, h) + boff + n * 2048 + k * 1024); } while (0)
#define PG8_MMA(ai, bj, At, Bt) do { __builtin_amdgcn_s_setprio(1); _Pragma("unroll") for (int m = 0; m < 4; ++m) _Pragma("unroll") for (int n = 0; n < 2; ++n) _Pragma("unroll") for (int k = 0; k < 2; ++k) \
        acc[ai][bj][m][n] = __builtin_amdgcn_mfma_f32_16x16x32_bf16(Bt[n][k], At[m][k], acc[ai][bj][m][n], 0, 0, 0); __builtin_amdgcn_s_setprio(0); } while (0)
#define PG8_WAIT_V(n) asm volatile("s_waitcnt vmcnt(" #n ")" ::: "memory")
#define PG8_WAIT_L(n) asm volatile("s_waitcnt lgkmcnt(" #n ")" ::: "memory")
#define PG8_BAR __builtin_amdgcn_s_barrier()
#define PG8_SCHED __builtin_amdgcn_sched_barrier(0)
    Unit cur, nxt; int ui = 0;
    if (!S.next(0, cur)) return;
    f32x4 acc[2][2][4][2];
#pragma unroll
    for (int a = 0; a < 2; ++a)
#pragma unroll
        for (int b = 0; b < 2; ++b)
#pragma unroll
            for (int m = 0; m < 4; ++m)
#pragma unroll
                for (int n = 0; n < 2; ++n) acc[a][b][m][n] = (f32x4){0.f, 0.f, 0.f, 0.f};
    bf16x8 At[4][2], B0[2][2], B1[2][2];
    const char* cA = (const char*)(g.A + (size_t)cur.g * g.gsA + (size_t)cur.pm * BM * g.lda);
    const char* cB = (const char*)(g.Bt + (size_t)cur.g * g.gsB + (size_t)cur.pn * BM * g.ldb);
    PG8_STAGE(PG8_SB(0, 0), cB, voffB); PG8_STAGE(PG8_SB(0, 1), cB + hstepB, voffB); PG8_STAGE(PG8_SA(0, 0), cA, voffA); PG8_STAGE(PG8_SA(0, 1), cA + hstepA, voffA);
    if (wr == 1) PG8_BAR;
    PG8_WAIT_V(2); PG8_BAR;
    PG8_STAGE(PG8_SB(1, 0), cB + kstep, voffB); PG8_STAGE(PG8_SA(1, 0), cA + kstep, voffA); PG8_STAGE(PG8_SB(1, 1), cB + hstepB + kstep, voffB);
    PG8_WAIT_V(6); PG8_BAR;
    for (;;) {
        const bool has_next = S.next(ui + 1, nxt);
        const char* nA = has_next ? (const char*)(g.A + (size_t)nxt.g * g.gsA + (size_t)nxt.pm * BM * g.lda) : cA;
        const char* nB = has_next ? (const char*)(g.Bt + (size_t)nxt.g * g.gsB + (size_t)nxt.pn * BM * g.ldb) : cB;
        for (int t = 0; t < nt; t += 2) {
            const bool last = (t == nt - 2);
            const char* a1 = cA + (size_t)(t + 1) * kstep;
            const char* a2 = last ? nA : cA + (size_t)(t + 2) * kstep; const char* b2 = last ? nB : cB + (size_t)(t + 2) * kstep;
            const char* a3 = a2 + kstep; const char* b3 = b2 + kstep;
            PG8_LDB(B0, 0, 0); PG8_LDB(B1, 0, 1); PG8_SCHED; PG8_LDA(At, 0, 0); PG8_STAGE(PG8_SA(1, 1), a1 + hstepA, voffA);
            PG8_WAIT_V(8); PG8_WAIT_L(0); PG8_BAR; PG8_MMA(0, 0, At, B0); PG8_MMA(0, 1, At, B1); PG8_BAR; PG8_SCHED;
            PG8_LDA(At, 0, 1); PG8_STAGE(PG8_SB(0, 0), b2, voffB); PG8_STAGE(PG8_SB(0, 1), b2 + hstepB, voffB); PG8_STAGE(PG8_SA(0, 0), a2, voffA);
            PG8_WAIT_V(8); PG8_WAIT_L(0); PG8_BAR; PG8_MMA(1, 0, At, B0); PG8_MMA(1, 1, At, B1); PG8_BAR; PG8_SCHED;
            PG8_LDB(B0, 1, 0); PG8_LDB(B1, 1, 1); PG8_SCHED; PG8_LDA(At, 1, 0); PG8_STAGE(PG8_SA(0, 1), a2 + hstepA, voffA);
            PG8_WAIT_V(8); PG8_WAIT_L(0); PG8_BAR; PG8_MMA(0, 0, At, B0); PG8_MMA(0, 1, At, B1); PG8_BAR; PG8_SCHED;
            PG8_LDA(At, 1, 1); PG8_STAGE(PG8_SB(1, 0), b3, voffB); PG8_STAGE(PG8_SB(1, 1), b3 + hstepB, voffB); PG8_STAGE(PG8_SA(1, 0), a3, voffA);
            PG8_WAIT_V(8); PG8_WAIT_L(0); PG8_BAR; PG8_MMA(1, 0, At, B0); PG8_MMA(1, 1, At, B1); PG8_BAR; PG8_SCHED;
        }
        if (wr == 0) PG8_BAR;
        { const int le = lane_id(); E(acc, cur, wr, wc, le & 15, le >> 4); }
        if (!has_next) break;
#pragma unroll
        for (int a = 0; a < 2; ++a)
#pragma unroll
            for (int b = 0; b < 2; ++b)
#pragma unroll
                for (int m = 0; m < 4; ++m)
#pragma unroll
                    for (int n = 0; n < 2; ++n) acc[a][b][m][n] = (f32x4){0.f, 0.f, 0.f, 0.f};
        cur = nxt; cA = nA; cB = nB; ++ui;
        if (wr == 1) PG8_BAR;
    }
    PG8_WAIT_V(0);
    PG8_BAR;
#undef PG8_SA
#undef PG8_SB
#undef PG8_STAGE
#undef PG8_LDA
#undef PG8_LDB
#undef PG8_MMA
#undef PG8_WAIT_V
#undef PG8_WAIT_L
#undef PG8_BAR
#undef PG8_SCHED
}
}
using pg8::Unit;
typedef f32x4 Acc[2][2][4][2];

#define EPI_ROWS(ai, m) _Pragma("unroll") for (int ai = 0; ai < 2; ++ai) _Pragma("unroll") for (int m = 0; m < 4; ++m)
#define EPI_FENCE() asm volatile("" ::: "memory")
#define EPI_RSTD8(rr, ssqp, invn) float rr[2][4]; EPI_ROWS(ai, m) rr[ai][m] = (ssqp)[epi_row(u, ai, wr, m, fr)]; EPI_FENCE(); EPI_ROWS(ai, m) rr[ai][m] = rstd_of(rr[ai][m], invn);
DI int epi_row(const Unit& u, int ai, int wr, int m, int fr) { return u.pm * 256 + ai * 128 + wr * 64 + m * 16 + fr; }
DI int epi_col(const Unit& u, int bj, int wc, int fq) { return u.pn * 256 + bj * 128 + wc * 32 + 8 * fq; }
DI float rstd_of(float ssq, float invn) { return __builtin_amdgcn_rsqf(ssq * invn + EPS); }

struct EpiSwiglu {
    const float* ssq; bf16_t* act;
    DI void operator()(const Acc& acc, const Unit& u, int wr, int wc, int fr, int fq) const {
        const int cb = u.pn * 128 + wc * 32 + 8 * fq;
        EPI_RSTD8(rr, ssq, 1.0f / D)
        EPI_ROWS(ai, m) { const int row = epi_row(u, ai, wr, m, fr); const float r = rr[ai][m];
            f32x4 v[2];
#pragma unroll
            for (int n = 0; n < 2; ++n)
#pragma unroll
                for (int j = 0; j < 4; ++j) v[n][j] = silu(acc[ai][0][m][n][j] * r) * (acc[ai][1][m][n][j] * r);
            *(u32x4*)(act + (size_t)row * FF + cb) = pack8(v[0], v[1]); }
    }
};
struct EpiResid {
    const float* res; float* out; float alpha; bf16_t* ob; float* ssq;
    DI void operator()(const Acc& acc, const Unit& u, int wr, int wc, int fr, int fq) const {
#pragma unroll
        for (int ai = 0; ai < 2; ++ai) {
            f32x4 pre[4][2][2];
#pragma unroll
            for (int m = 0; m < 4; ++m)
#pragma unroll
                for (int bj = 0; bj < 2; ++bj) { const size_t off = (size_t)epi_row(u, ai, wr, m, fr) * D + epi_col(u, bj, wc, fq);
                    pre[m][bj][0] = *(const f32x4*)(res + off); pre[m][bj][1] = *(const f32x4*)(res + off + 4); }
            EPI_FENCE();
#pragma unroll
            for (int m = 0; m < 4; ++m) { const int row = epi_row(u, ai, wr, m, fr); float sq = 0.f;
#pragma unroll
                for (int bj = 0; bj < 2; ++bj) { const size_t off = (size_t)row * D + epi_col(u, bj, wc, fq);
                    const f32x4 o0 = pre[m][bj][0] + alpha * acc[ai][bj][m][0], o1 = pre[m][bj][1] + alpha * acc[ai][bj][m][1];
                    *(f32x4*)(out + off) = o0; *(f32x4*)(out + off + 4) = o1;
                    if (ob) *(u32x4*)(ob + off) = pack8(o0, o1);
                    sq += (o0[0] * o0[0] + o0[1] * o0[1]) + (o0[2] * o0[2] + o0[3] * o0[3]) + (o1[0] * o1[0] + o1[1] * o1[1]) + (o1[2] * o1[2] + o1[3] * o1[3]); }
                sq += __shfl_xor(sq, 16); sq += __shfl_xor(sq, 32);
                if (fq == 0) unsafeAtomicAdd(ssq + row, sq); }
            EPI_FENCE();
        }
    }
};
struct EpiResidNorm {
    const float* res; float* out; float alpha; float* ssq; unsigned* pcnt; const float* gain;
    DI void operator()(Acc& acc, const Unit& u, int wr, int wc, int fr, int fq) const {
#pragma unroll
        for (int ai = 0; ai < 2; ++ai) {
            f32x4 pre[4][2][2];
#pragma unroll
            for (int m = 0; m < 4; ++m)
#pragma unroll
                for (int bj = 0; bj < 2; ++bj) { const size_t off = (size_t)epi_row(u, ai, wr, m, fr) * D + epi_col(u, bj, wc, fq);
                    pre[m][bj][0] = *(const f32x4*)(res + off); pre[m][bj][1] = *(const f32x4*)(res + off + 4); }
            EPI_FENCE();
#pragma unroll
            for (int m = 0; m < 4; ++m) { const int row = epi_row(u, ai, wr, m, fr); float sq = 0.f;
#pragma unroll
                for (int bj = 0; bj < 2; ++bj) {
                    const f32x4 o0 = pre[m][bj][0] + alpha * acc[ai][bj][m][0], o1 = pre[m][bj][1] + alpha * acc[ai][bj][m][1];
                    acc[ai][bj][m][0] = o0; acc[ai][bj][m][1] = o1;
                    sq += (o0[0] * o0[0] + o0[1] * o0[1]) + (o0[2] * o0[2] + o0[3] * o0[3]) + (o1[0] * o1[0] + o1[1] * o1[1]) + (o1[2] * o1[2] + o1[3] * o1[3]); }
                sq += __shfl_xor(sq, 16); sq += __shfl_xor(sq, 32);
                if (fq == 0) unsafeAtomicAdd(ssq + row, sq); }
            EPI_FENCE();
        }
        asm volatile("s_waitcnt vmcnt(0)" ::: "memory");
        __syncthreads();
        if (wr == 0 && wc == 0 && fr == 0 && fq == 0) {
            unsigned* cp = pcnt + 16 * u.pm;
            __hip_atomic_fetch_add(cp, 1u, __ATOMIC_RELAXED, __HIP_MEMORY_SCOPE_AGENT);
            unsigned sp = 0;
            while (__hip_atomic_load(cp, __ATOMIC_RELAXED, __HIP_MEMORY_SCOPE_AGENT) < 4u) { __builtin_amdgcn_s_sleep(2); if (++sp > (1u << 22)) break; }
            __builtin_amdgcn_fence(__ATOMIC_ACQUIRE, "agent");
        }
        __syncthreads();
        float rr[2][4]; f32x4 gg[2][2];
        EPI_ROWS(ai, m) rr[ai][m] = __hip_atomic_load(ssq + epi_row(u, ai, wr, m, fr), __ATOMIC_RELAXED, __HIP_MEMORY_SCOPE_AGENT);
#pragma unroll
        for (int bj = 0; bj < 2; ++bj) { const int col = epi_col(u, bj, wc, fq); gg[bj][0] = *(const f32x4*)(gain + col); gg[bj][1] = *(const f32x4*)(gain + col + 4); }
        EPI_FENCE();
        EPI_ROWS(ai, m) { const int row = epi_row(u, ai, wr, m, fr); const float r = rstd_of(rr[ai][m], 1.0f / D);
#pragma unroll
            for (int bj = 0; bj < 2; ++bj) { const size_t off = (size_t)row * D + epi_col(u, bj, wc, fq);
                *(f32x4*)(out + off) = acc[ai][bj][m][0] * r * gg[bj][0]; *(f32x4*)(out + off + 4) = acc[ai][bj][m][1] * r * gg[bj][1]; } }
    }
};
struct EpiWin {
    float* ssq1; const f32x2* rope; unsigned char* ws; bf16_t* sga;
    DI void operator()(const Acc& acc, const Unit& u, int wr, int wc, int fr, int fq) const {
        const int pn = u.pn;
        const float* ssq2 = ssq1 + T; float* ssqq = ssq1 + 2 * T; float* ssqkv = ssq1 + 3 * T;
        bf16_t* cq = (bf16_t*)(ws + O_CQ); bf16_t* ckv = (bf16_t*)(ws + O_CKV); bf16_t* kr = (bf16_t*)(ws + O_KR); bf16_t* apack = (bf16_t*)(ws + O_APACK); bf16_t* sgs = sga + (size_t)T * D;
        EPI_RSTD8(rr, ssq2, 1.0f / D)
        EPI_ROWS(ai, m) { const int row = epi_row(u, ai, wr, m, fr); const float r = rr[ai][m];
            if (pn == 0) { float sq = 0.f;
#pragma unroll
                for (int bj = 0; bj < 2; ++bj) { const f32x4 a = acc[ai][bj][m][0] * r, b = acc[ai][bj][m][1] * r;
                    *(u32x4*)(cq + (size_t)row * 256 + bj * 128 + wc * 32 + 8 * fq) = pack8(a, b);
                    sq += (a[0] * a[0] + a[1] * a[1]) + (a[2] * a[2] + a[3] * a[3]) + (b[0] * b[0] + b[1] * b[1]) + (b[2] * b[2] + b[3] * b[3]); }
                sq += __shfl_xor(sq, 16); sq += __shfl_xor(sq, 32);
                if (fq == 0) unsafeAtomicAdd(ssqq + row, sq);
            } else if (pn == 1) {
                { const f32x4 a = acc[ai][0][m][0] * r, b = acc[ai][0][m][1] * r;
                  *(u32x4*)(ckv + (size_t)row * 128 + wc * 32 + 8 * fq) = pack8(a, b);
                  float sq = (a[0] * a[0] + a[1] * a[1]) + (a[2] * a[2] + a[3] * a[3]) + (b[0] * b[0] + b[1] * b[1]) + (b[2] * b[2] + b[3] * b[3]);
                  sq += __shfl_xor(sq, 16); sq += __shfl_xor(sq, 32);
                  if (fq == 0) unsafeAtomicAdd(ssqkv + row, sq); }
                if (wc == 0) {
                    const f32x4 a = acc[ai][1][m][0] * r, b = acc[ai][1][m][1] * r;
                    const f32x4 c0 = *(const f32x4*)(rope + (size_t)row * 16 + 4 * fq), c1 = *(const f32x4*)(rope + (size_t)row * 16 + 4 * fq + 2);
                    f32x4 oa, ob;
                    oa[0] = a[0] * c0[0] - a[1] * c0[1]; oa[1] = a[1] * c0[0] + a[0] * c0[1]; oa[2] = a[2] * c0[2] - a[3] * c0[3]; oa[3] = a[3] * c0[2] + a[2] * c0[3];
                    ob[0] = b[0] * c1[0] - b[1] * c1[1]; ob[1] = b[1] * c1[0] + b[0] * c1[1]; ob[2] = b[2] * c1[2] - b[3] * c1[3]; ob[3] = b[3] * c1[2] + b[2] * c1[3];
                    *(u32x4*)(kr + (size_t)row * 32 + 8 * fq) = pack8(oa, ob); }
            } else if (pn < 4) {
#pragma unroll
                for (int bj = 0; bj < 2; ++bj) { const int uc = (pn - 2) * 256 + bj * 128 + wc * 32 + 8 * fq; const int gg = uc >> 4, i0 = uc & 15;
                    *(u32x4*)(apack + ((size_t)gg * MG + (row >> 5)) * KP + (row & 31) * 16 + i0) = pack8(acc[ai][bj][m][0] * r, acc[ai][bj][m][1] * r); }
            } else { bf16_t* dst = pn < 8 ? sga : sgs; const int c0 = ((pn - 4) & 3) * 256;
#pragma unroll
                for (int bj = 0; bj < 2; ++bj) { f32x4 a, b;
#pragma unroll
                    for (int j = 0; j < 4; ++j) { a[j] = sigm(acc[ai][bj][m][0][j] * r); b[j] = sigm(acc[ai][bj][m][1][j] * r); }
                    *(u32x4*)(dst + (size_t)row * D + c0 + bj * 128 + wc * 32 + 8 * fq) = pack8(a, b); }
            } }
    }
};
struct EpiQ {
    const float* ssqq; const f32x2* rope; bf16_t* q;
    DI void operator()(const Acc& acc, const Unit& u, int wr, int wc, int fr, int fq_in) const {
        int fq = fq_in; asm volatile("" : "+v"(fq));
        EPI_RSTD8(rr, ssqq, 1.0f / 256)
#pragma unroll
        for (int bj = 0; bj < 2; ++bj) { const int c = epi_col(u, bj, wc, fq); const int d = c % 96; const bool rot = d >= 64; const int i0 = rot ? (d - 64) >> 1 : 0;
#pragma unroll
            for (int ai = 0; ai < 2; ++ai) {
                f32x4 cs[4][2];
#pragma unroll
                for (int m = 0; m < 4; ++m) { const f32x2* rp = rope + (size_t)epi_row(u, ai, wr, m, fr) * 16 + i0;
                    cs[m][0] = rot ? *(const f32x4*)rp : (f32x4){1.f, 0.f, 1.f, 0.f}; cs[m][1] = rot ? *(const f32x4*)(rp + 2) : (f32x4){1.f, 0.f, 1.f, 0.f}; }
                EPI_FENCE();
#pragma unroll
                for (int m = 0; m < 4; ++m) { const int row = epi_row(u, ai, wr, m, fr); const float r = rr[ai][m] * QSCALE;
                    f32x4 a = acc[ai][bj][m][0] * r, b = acc[ai][bj][m][1] * r;
                    if (rot) { const f32x4 c0 = cs[m][0], c1 = cs[m][1]; f32x4 oa, ob;
                        oa[0] = a[0] * c0[0] - a[1] * c0[1]; oa[1] = a[1] * c0[0] + a[0] * c0[1]; oa[2] = a[2] * c0[2] - a[3] * c0[3]; oa[3] = a[3] * c0[2] + a[2] * c0[3];
                        ob[0] = b[0] * c1[0] - b[1] * c1[1]; ob[1] = b[1] * c1[0] + b[0] * c1[1]; ob[2] = b[2] * c1[2] - b[3] * c1[3]; ob[3] = b[3] * c1[2] + b[2] * c1[3];
                        a = oa; b = ob; }
                    *(u32x4*)(q + (size_t)row * 768 + c) = pack8(a, b); }
                EPI_FENCE();
            } }
    }
};
struct EpiRowScale {
    const float* ssq; float invn; bf16_t* o; int ldo;
    DI void operator()(const Acc& acc, const Unit& u, int wr, int wc, int fr, int fq) const {
        EPI_RSTD8(rr, ssq, invn)
        EPI_ROWS(ai, m) { const int row = epi_row(u, ai, wr, m, fr); const float r = rr[ai][m];
#pragma unroll
            for (int bj = 0; bj < 2; ++bj) *(u32x4*)(o + (size_t)row * ldo + epi_col(u, bj, wc, fq)) = pack8(acc[ai][bj][m][0] * r, acc[ai][bj][m][1] * r); }
    }
};
struct EpiVt {
    const float* ssq; bf16_t* vt;
    DI void operator()(const Acc& acc, const Unit& u, int wr, int wc, int fr, int fq) const {
#pragma unroll
        for (int bj = 0; bj < 2; ++bj) { const int c = epi_col(u, bj, wc, fq);
            const f32x4 s0 = *(const f32x4*)(ssq + c), s1 = *(const f32x4*)(ssq + c + 4); f32x4 r0, r1;
#pragma unroll
            for (int j = 0; j < 4; ++j) { r0[j] = rstd_of(s0[j], 1.0f / 128); r1[j] = rstd_of(s1[j], 1.0f / 128); }
            EPI_ROWS(ai, m) { const int row = epi_row(u, ai, wr, m, fr);
                *(u32x4*)(vt + (size_t)row * T + c) = pack8(acc[ai][bj][m][0] * r0, acc[ai][bj][m][1] * r1); } }
    }
};
struct EpiSloc {
    float* sloc;
    DI void operator()(const Acc& acc, const Unit& u, int wr, int wc, int fr, int fq) const {
        EPI_ROWS(ai, m) { const int row = epi_row(u, ai, wr, m, fr);
#pragma unroll
            for (int bj = 0; bj < 2; ++bj) { float* p = sloc + ((size_t)u.g * MG + row) * 256 + bj * 128 + wc * 32 + 8 * fq;
                *(f32x4*)p = acc[ai][bj][m][0]; *(f32x4*)(p + 4) = acc[ai][bj][m][1]; } }
    }
};
struct EpiSsmOut {
    bf16_t* gy;
    DI void operator()(const Acc& acc, const Unit& u, int wr, int wc, int fr, int fq) const {
        EPI_ROWS(ai, m) { const int row = epi_row(u, ai, wr, m, fr);
#pragma unroll
            for (int bj = 0; bj < 2; ++bj) { const int c = epi_col(u, bj, wc, fq); const int tau = c >> 4, i0 = c & 15; f32x4 a, b;
#pragma unroll
                for (int j = 0; j < 4; ++j) { a[j] = gelu_tanh(acc[ai][bj][m][0][j]); b[j] = gelu_tanh(acc[ai][bj][m][1][j]); }
                *(u32x4*)(gy + ((size_t)row * CL + tau) * 512 + u.g * 16 + i0) = pack8(a, b); } }
    }
};
template <int MODE> struct EpiGate {
    const bf16_t* gate; const bf16_t* prev; bf16_t* o;
    DI void operator()(const Acc& acc, const Unit& u, int wr, int wc, int fr, int fq) const {
#pragma unroll
        for (int ai = 0; ai < 2; ++ai) {
            u32x4 gv[4][2], pv[4][2];
#pragma unroll
            for (int m = 0; m < 4; ++m)
#pragma unroll
                for (int bj = 0; bj < 2; ++bj) { const size_t off = (size_t)epi_row(u, ai, wr, m, fr) * D + epi_col(u, bj, wc, fq);
                    gv[m][bj] = *(const u32x4*)(gate + off); if (MODE == 1) pv[m][bj] = *(const u32x4*)(prev + off); }
            EPI_FENCE();
#pragma unroll
            for (int m = 0; m < 4; ++m)
#pragma unroll
                for (int bj = 0; bj < 2; ++bj) { const size_t off = (size_t)epi_row(u, ai, wr, m, fr) * D + epi_col(u, bj, wc, fq);
                    const u32x4 g = gv[m][bj]; f32x4 a, b;
                    a[0] = bflo(g.x) * acc[ai][bj][m][0][0]; a[1] = bfhi(g.x) * acc[ai][bj][m][0][1]; a[2] = bflo(g.y) * acc[ai][bj][m][0][2]; a[3] = bfhi(g.y) * acc[ai][bj][m][0][3];
                    b[0] = bflo(g.z) * acc[ai][bj][m][1][0]; b[1] = bfhi(g.z) * acc[ai][bj][m][1][1]; b[2] = bflo(g.w) * acc[ai][bj][m][1][2]; b[3] = bfhi(g.w) * acc[ai][bj][m][1][3];
                    if (MODE == 1) { const u32x4 p = pv[m][bj];
                        a[0] += bflo(p.x); a[1] += bfhi(p.x); a[2] += bflo(p.y); a[3] += bfhi(p.y); b[0] += bflo(p.z); b[1] += bfhi(p.z); b[2] += bflo(p.w); b[3] += bfhi(p.w); }
                    *(u32x4*)(o + off) = pack8(a, b); }
            EPI_FENCE();
        }
    }
};
struct EpiGlu {
    const float* bias; bf16_t* so;
    DI void operator()(const Acc& acc, const Unit& u, int wr, int wc, int fr, int fq) const {
        const int cb = u.pn * 128 + wc * 32 + 8 * fq;
        const f32x4 bv0 = *(const f32x4*)(bias + cb), bv1 = *(const f32x4*)(bias + cb + 4), bg0 = *(const f32x4*)(bias + 512 + cb), bg1 = *(const f32x4*)(bias + 512 + cb + 4);
        EPI_ROWS(ai, m) { const int row = epi_row(u, ai, wr, m, fr); f32x4 a, b;
#pragma unroll
            for (int j = 0; j < 4; ++j) { a[j] = (acc[ai][0][m][0][j] + bv0[j]) * sigm(acc[ai][1][m][0][j] + bg0[j]); b[j] = (acc[ai][0][m][1][j] + bv1[j]) * sigm(acc[ai][1][m][1][j] + bg1[j]); }
            *(u32x4*)(so + (size_t)row * 512 + cb) = pack8(a, b); }
    }
};

struct Args { const void* in[30]; float* out; unsigned char* ws; };
typedef __attribute__((address_space(4))) const char* kseg_t;
DI const void* karg(int idx) { kseg_t kp = (kseg_t)__builtin_amdgcn_kernarg_segment_ptr(); asm volatile("" : "+s"(kp)); return *(const void* const __attribute__((address_space(4)))*)(kp + idx * 8); }
#define INF(i) ((const float*)karg(i))
#define KOUT ((float*)karg(30))
#define KWS ((unsigned char*)karg(31))
enum { I_X = 0, I_POS, I_N1, I_WG1, I_WU1, I_WD1, I_NMIX, I_WIN, I_QN, I_WUQ, I_KVN, I_WUKV, I_WOA, I_LRE, I_LIM, I_LDT, I_BRE, I_BIM, I_CRE, I_CIM, I_DSK, I_WGLU, I_BGLU, I_WOS, I_WOUT, I_N2, I_WG2, I_WU2, I_WD2, I_NF };

template <class F> DI void prep_item(const F& f, int K, int nblk, bf16_t* WT, LAS float* scr, int item, int lane) {
    const int kb = item / nblk, nb = item % nblk, k0 = 64 * kb, n0 = 32 * nb;
#pragma unroll 8
    for (int i = 0; i < 32; ++i) { const int kk = 2 * i + (lane >> 5); scr[kk * 33 + (lane & 31)] = f(k0 + kk, n0 + (lane & 31)); }
    asm volatile("s_waitcnt lgkmcnt(0)" ::: "memory");
    const int c = lane & 7;
#pragma unroll
    for (int j = 0; j < 4; ++j) { const int n = (lane >> 3) + 8 * j; const LAS float* s = scr + (8 * c) * 33 + n;
        u32x4 o; o.x = pk2(s[0 * 33], s[1 * 33]); o.y = pk2(s[2 * 33], s[3 * 33]); o.z = pk2(s[4 * 33], s[5 * 33]); o.w = pk2(s[6 * 33], s[7 * 33]);
        *(u32x4*)(WT + (size_t)(n0 + n) * K + k0 + 8 * c) = o; }
    asm volatile("s_waitcnt lgkmcnt(0)" ::: "memory");
}
struct FGateUp { const float *wg, *wu, *gain; DI float operator()(int k, int n) const { const int col = (n >> 8) * 128 + (n & 127); const long delta = (n & 128) ? ((const char*)wu - (const char*)wg) : 0l; const float* w = (const float*)((const char*)wg + delta); return w[(size_t)k * FF + col] * gain[k]; } };
struct FPlain { const float* w; int N; DI float operator()(int k, int n) const { return w[(size_t)k * N + n]; } };
struct FWin { const float *w, *gain; DI float operator()(int k, int n) const {
    int src;
    if (n < 384) src = n; else if (n < 416) { const int j = n - 384; src = 384 + (j & 1) * 16 + (j >> 1); } else if (n < 512) src = -1; else src = n - 96;
    return src < 0 ? 0.f : w[(size_t)k * 2976 + src] * gain[k]; } };
struct FWuq { const float *w, *gain; DI float operator()(int k, int n) const { const int h = n / 96, d = n % 96; int src = n; if (d >= 64) { const int j = d - 64; src = h * 96 + 64 + (j & 1) * 16 + (j >> 1); } return w[(size_t)k * 768 + src] * gain[k]; } };
struct FWukv { const float *w, *gain; int off; DI float operator()(int k, int n) const { return w[(size_t)k * 1024 + (n >> 6) * 128 + off + (n & 63)] * gain[k]; } };
struct FWglu { const float* w; DI float operator()(int k, int n) const { return w[(size_t)k * 1024 + ((n >> 7) & 1) * 512 + (n >> 8) * 128 + (n & 127)]; } };

DI void lam_pow_exact(float lre, float lim, float dt, float e, float& pr, float& pi) { const float mag = expf(e * lre * dt), ang = e * (lim * dt); pr = mag * cosf(ang); pi = mag * sinf(ang); }
DI void lam_pow(float lre, float lim, float dt, float e, float& pr, float& pi) { const float mag = __expf(e * lre * dt); const float tu = __builtin_amdgcn_fractf(e * (lim * dt) * 0.15915494309189535f); pr = mag * __builtin_amdgcn_cosf(tu); pi = mag * __builtin_amdgcn_sinf(tu); }
DI void lam_kfac(float lre, float lim, float dt, float& kr, float& ki) { float br, bi; lam_pow(lre, lim, dt, 1.0f, br, bi); const float den = lre * lre + lim * lim, nr = br - 1.0f; kr = (nr * lre + bi * lim) / den; ki = (bi * lre - nr * lim) / den; }

constexpr int KS_STRIDE = 208, VS_STRIDE = 144, KS_BYTES = 64 * KS_STRIDE, VS_BYTES = 64 * VS_STRIDE, VOFF = 2 * KS_BYTES, NKT = SEQ / 64;
#define MFMA16(a_, b_, c_) __builtin_amdgcn_mfma_f32_16x16x32_bf16((a_), (b_), (c_), 0, 0, 0)
#define ATT_STEP(KTX, LKN, LKR, LVT, WKN, WKR, WVT, sc, sn) do { const int kt_ = (KTX); \
            if (kt_ + 3 < NKT) { const size_t k3 = (size_t)(kt_ + 3) * 64; LKN = *(const u32x4*)(gkn + k3 * 512); if (tid < 256) LKR = *(const u32x4*)(gkr + k3 * 32); } \
            if (kt_ + 2 < NKT) LVT = *(const u32x4*)(gvt + (size_t)(kt_ + 2) * 64); \
            float mx0 = max3f(sc[0][0][0], sc[0][0][1], sc[0][0][2]), mx1 = max3f(sc[0][1][0], sc[0][1][1], sc[0][1][2]); \
            mx0 = max3f(mx0, sc[0][0][3], sc[1][0][0]); mx1 = max3f(mx1, sc[0][1][3], sc[1][1][0]); \
            _Pragma("unroll") \
            for (int t4 = 1; t4 < 4; ++t4) { mx0 = max3f(mx0, sc[t4][0][1], sc[t4][0][2]); mx1 = max3f(mx1, sc[t4][1][1], sc[t4][1][2]); \
                if (t4 < 3) { mx0 = max3f(mx0, sc[t4][0][3], sc[t4 + 1][0][0]); mx1 = max3f(mx1, sc[t4][1][3], sc[t4 + 1][1][0]); } else { mx0 = fmaxf(mx0, sc[3][0][3]); mx1 = fmaxf(mx1, sc[3][1][3]); } } \
            const bool up_ = (kt_ == 0) | (mx0 > 6.0f) | (mx1 > 6.0f); \
            if (__builtin_amdgcn_ballot_w64(up_) != 0ull) {     \
                mx0 = fmaxf(mx0, __shfl_xor(mx0, 16)); mx0 = fmaxf(mx0, __shfl_xor(mx0, 32)); mx1 = fmaxf(mx1, __shfl_xor(mx1, 16)); mx1 = fmaxf(mx1, __shfl_xor(mx1, 32)); \
                const float d0 = ((kt_ == 0) | (mx0 > 6.0f)) ? mx0 : 0.f, d1 = ((kt_ == 0) | (mx1 > 6.0f)) ? mx1 : 0.f; \
                const float a0 = __builtin_amdgcn_exp2f(-d0), a1 = __builtin_amdgcn_exp2f(-d1); \
                l0 *= a0; l1 *= a1; negm0 -= d0; negm1 -= d1; \
                _Pragma("unroll") \
                for (int t4 = 0; t4 < 4; ++t4) { sc[t4][0] -= d0; sc[t4][1] -= d1; oacc[t4][0] *= a0; oacc[t4][1] *= a1; } \
            } \
            { const LAS unsigned char* kp = lds + ((kt_ + 1) & 1) * KS_BYTES + r16 * KS_STRIDE + qd * 16; \
              _Pragma("unroll") \
              for (int t4 = 0; t4 < 4; ++t4) { sn[t4][0] = negm0; sn[t4][1] = negm1; } \
              _Pragma("unroll") \
              for (int ks = 0; ks < 3; ++ks) \
              _Pragma("unroll") \
                for (int t4 = 0; t4 < 4; ++t4) { const bf16x8 kf = *(const LAS bf16x8*)(kp + t4 * 16 * KS_STRIDE + ks * 64); \
                    sn[t4][0] = MFMA16(kf, qf[0][ks], sn[t4][0]); sn[t4][1] = MFMA16(kf, qf[1][ks], sn[t4][1]); } } \
            { f32x4 p0 = {0.f, 0.f, 0.f, 0.f}, p1 = {0.f, 0.f, 0.f, 0.f}; \
              _Pragma("unroll") \
              for (int t4 = 0; t4 < 4; ++t4) \
              _Pragma("unroll") \
                for (int e = 0; e < 4; ++e) { sc[t4][0][e] = __builtin_amdgcn_exp2f(sc[t4][0][e]); sc[t4][1][e] = __builtin_amdgcn_exp2f(sc[t4][1][e]); p0[e] += sc[t4][0][e]; p1[e] += sc[t4][1][e]; } \
              l0 += (p0[0] + p0[1]) + (p0[2] + p0[3]); l1 += (p1[0] + p1[1]) + (p1[2] + p1[3]); } \
            { const LAS unsigned char* vp = lds + VOFF + (kt_ & 1) * VS_BYTES + r16 * VS_STRIDE + qd * 16; \
              _Pragma("unroll") \
              for (int kp2 = 0; kp2 < 2; ++kp2) { \
                  u32x4 w0, w1; \
                  w0.x = pk2(sc[2 * kp2][0][0], sc[2 * kp2][0][1]); w0.y = pk2(sc[2 * kp2][0][2], sc[2 * kp2][0][3]); w0.z = pk2(sc[2 * kp2 + 1][0][0], sc[2 * kp2 + 1][0][1]); w0.w = pk2(sc[2 * kp2 + 1][0][2], sc[2 * kp2 + 1][0][3]); \
                  w1.x = pk2(sc[2 * kp2][1][0], sc[2 * kp2][1][1]); w1.y = pk2(sc[2 * kp2][1][2], sc[2 * kp2][1][3]); w1.z = pk2(sc[2 * kp2 + 1][1][0], sc[2 * kp2 + 1][1][1]); w1.w = pk2(sc[2 * kp2 + 1][1][2], sc[2 * kp2 + 1][1][3]); \
                  const bf16x8 pf0 = __builtin_bit_cast(bf16x8, w0), pf1 = __builtin_bit_cast(bf16x8, w1); \
                  _Pragma("unroll") \
                  for (int dt = 0; dt < 4; ++dt) { const bf16x8 vf = *(const LAS bf16x8*)(vp + dt * 16 * VS_STRIDE + kp2 * 64); \
                      oacc[dt][0] = MFMA16(vf, pf0, oacc[dt][0]); oacc[dt][1] = MFMA16(vf, pf1, oacc[dt][1]); } } } \
            if (kt_ + 2 < NKT) { *(LAS u32x4*)(lds + (kt_ & 1) * KS_BYTES + lkn) = WKN; if (tid < 256) *(LAS u32x4*)(lds + (kt_ & 1) * KS_BYTES + lkr) = WKR; } \
            if (kt_ + 1 < NKT) { *(LAS u32x2*)(lds + ((kt_ + 1) & 1) * VS_BYTES + lvt) = (u32x2){WVT.x, WVT.y}; *(LAS u32x2*)(lds + ((kt_ + 1) & 1) * VS_BYTES + lvt + 16) = (u32x2){WVT.z, WVT.w}; } \
            __syncthreads(); \
            } while (0)
DI void attn_phase(LAS unsigned char* lds, const int wid, const bf16_t* Q, const bf16_t* Kn, const bf16_t* Kr, const bf16_t* Vt, bf16_t* O, int G, int c) {
    const int lane = lane_id(), tid = wid * 64 + lane, r16 = lane & 15, qd = lane >> 4;
    for (int it = 0;; ++it) {
        const long L = (long)it * G + c; if (L >= 2048) break;
        const int xcd = (int)(L & 7), idx = (int)(L >> 3), bh = (idx >> 5) * 8 + xcd, qb = idx & 31, b = bh >> 3, h = bh & 7;
        const size_t tok0 = (size_t)b * SEQ;
        const int q0 = qb * 256 + wid * 32;
        bf16x8 qf[2][3];
#pragma unroll
        for (int qt = 0; qt < 2; ++qt) { const bf16_t* qp = Q + (tok0 + q0 + 16 * qt + r16) * 768 + h * 96 + 8 * qd;
#pragma unroll
          for (int ks = 0; ks < 3; ++ks) qf[qt][ks] = *(const bf16x8*)(qp + 32 * ks); }
        f32x4 oacc[4][2], sa[4][2], sb[4][2];
        f32x4 negm0 = {0.f, 0.f, 0.f, 0.f}, negm1 = {0.f, 0.f, 0.f, 0.f};
#pragma unroll
        for (int t4 = 0; t4 < 4; ++t4) { oacc[t4][0] = (f32x4){0.f, 0.f, 0.f, 0.f}; oacc[t4][1] = (f32x4){0.f, 0.f, 0.f, 0.f}; }
        float l0 = 0.f, l1 = 0.f;
        const int skey = tid >> 3, sch = tid & 7;
        const int rkey = (tid & 255) >> 2, rch = tid & 3;
        const bf16_t* gkn = Kn + (tok0 + skey) * 512 + h * 64 + sch * 8;
        const bf16_t* gkr = Kr + (tok0 + rkey) * 32 + rch * 8;
        const bf16_t* gvt = Vt + (size_t)(h * 64 + skey) * T + tok0 + sch * 8;
        const unsigned lkn = skey * KS_STRIDE + sch * 16, lkr = rkey * KS_STRIDE + 128 + rch * 16, lvt = VOFF + skey * VS_STRIDE + (sch >> 2) * 64 + ((sch & 1) * 4 + ((sch >> 1) & 1)) * 8;
        u32x4 rkn = *(const u32x4*)gkn, rvt = *(const u32x4*)gvt, rkr = {0u, 0u, 0u, 0u};
        if (tid < 256) rkr = *(const u32x4*)gkr;
        *(LAS u32x4*)(lds + lkn) = rkn; *(LAS u32x2*)(lds + lvt) = (u32x2){rvt.x, rvt.y}; *(LAS u32x2*)(lds + lvt + 16) = (u32x2){rvt.z, rvt.w}; if (tid < 256) *(LAS u32x4*)(lds + lkr) = rkr;
        rkn = *(const u32x4*)(gkn + 64 * 512); if (tid < 256) rkr = *(const u32x4*)(gkr + 64 * 32);
        *(LAS u32x4*)(lds + KS_BYTES + lkn) = rkn; if (tid < 256) *(LAS u32x4*)(lds + KS_BYTES + lkr) = rkr;
        __syncthreads();
        { const LAS unsigned char* kp = lds + r16 * KS_STRIDE + qd * 16;
#pragma unroll
          for (int t4 = 0; t4 < 4; ++t4) { sa[t4][0] = negm0; sa[t4][1] = negm1; }
#pragma unroll
          for (int ks = 0; ks < 3; ++ks)
#pragma unroll
            for (int t4 = 0; t4 < 4; ++t4) { const bf16x8 kf = *(const LAS bf16x8*)(kp + t4 * 16 * KS_STRIDE + ks * 64);
                sa[t4][0] = MFMA16(kf, qf[0][ks], sa[t4][0]); sa[t4][1] = MFMA16(kf, qf[1][ks], sa[t4][1]); } }
        __syncthreads();
        u32x4 akn = *(const u32x4*)(gkn + (size_t)2 * 64 * 512), avt = *(const u32x4*)(gvt + 64), akr = {0u, 0u, 0u, 0u}, bkn, bkr = {0u, 0u, 0u, 0u}, bvt;
        if (tid < 256) akr = *(const u32x4*)(gkr + (size_t)2 * 64 * 32);
        for (int kt = 0; kt < NKT; kt += 2) {
            ATT_STEP(kt, bkn, bkr, bvt, akn, akr, avt, sa, sb);
            ATT_STEP(kt + 1, akn, akr, avt, bkn, bkr, bvt, sb, sa);
        }
        l0 += __shfl_xor(l0, 16); l0 += __shfl_xor(l0, 32); l1 += __shfl_xor(l1, 16); l1 += __shfl_xor(l1, 32);
        const float inv0 = 1.0f / l0, inv1 = 1.0f / l1;
#pragma unroll
        for (int qt = 0; qt < 2; ++qt) { const float inv = qt ? inv1 : inv0;
            bf16_t* op = O + (tok0 + q0 + 16 * qt + r16) * 512 + h * 64 + 4 * qd;
#pragma unroll
            for (int dt = 0; dt < 4; ++dt) { u32x2 w; w.x = pk2(oacc[dt][qt][0] * inv, oacc[dt][qt][1] * inv); w.y = pk2(oacc[dt][qt][2] * inv, oacc[dt][qt][3] * inv);
                *(u32x2*)(op + 16 * dt) = w; } }
    }
}

#define XB_TMO      128
#define XB_XCNT(j)  (256  + 64 * (j))
#define XB_XSUB(j)  (1280 + 64 * (j))
#define XB_XGEN(j)  (2304 + 64 * (j))
#define XB_TOP      3328
#define XB_TOPGEN   3392
#define XCD_BAR_WORDS 3456
#define XB_SPIN_CAP (1u << 18)

__device__ __forceinline__ unsigned xb_ld(unsigned* p)              { return __hip_atomic_load(p, __ATOMIC_RELAXED, __HIP_MEMORY_SCOPE_AGENT); }
__device__ __forceinline__ unsigned xb_add(unsigned* p, unsigned v) { return __hip_atomic_fetch_add(p, v, __ATOMIC_RELAXED, __HIP_MEMORY_SCOPE_AGENT); }
__device__ __forceinline__ unsigned xb_xcc_id() { return (unsigned)__builtin_amdgcn_s_getreg((3 << 11) | 20) & 0xFu; }
#define XB_SPIN(cond, bar) do { unsigned _sp = 0; while (cond) { __builtin_amdgcn_s_sleep(1); \
    if ((++_sp & 255u) == 0u) { if (xb_ld(&(bar)[XB_TMO])) break; if (_sp > XB_SPIN_CAP) { atomicAdd(&(bar)[XB_TMO], 1u); break; } } } } while (0)

struct XcdBarrier {
    unsigned* bar; unsigned x;
    volatile LAS unsigned* st;
};

__device__ __forceinline__ XcdBarrier xcd_barrier_post(unsigned* bar, volatile LAS unsigned* st, const bool t0) {
    XcdBarrier b; b.bar = bar; b.x = xb_xcc_id(); b.st = st;
    if (t0) (void)xb_add(&bar[XB_XCNT(b.x)], 1u);
    return b;
}
__device__ __forceinline__ void xcd_barrier_complete(unsigned* bar, unsigned x, unsigned& nloc, unsigned& nx) {
    const unsigned G = gridDim.x * gridDim.y * gridDim.z;
    unsigned sum, cnt, mine, sp = 0u;
    for (;;) {
        sum = 0u; cnt = 0u; mine = 0u;
#pragma unroll
        for (unsigned j = 0; j < 16; ++j) { const unsigned c = xb_ld(&bar[XB_XCNT(j)]); sum += c; cnt += (c > 0u) ? 1u : 0u; mine = (j == x) ? c : mine; }
        if (sum == G) break;
        __builtin_amdgcn_s_sleep(1);
        if ((++sp & 255u) == 0u) { if (xb_ld(&bar[XB_TMO])) break; if (sp > XB_SPIN_CAP) { atomicAdd(&bar[XB_TMO], 1u); break; } }
    }
    nloc = mine > 0u ? mine : 1u; nx = cnt > 0u ? cnt : 1u;
}

__device__ __forceinline__ void xcd_barrier(const XcdBarrier& b, const bool t0) {
    asm volatile("s_waitcnt vmcnt(0)" ::: "memory");
    __syncthreads();
    if (t0) {
        unsigned* bar = b.bar;
        __builtin_amdgcn_s_waitcnt(0);
        unsigned nloc = b.st[0], nx = b.st[1];
        if (nloc == 0u) { xcd_barrier_complete(bar, b.x, nloc, nx); b.st[0] = nloc; b.st[1] = nx; }
        const unsigned old = xb_add(&bar[XB_XSUB(b.x)], 1u);
        const unsigned gen = old / nloc;
        if (old + 1u == (gen + 1u) * nloc) {
            __builtin_amdgcn_fence(__ATOMIC_RELEASE, "agent");
            asm volatile("s_waitcnt vmcnt(0)" ::: "memory");
            const unsigned og = xb_add(&bar[XB_TOP], 1u);
            const unsigned tg = og / nx;
            if (og + 1u == (tg + 1u) * nx) xb_add(&bar[XB_TOPGEN], 1u);
            else XB_SPIN(xb_ld(&bar[XB_TOPGEN]) == tg, bar);
            __builtin_amdgcn_fence(__ATOMIC_ACQUIRE, "agent");
            xb_add(&bar[XB_XGEN(b.x)], 1u);
            asm volatile("s_waitcnt vmcnt(0)" ::: "memory");
        } else {
            XB_SPIN(xb_ld(&bar[XB_XGEN(b.x)]) == gen, bar);
            __builtin_amdgcn_fence(__ATOMIC_ACQUIRE, "agent");
            asm volatile("s_waitcnt vmcnt(0)" ::: "memory");
        }
    }
    __syncthreads();
}

constexpr int LDS_BYTES = 147456;
#define WSB(off) ((bf16_t*)(KWS + (off)))
#define WSF(off) ((float*)(KWS + (off)))
#define SSQ(k) (WSF(O_SSQ) + (size_t)(k) * T)
__global__ void __launch_bounds__(512, 2) fwd_megakernel(Args args_unused) {
    extern __shared__ __attribute__((aligned(16))) unsigned char lds_raw[];
    LAS unsigned char* lds = (LAS unsigned char*)lds_raw;
    cg::grid_group grid = cg::this_grid();
    const int wid_s = __builtin_amdgcn_readfirstlane((int)threadIdx.x >> 6);
#define BAR_ST ((volatile LAS unsigned*)(lds + 131072 + 64))
#define T0 (wid_s == 0 && lane_id() == 0)
    if (T0) { BAR_ST[0] = 0u; BAR_ST[1] = 0u; }
    __syncthreads();
    (void)xcd_barrier_post((unsigned*)(KWS + O_CTL), BAR_ST, T0);
#define GRID_BAR() do { XcdBarrier b_; b_.bar = (unsigned*)(KWS + O_CTL); b_.x = xb_xcc_id(); b_.st = BAR_ST; xcd_barrier(b_, T0); } while (0)
#define TID (wid_s * 64 + lane_id())
#define LANE (lane_id())
#define WID (wid_s)
#define GG ((int)gridDim.x)
#define CC ((int)blockIdx.x)
#define GW (CC * 8 + WID)
#define NGW (GG * 8)
#define GT ((long)CC * 512 + TID)
#define NGT ((long)GG * 512)

    {
        { float* z = SSQ(1); for (long i = GT; i < 5L * T; i += NGT) z[i] = 0.f; }
        { const float* x = INF(I_X); bf16_t* hb = WSB(O_HB); float* ssq1 = SSQ(0); const int lane = LANE;
          for (int row = GW; row < T; row += 2 * NGW) {
            const int row2 = row + NGW; const bool has2 = row2 < T;
            const f32x4* xr = (const f32x4*)(x + (size_t)row * D) + lane; const f32x4* xq = (const f32x4*)(x + (size_t)(has2 ? row2 : row) * D) + lane;
            f32x4 v[4], w[4]; float s = 0.f, s2 = 0.f;
#pragma unroll
            for (int j = 0; j < 4; ++j) { v[j] = xr[64 * j]; w[j] = xq[64 * j]; }
#pragma unroll
            for (int j = 0; j < 4; ++j) { s += (v[j][0] * v[j][0] + v[j][1] * v[j][1]) + (v[j][2] * v[j][2] + v[j][3] * v[j][3]); s2 += (w[j][0] * w[j][0] + w[j][1] * w[j][1]) + (w[j][2] * w[j][2] + w[j][3] * w[j][3]); }
            s = wave_sum(s); s2 = wave_sum(s2);
            if (lane == 0) { ssq1[row] = s; if (has2) ssq1[row2] = s2; }
            u32x2* o8 = (u32x2*)(hb + (size_t)row * D) + lane;
#pragma unroll
            for (int j = 0; j < 4; ++j) { u32x2 t; t.x = pk2(v[j][0], v[j][1]); t.y = pk2(v[j][2], v[j][3]); o8[64 * j] = t; }
            if (has2) { u32x2* o9 = (u32x2*)(hb + (size_t)row2 * D) + lane;
#pragma unroll
              for (int j = 0; j < 4; ++j) { u32x2 t; t.x = pk2(w[j][0], w[j][1]); t.y = pk2(w[j][2], w[j][3]); o9[64 * j] = t; } }
          } }
        { const int* pos = (const int*)karg(I_POS); f32x2* rope = (f32x2*)(KWS + O_ROPE);
          for (long i = GT; i < (long)T * 16; i += NGT) { const int t = (int)(i >> 4), fi = (int)(i & 15);
            const float invf = (float)exp2(-(double)fi * 0.83048202372184058696); const float ang = (float)pos[t] * invf;
            rope[i] = (f32x2){cosf(ang), sinf(ang)}; } }
        {
            const int lane = LANE; LAS float* scr = (LAS float*)(lds + WID * 16384);
            constexpr int I_GU = 16 * 176, I_D = 44 * 32, I_IN = 16 * 96, I_UQ = 4 * 24, I_UK = 2 * 16, I_OA = 8 * 32, I_OUT = 16 * 32;
            constexpr int NITEMS = 2 * I_GU + 2 * I_D + I_IN + I_UQ + 2 * I_UK + 3 * I_OA + I_OUT;
            for (int it = GW; it < NITEMS; it += NGW) {
                int r = it;
                if (r < I_GU) { prep_item(FGateUp{INF(I_WG1), INF(I_WU1), INF(I_N1)}, D, 176, WSB(O_WGU1), scr, r, lane); continue; } r -= I_GU;
                if (r < I_GU) { prep_item(FGateUp{INF(I_WG2), INF(I_WU2), INF(I_N2)}, D, 176, WSB(O_WGU2), scr, r, lane); continue; } r -= I_GU;
                if (r < I_D) { prep_item(FPlain{INF(I_WD1), D}, FF, 32, WSB(O_WD1), scr, r, lane); continue; } r -= I_D;
                if (r < I_D) { prep_item(FPlain{INF(I_WD2), D}, FF, 32, WSB(O_WD2), scr, r, lane); continue; } r -= I_D;
                if (r < I_IN) { prep_item(FWin{INF(I_WIN), INF(I_NMIX)}, D, 96, WSB(O_WIN), scr, r, lane); continue; } r -= I_IN;
                if (r < I_UQ) { prep_item(FWuq{INF(I_WUQ), INF(I_QN)}, 256, 24, WSB(O_WUQ), scr, r, lane); continue; } r -= I_UQ;
                if (r < I_UK) { prep_item(FWukv{INF(I_WUKV), INF(I_KVN), 0}, 128, 16, WSB(O_WUK), scr, r, lane); continue; } r -= I_UK;
                if (r < I_UK) { prep_item(FWukv{INF(I_WUKV), INF(I_KVN), 64}, 128, 16, WSB(O_WUV), scr, r, lane); continue; } r -= I_UK;
                if (r < I_OA) { prep_item(FPlain{INF(I_WOA), D}, 512, 32, WSB(O_WOA), scr, r, lane); continue; } r -= I_OA;
                if (r < I_OA) { prep_item(FWglu{INF(I_WGLU)}, 512, 32, WSB(O_WGLU), scr, r, lane); continue; } r -= I_OA;
                if (r < I_OA) { prep_item(FPlain{INF(I_WOS), D}, 512, 32, WSB(O_WOS), scr, r, lane); continue; } r -= I_OA;
                prep_item(FPlain{INF(I_WOUT), D}, D, 32, WSB(O_WOUT), scr, r, lane);
            }
        }
        { const float *ilre = INF(I_LRE), *ilim = INF(I_LIM), *ildt = INF(I_LDT), *ibre = INF(I_BRE), *ibim = INF(I_BIM), *icre = INF(I_CRE), *icim = INF(I_CIM); float* kt = WSF(O_KT);
          for (long it = GT; it < 131072; it += NGT) {
            const int pq = (int)it & 3, i = ((int)it >> 2) & 15, d = ((int)it >> 6) & 31, dir = ((int)it >> 11) & 1, g = (int)it >> 12, dg = dir * 32 + g;
            const float dt = expf(ildt[dg]); float a16[16];
#pragma unroll
            for (int q = 0; q < 16; ++q) a16[q] = 0.f;
            for (int p = pq * 16; p < pq * 16 + 16; ++p) {
                const float lre = ilre[dg * 64 + p], lim = ilim[dg * 64 + p]; float kr_, ki_, pr, pi;
                lam_kfac(lre, lim, dt, kr_, ki_); lam_pow(lre, lim, dt, (float)d, pr, pi);
                const float cr = icre[(dg * 16 + i) * 64 + p], ci = icim[(dg * 16 + i) * 64 + p];
                const float tr = cr * pr - ci * pi, ti = cr * pi + ci * pr, gr = tr * kr_ - ti * ki_, gi = tr * ki_ + ti * kr_;
                const f32x4* br = (const f32x4*)(ibre + (size_t)(dg * 64 + p) * 16); const f32x4* bi = (const f32x4*)(ibim + (size_t)(dg * 64 + p) * 16);
#pragma unroll
                for (int q = 0; q < 4; ++q) { const f32x4 x = br[q], y = bi[q];
#pragma unroll
                    for (int e = 0; e < 4; ++e) a16[4 * q + e] += gr * x[e] - gi * y[e]; }
            }
#pragma unroll
            for (int q = 0; q < 16; ++q) { a16[q] += __shfl_xor(a16[q], 1); a16[q] += __shfl_xor(a16[q], 2); }
            f32x4* o = (f32x4*)(kt + ((size_t)(g * 2 + dir) * 32 + d) * 256 + i * 16);
            if (pq == 0) {
#pragma unroll
            for (int q = 0; q < 4; ++q) o[q] = (f32x4){a16[4 * q], a16[4 * q + 1], a16[4 * q + 2], a16[4 * q + 3]}; }
          }
          bf16_t* wst = WSB(O_WST);
          for (long it = GT; it < 262144; it += NGT) {
            const int j = (int)it & 31, n = ((int)it >> 5) & 255, g = (int)it >> 13, dir = n >> 7, p = (n & 127) >> 1, ri = n & 1, dg = dir * 32 + g;
            const float dt = expf(ildt[dg]), lre = ilre[dg * 64 + p], lim = ilim[dg * 64 + p]; float kr_, ki_, pr, pi;
            lam_kfac(lre, lim, dt, kr_, ki_); lam_pow(lre, lim, dt, (float)(dir == 0 ? 31 - j : j), pr, pi);
            const float gr = pr * kr_ - pi * ki_, gi = pr * ki_ + pi * kr_;
            const f32x4* br = (const f32x4*)(ibre + (size_t)(dg * 64 + p) * 16); const f32x4* bi = (const f32x4*)(ibim + (size_t)(dg * 64 + p) * 16);
            f32x4 v[4];
#pragma unroll
            for (int q = 0; q < 4; ++q) { const f32x4 x = br[q], y = bi[q]; v[q] = ri ? (gr * y + gi * x) : (gr * x - gi * y); }
            u32x4* o = (u32x4*)(wst + ((size_t)g * 256 + n) * 512 + j * 16);
            o[0] = pack8(v[0], v[1]); o[1] = pack8(v[2], v[3]);
          }
          bf16_t* wss2 = WSB(O_WSS2);
          for (long it = GT; it < 262144; it += NGT) {
            const int pc = (int)it & 7, dir = ((int)it >> 3) & 1, n = ((int)it >> 4) & 511, g = (int)it >> 13, tau = n >> 4, i = n & 15, dg = dir * 32 + g;
            const float dt = expf(ildt[dg]), e = (float)(dir == 0 ? tau + 1 : 32 - tau); float v[16];
#pragma unroll
            for (int q = 0; q < 8; ++q) { const int p = pc * 8 + q; float pr, pi; lam_pow(ilre[dg * 64 + p], ilim[dg * 64 + p], dt, e, pr, pi);
                const float cr = icre[(dg * 16 + i) * 64 + p], ci = icim[(dg * 16 + i) * 64 + p];
                v[2 * q] = cr * pr - ci * pi; v[2 * q + 1] = -(cr * pi + ci * pr); }
            u32x4* o = (u32x4*)(wss2 + ((size_t)g * 512 + n) * KP + 512 + dir * 128 + pc * 16);
            u32x4 w0, w1; w0.x = pk2(v[0], v[1]); w0.y = pk2(v[2], v[3]); w0.z = pk2(v[4], v[5]); w0.w = pk2(v[6], v[7]); w1.x = pk2(v[8], v[9]); w1.y = pk2(v[10], v[11]); w1.z = pk2(v[12], v[13]); w1.w = pk2(v[14], v[15]);
            o[0] = w0; o[1] = w1;
          }
          float* al = WSF(O_AL);
          for (long it = GT; it < 4096; it += NGT) { const int p = (int)it & 63, dir = ((int)it >> 6) & 1, g = (int)it >> 7, dg = dir * 32 + g; float pr, pi;
            lam_pow_exact(ilre[dg * 64 + p], ilim[dg * 64 + p], expf(ildt[dg]), 32.0f, pr, pi); al[it * 2] = pr; al[it * 2 + 1] = pi; }
        }
    }
    if (GG == 0x7fffffff) grid.sync();
    GRID_BAR();

    { const float* kt = WSF(O_KT); const float* dsk = INF(I_DSK); bf16_t* wss2 = WSB(O_WSS2);
      for (long it = GT; it < 524288; it += NGT) {
        const int j = (int)it & 31, n = ((int)it >> 5) & 511, g = (int)it >> 14, tau = n >> 4, i = n & 15;
        f32x4 v[4];
#pragma unroll
        for (int q = 0; q < 4; ++q) v[q] = (f32x4){0.f, 0.f, 0.f, 0.f};
        if (j <= tau) { const f32x4* s = (const f32x4*)(kt + ((size_t)(g * 2 + 0) * 32 + (tau - j)) * 256 + i * 16);
#pragma unroll
            for (int q = 0; q < 4; ++q) v[q] += s[q]; }
        if (j >= tau) { const f32x4* s = (const f32x4*)(kt + ((size_t)(g * 2 + 1) * 32 + (j - tau)) * 256 + i * 16);
#pragma unroll
            for (int q = 0; q < 4; ++q) v[q] += s[q]; }
        if (j == tau) { const float dv = dsk[g * 16 + i];
#pragma unroll
            for (int q = 0; q < 4; ++q)
#pragma unroll
                for (int e = 0; e < 4; ++e) if (4 * q + e == i) v[q][e] += dv; }
        u32x4* o = (u32x4*)(wss2 + ((size_t)g * 512 + n) * KP + j * 16);
        o[0] = pack8(v[0], v[1]); o[1] = pack8(v[2], v[3]);
      } }
    { pg8::Gemm g{WSB(O_HB), WSB(O_WGU1), D, D, D, 0, 0}; pg8::Order S; S.init(T / 256, 22, 1, GG, CC); EpiSwiglu E{SSQ(0), WSB(O_ACT)}; pg8::gemm_phase(lds, wid_s, g, S, E); }
    GRID_BAR();
    { pg8::Gemm g{WSB(O_ACT), WSB(O_WD1), FF, FF, FF, 0, 0}; pg8::Order S; S.init(T / 256, 4, 1, GG, CC); EpiResid E{INF(I_X), WSF(O_H), 0.5f, WSB(O_HB), SSQ(1)}; pg8::gemm_phase(lds, wid_s, g, S, E); }
    GRID_BAR();
    { pg8::Gemm g{WSB(O_HB), WSB(O_WIN), D, D, D, 0, 0}; pg8::Order S; S.init(T / 256, 12, 1, GG, CC); EpiWin E{SSQ(0), (const f32x2*)(KWS + O_ROPE), KWS, (bf16_t*)KOUT}; pg8::gemm_phase(lds, wid_s, g, S, E); }
    GRID_BAR();
    { pg8::Gemm g{WSB(O_CQ), WSB(O_WUQ), 256, 256, 256, 0, 0}; pg8::Order S; S.init(T / 256, 3, 1, GG, CC); EpiQ E{SSQ(2), (const f32x2*)(KWS + O_ROPE), WSB(O_Q)}; pg8::gemm_phase(lds, wid_s, g, S, E); }
    { pg8::Gemm g{WSB(O_CKV), WSB(O_WUK), 128, 128, 128, 0, 0}; pg8::Order S; S.init(T / 256, 2, 1, GG, CC); EpiRowScale E{SSQ(3), 1.0f / 128, WSB(O_KN), 512}; pg8::gemm_phase(lds, wid_s, g, S, E); }
    { pg8::Gemm g{WSB(O_WUV), WSB(O_CKV), 128, 128, 128, 0, 0}; pg8::Order S; S.init(2, T / 256, 1, GG, CC); EpiVt E{SSQ(3), WSB(O_VT)}; pg8::gemm_phase(lds, wid_s, g, S, E); }
    { pg8::Gemm g{WSB(O_APACK), WSB(O_WST), KP, 512, 512, (size_t)MG * KP, (size_t)256 * 512}; pg8::Order S; S.init(MG / 256, 1, 32, GG, CC); EpiSloc E{WSF(O_SLOC)}; pg8::gemm_phase(lds, wid_s, g, S, E); }
    GRID_BAR();
    { const float* al = WSF(O_AL); const float* sloc = WSF(O_SLOC); bf16_t* apack = WSB(O_APACK); const int G = GG;
      for (int it = WID * G + CC; it < 512; it += 8 * G) {
        const int dir = it & 1, g = (it >> 1) & 31, b = it >> 6, p = LANE;
        const float ar = al[((g * 2 + dir) * 64 + p) * 2], ai_ = al[((g * 2 + dir) * 64 + p) * 2 + 1];
        float hr = 0.f, hi = 0.f;
        for (int c0 = 0; c0 < NCH; c0 += 32) {
            f32x2 s[32];
#pragma unroll
            for (int e = 0; e < 32; ++e) { const int cc = dir ? NCH - 1 - (c0 + e) : c0 + e; s[e] = *(const f32x2*)(sloc + ((size_t)g * MG + b * NCH + cc) * 256 + dir * 128 + 2 * p); }
#pragma unroll
            for (int e = 0; e < 32; ++e) { const int cc = dir ? NCH - 1 - (c0 + e) : c0 + e;
                *(unsigned*)(apack + ((size_t)g * MG + b * NCH + cc) * KP + 512 + dir * 128 + 2 * p) = pk2(hr, hi);
                const float nr = ar * hr - ai_ * hi + s[e][0], ni = ar * hi + ai_ * hr + s[e][1]; hr = nr; hi = ni; }
        }
      } }
    attn_phase(lds, wid_s, WSB(O_Q), WSB(O_KN), WSB(O_KR), WSB(O_VT), WSB(O_ATTN), GG, CC);
    GRID_BAR();
    { pg8::Gemm g{WSB(O_APACK), WSB(O_WSS2), KP, KP, KP, (size_t)MG * KP, (size_t)512 * KP}; pg8::Order S; S.init(MG / 256, 2, 32, GG, CC); EpiSsmOut E{WSB(O_GY)}; pg8::gemm_phase(lds, wid_s, g, S, E); }
    { pg8::Gemm g{WSB(O_ATTN), WSB(O_WOA), 512, 512, 512, 0, 0}; pg8::Order S; S.init(T / 256, 4, 1, GG, CC); EpiGate<0> E{(const bf16_t*)KOUT, nullptr, WSB(O_MRG)}; pg8::gemm_phase(lds, wid_s, g, S, E); }
    GRID_BAR();
    { pg8::Gemm g{WSB(O_GY), WSB(O_WGLU), 512, 512, 512, 0, 0}; pg8::Order S; S.init(T / 256, 4, 1, GG, CC); EpiGlu E{INF(I_BGLU), WSB(O_SO)}; pg8::gemm_phase(lds, wid_s, g, S, E); }
    GRID_BAR();
    { pg8::Gemm g{WSB(O_SO), WSB(O_WOS), 512, 512, 512, 0, 0}; pg8::Order S; S.init(T / 256, 4, 1, GG, CC); EpiGate<1> E{(const bf16_t*)KOUT + (size_t)T * D, WSB(O_MRG), WSB(O_MG)}; pg8::gemm_phase(lds, wid_s, g, S, E); }
    GRID_BAR();
    { pg8::Gemm g{WSB(O_MG), WSB(O_WOUT), D, D, D, 0, 0}; pg8::Order S; S.init(T / 256, 4, 1, GG, CC); EpiResid E{WSF(O_H), WSF(O_H), 1.0f, WSB(O_HB), SSQ(4)}; pg8::gemm_phase(lds, wid_s, g, S, E); }
    GRID_BAR();
    { pg8::Gemm g{WSB(O_HB), WSB(O_WGU2), D, D, D, 0, 0}; pg8::Order S; S.init(T / 256, 22, 1, GG, CC); EpiSwiglu E{SSQ(4), WSB(O_ACT)}; pg8::gemm_phase(lds, wid_s, g, S, E); }
    GRID_BAR();
    if (GG == 256) {
        pg8::Gemm g{WSB(O_ACT), WSB(O_WD2), FF, FF, FF, 0, 0}; pg8::Order S; S.init(T / 256, 4, 1, GG, CC); EpiResidNorm E{WSF(O_H), KOUT, 0.5f, SSQ(5), (unsigned*)(KWS + O_PCNT), INF(I_NF)}; pg8::gemm_phase(lds, wid_s, g, S, E);
    } else {
    { pg8::Gemm g{WSB(O_ACT), WSB(O_WD2), FF, FF, FF, 0, 0}; pg8::Order S; S.init(T / 256, 4, 1, GG, CC); EpiResid E{WSF(O_H), KOUT, 0.5f, nullptr, SSQ(5)}; pg8::gemm_phase(lds, wid_s, g, S, E); }
    GRID_BAR();
    { const float* ssq4 = SSQ(5); float* out = KOUT; const f32x4* gn = (const f32x4*)INF(I_NF) + LANE; const int lane = LANE;
      for (int row = GW; row < T; row += NGW) {
        const float r = rstd_of(ssq4[row], 1.0f / D);
        f32x4* o = (f32x4*)(out + (size_t)row * D) + lane;
#pragma unroll
        for (int j = 0; j < 4; ++j) o[64 * j] = o[64 * j] * r * gn[64 * j];
      } }
    }
}

extern "C" void kernel_launch(void* const* d_in, const int* in_sizes, int n_in, void* d_out, int out_size, void* d_ws, size_t ws_size, hipStream_t stream) {
    static int grid = 0;
    if (grid == 0) {
        if (n_in != 30 || out_size != T * D || ws_size < WS_NEED) { fprintf(stderr, "kernel_launch: unexpected problem (n_in %d, out %d, ws %zu)\n", n_in, out_size, ws_size); grid = -1; return; }
        int dev = 0, cus = 0, per_cu = 0;
        (void)hipGetDevice(&dev); (void)hipDeviceGetAttribute(&cus, hipDeviceAttributeMultiprocessorCount, dev);
        if (hipFuncSetAttribute((const void*)fwd_megakernel, hipFuncAttributeMaxDynamicSharedMemorySize, LDS_BYTES) != hipSuccess) { fprintf(stderr, "kernel_launch: hipFuncSetAttribute failed\n"); grid = -1; return; }
        if (hipOccupancyMaxActiveBlocksPerMultiprocessor(&per_cu, (const void*)fwd_megakernel, 512, LDS_BYTES) != hipSuccess || per_cu < 1) { fprintf(stderr, "kernel_launch: occupancy query gave %d\n", per_cu); per_cu = 1; }
        (void)hipGetLastError();
        grid = cus * per_cu; if (grid > 256) grid = 256; grid &= ~7; if (grid < 8) grid = 8;
    }
    if (grid < 0) return;
    if (hipMemsetAsync((char*)d_ws + O_CTL, 0, CTL_BYTES, stream) != hipSuccess) { fprintf(stderr, "kernel_launch: memset of the barrier words failed\n"); return; }
    Args a{};
    for (int i = 0; i < 30; ++i) a.in[i] = d_in[i];
    a.out = (float*)d_out; a.ws = (unsigned char*)d_ws;
    void* kargs[] = {&a};
    hipError_t e = hipLaunchCooperativeKernel((const void*)fwd_megakernel, dim3(grid), dim3(512), kargs, LDS_BYTES, stream);
    if (e != hipSuccess) fprintf(stderr, "cooperative launch failed: %s (grid %d)\n", hipGetErrorString(e), grid);
}
```

```cpp
#include <hip/hip_runtime.h>
#include <hip/hip_cooperative_groups.h>
#include <cstdio>
#include <cstdint>
namespace cg = cooperative_groups;

#define LAS __attribute__((address_space(3)))
#define DI __device__ __forceinline__
typedef unsigned short bf16_t;
typedef short bf16x8 __attribute__((ext_vector_type(8)));
typedef short s16x4 __attribute__((ext_vector_type(4)));
typedef float f32x2 __attribute__((ext_vector_type(2)));
typedef float f32x4 __attribute__((ext_vector_type(4)));
typedef float f32x16 __attribute__((ext_vector_type(16)));
typedef unsigned u32x2 __attribute__((ext_vector_type(2)));
typedef unsigned u32x4 __attribute__((ext_vector_type(4)));
typedef __bf16 bf16x2_t __attribute__((ext_vector_type(2)));

constexpr int NB = 8, SEQ = 8192, T = NB * SEQ, D = 1024, FF = 2816, NH = 8;
constexpr int NIN = 3072;
constexpr int CL = 32, NCH = SEQ / CL;
constexpr int MG = T / CL;
constexpr int KP = 768;
constexpr float EPS = 1e-6f;
constexpr float QSCALE = 0.14724438f;

constexpr size_t MiB = 1u << 20, QM = MiB / 4;
constexpr size_t O_WGU1 = 0, O_WD1 = 11 * MiB, O_WGU2 = O_WD1 + 22 * QM, O_WD2 = O_WGU2 + 11 * MiB, O_WIN = O_WD2 + 22 * QM;
constexpr size_t O_WUQ = O_WIN + 6 * MiB, O_WUK = O_WUQ + 2 * QM, O_WUV = O_WUK + QM, O_WOA = O_WUV + QM, O_WGLU = O_WOA + MiB, O_WOS = O_WGLU + MiB, O_WOUT = O_WOS + MiB;
constexpr size_t O_WST = O_WOUT + 2 * MiB, O_WSS2 = O_WST + 8 * MiB, O_KT = O_WSS2 + 24 * MiB, O_AL = O_KT + 2 * MiB, O_SSQ = O_AL + QM;
constexpr size_t O_ROPE = O_SSQ + 6 * QM, O_HB = O_ROPE + 8 * MiB, O_H = O_HB + 128 * MiB, O_ACT = O_H + 256 * MiB, O_R4 = O_ACT + 352 * MiB;
constexpr size_t O_CQ = O_ACT, O_CKV = O_CQ + 32 * MiB, O_KR = O_CKV + 16 * MiB, O_APACK = O_KR + 4 * MiB, O_Q = O_APACK + 96 * MiB, O_KN = O_Q + 96 * MiB;
constexpr size_t O_MG = O_Q, O_MRG = O_HB;
constexpr size_t O_VT = O_R4, O_SLOC = O_VT + 64 * MiB, O_ATTN = O_SLOC + 64 * MiB, O_END = O_ATTN + 64 * MiB, O_GY = O_VT, O_SO = O_SLOC;
static_assert(O_KN + 64 * MiB <= O_R4, "act overlay");
constexpr size_t O_CTL = O_END, CTL_BYTES = 32768, O_PCNT = O_CTL + 16384, WS_NEED = O_CTL + CTL_BYTES;
static_assert(WS_NEED <= 1024 * MiB, "workspace");
static_assert(O_WIN == 33 * MiB && O_ROPE % 256 == 0 && O_HB % 256 == 0, "map");

DI unsigned pk2(float lo, float hi) { f32x2 v = {lo, hi}; bf16x2_t b = __builtin_convertvector(v, bf16x2_t); return __builtin_bit_cast(unsigned, b); }
DI float bflo(unsigned u) { return __builtin_bit_cast(float, u << 16); }
DI float bfhi(unsigned u) { return __builtin_bit_cast(float, u & 0xffff0000u); }
DI float sigm(float x) { return __builtin_amdgcn_rcpf(1.0f + __expf(-x)); }
DI float silu(float x) { return x * sigm(x); }
DI float gelu_tanh(float x) { const float z = 1.5957691216f * (x + 0.044715f * x * x * x); return x * sigm(z); }
DI float wave_sum(float v) {
#pragma unroll
    for (int o = 1; o < 64; o <<= 1) v += __shfl_xor(v, o);
    return v;
}
DI int lane_id() { int l; asm volatile("v_mbcnt_lo_u32_b32 %0, -1, 0\n\tv_mbcnt_hi_u32_b32 %0, -1, %0" : "=v"(l)); return l; }
DI float max3f(float a, float b, float c) { return __builtin_fmaxf(__builtin_fmaxf(a, b), c); }
DI u32x4 pack8(f32x4 a, f32x4 b) { u32x4 w; w.x = pk2(a[0], a[1]); w.y = pk2(a[2], a[3]); w.z = pk2(b[0], b[1]); w.w = pk2(b[2], b[3]); return w; }

namespace pg8 {
constexpr int BM = 256, BK = 64, HALF = 128, HTB = HALF * BK * 2, STAGE_BYTES = 8 * HTB, NXCD = 8, WGM = 8;
DI int lds_byte(int r, int c) { const int st = (r >> 4) * 2 + (c >> 5), rr = r & 15, cc = c & 31, ob = rr * 64 + cc * 2; return st * 1024 + (ob ^ (((ob >> 9) & 1) << 5)); }
DI void stage_rc(int b, int& R, int& C) { const int st = b / 1024, sb = b % 1024, swz = sb ^ (((sb >> 9) & 1) << 5); R = (st >> 1) * 16 + swz / 64; C = (st & 1) * 32 + (swz % 64) / 2; }
DI int perm32(int rho) { const int n = rho >> 4, i = rho & 15; return 8 * (i >> 2) + 4 * n + (i & 3); }

struct Unit { int g, pm, pn; };
struct Gemm { const bf16_t* A; const bf16_t* Bt; int lda, ldb, K; size_t gsA, gsB; };
struct Order {
    int nM, nN, nwg, total, G, c;
    DI void init(int nM_, int nN_, int ngroups, int G_, int c_) { nM = nM_; nN = nN_; nwg = nM * nN; total = nwg * ngroups; G = G_; c = c_; }
    DI bool next(int i, Unit& u) const {
        const long L = (long)i * G + c; if (L >= total) return false;
        u.g = (int)(L / nwg); int wgid = (int)(L % nwg);
        { const int q = nwg / NXCD, r = nwg % NXCD, xcd = wgid % NXCD, off = wgid / NXCD; wgid = (xcd < r ? xcd * (q + 1) : r * (q + 1) + (xcd - r) * q) + off; }
        const int nig = WGM * nN, gid = wgid / nig, fm = gid * WGM, gsz = (nM - fm) < WGM ? (nM - fm) : WGM;
        u.pm = fm + ((wgid % nig) % gsz); u.pn = (wgid % nig) / gsz; return true;
    }
};

template <class Epi>
DI void gemm_phase(LAS unsigned char* lds, const int wid, const Gemm g, const Order& S, const Epi& E) {
    const int lane = lane_id(), tid = wid * 64 + lane, wr = wid >> 2, wc = wid & 3, fr = lane & 15, fq = lane >> 4;
    const int K = g.K, nt = K / BK;
    unsigned voffA[2], voffB[2];
#pragma unroll
    for (int i = 0; i < 2; ++i) { int R, C; stage_rc(tid * 16 + i * 8192, R, C); const int Rb = (R & ~31) + perm32(R & 31);
        voffA[i] = (unsigned)(R * g.lda + C) * 2u; voffB[i] = (unsigned)(Rb * g.ldb + C) * 2u; }
    const size_t kstep = (size_t)(BK * 2);
    const size_t hstepA = (size_t)HALF * g.lda * 2, hstepB = (size_t)HALF * g.ldb * 2;
    const unsigned ldsw = (unsigned)wid * 1024u;
    const int aoff = lds_byte(wr * 64 + fr, fq * 8), boff = lds_byte(wc * 32 + fr, fq * 8);
#define PG8_SA(b, h) (((b) * 2 + (h)) * HTB)
#define PG8_SB(b, h) ((4 + (b) * 2 + (h)) * HTB)
#define PG8_STAGE(bufoff, gbase, voff) do { _Pragma("unroll") for (int _i = 0; _i < 2; ++_i) \
        __builtin_amdgcn_global_load_lds((const unsigned*)((const char*)(gbase) + (voff)[_i]), (LAS unsigned*)(lds + (bufoff) + ldsw + _i * 8192), 16, 0, 0); } while (0)
#define PG8_LDA(dst, b, h) do { _Pragma("unroll") for (int m = 0; m < 4; ++m) _Pragma("unroll") for (int k = 0; k < 2; ++k) dst[m][k] = *(const LAS bf16x8*)(lds + PG8_SA(b, h) + aoff + m * 2048 + k * 1024); } while (0)
#define PG8_LDB(dst, b, h) do { _Pragma("unroll") for (int n = 0; n < 2; ++n) _Pragma("unroll") for (int k = 0; k < 2; ++k) dst[n][k] = *(const LAS bf16x8*)(lds + PG8_SB(b, h) + boff + n * 2048 + k * 1024); } while (0)
#define PG8_MMA(ai, bj, At, Bt) do { __builtin_amdgcn_s_setprio(1); _Pragma("unroll") for (int m = 0; m < 4; ++m) _Pragma("unroll") for (int n = 0; n < 2; ++n) _Pragma("unroll") for (int k = 0; k < 2; ++k) \
        acc[ai][bj][m][n] = __builtin_amdgcn_mfma_f32_16x16x32_bf16(Bt[n][k], At[m][k], acc[ai][bj][m][n], 0, 0, 0); __builtin_amdgcn_s_setprio(0); } while (0)
#define PG8_WAIT_V(n) asm volatile("s_waitcnt vmcnt(" #n ")" ::: "memory")
#define PG8_WAIT_L(n) asm volatile("s_waitcnt lgkmcnt(" #n ")" ::: "memory")
#define PG8_BAR __builtin_amdgcn_s_barrier()
#define PG8_SCHED __builtin_amdgcn_sched_barrier(0)
    Unit cur, nxt; int ui = 0;
    if (!S.next(0, cur)) return;
    f32x4 acc[2][2][4][2];
#pragma unroll
    for (int a = 0; a < 2; ++a)
#pragma unroll
        for (int b = 0; b < 2; ++b)
#pragma unroll
            for (int m = 0; m < 4; ++m)
#pragma unroll
                for (int n = 0; n < 2; ++n) acc[a][b][m][n] = (f32x4){0.f, 0.f, 0.f, 0.f};
    bf16x8 At[4][2], B0[2][2], B1[2][2];
    const char* cA = (const char*)(g.A + (size_t)cur.g * g.gsA + (size_t)cur.pm * BM * g.lda);
    const char* cB = (const char*)(g.Bt + (size_t)cur.g * g.gsB + (size_t)cur.pn * BM * g.ldb);
    PG8_STAGE(PG8_SB(0, 0), cB, voffB); PG8_STAGE(PG8_SB(0, 1), cB + hstepB, voffB); PG8_STAGE(PG8_SA(0, 0), cA, voffA); PG8_STAGE(PG8_SA(0, 1), cA + hstepA, voffA);
    if (wr == 1) PG8_BAR;
    PG8_WAIT_V(2); PG8_BAR;
    PG8_STAGE(PG8_SB(1, 0), cB + kstep, voffB); PG8_STAGE(PG8_SA(1, 0), cA + kstep, voffA); PG8_STAGE(PG8_SB(1, 1), cB + hstepB + kstep, voffB);
    PG8_WAIT_V(6); PG8_BAR;
    for (;;) {
        const bool has_next = S.next(ui + 1, nxt);
        const char* nA = has_next ? (const char*)(g.A + (size_t)nxt.g * g.gsA + (size_t)nxt.pm * BM * g.lda) : cA;
        const char* nB = has_next ? (const char*)(g.Bt + (size_t)nxt.g * g.gsB + (size_t)nxt.pn * BM * g.ldb) : cB;
        for (int t = 0; t < nt; t += 2) {
            const bool last = (t == nt - 2);
            const char* a1 = cA + (size_t)(t + 1) * kstep;
            const char* a2 = last ? nA : cA + (size_t)(t + 2) * kstep; const char* b2 = last ? nB : cB + (size_t)(t + 2) * kstep;
            const char* a3 = a2 + kstep; const char* b3 = b2 + kstep;
            PG8_LDB(B0, 0, 0); PG8_LDB(B1, 0, 1); PG8_SCHED; PG8_LDA(At, 0, 0); PG8_STAGE(PG8_SA(1, 1), a1 + hstepA, voffA);
            PG8_WAIT_V(8); PG8_WAIT_L(0); PG8_BAR; PG8_MMA(0, 0, At, B0); PG8_MMA(0, 1, At, B1); PG8_BAR; PG8_SCHED;
            PG8_LDA(At, 0, 1); PG8_STAGE(PG8_SB(0, 0), b2, voffB); PG8_STAGE(PG8_SB(0, 1), b2 + hstepB, voffB); PG8_STAGE(PG8_SA(0, 0), a2, voffA);
            PG8_WAIT_V(8); PG8_WAIT_L(0); PG8_BAR; PG8_MMA(1, 0, At, B0); PG8_MMA(1, 1, At, B1); PG8_BAR; PG8_SCHED;
            PG8_LDB(B0, 1, 0); PG8_LDB(B1, 1, 1); PG8_SCHED; PG8_LDA(At, 1, 0); PG8_STAGE(PG8_SA(0, 1), a2 + hstepA, voffA);
            PG8_WAIT_V(8); PG8_WAIT_L(0); PG8_BAR; PG8_MMA(0, 0, At, B0); PG8_MMA(0, 1, At, B1); PG8_BAR; PG8_SCHED;
            PG8_LDA(At, 1, 1); PG8_STAGE(PG8_SB(1, 0), b3, voffB); PG8_STAGE(PG8_SB(1, 1), b3 + hstepB, voffB); PG8_STAGE(PG8_SA(1, 0), a3, voffA);
            PG8_WAIT_V(8); PG8_WAIT_L(0); PG8_BAR; PG8_MMA(1, 0, At, B0); PG8_MMA(1, 1, At, B1); PG8_BAR; PG8_SCHED;
        }
        if (wr == 0) PG8_BAR;
        { const int le = lane_id(); E(acc, cur, wr, wc, le & 15, le >> 4); }
        if (!has_next) break;
#pragma unroll
        for (int a = 0; a < 2; ++a)
#pragma unroll
            for (int b = 0; b < 2; ++b)
#pragma unroll
                for (int m = 0; m < 4; ++m)
#pragma unroll
                    for (int n = 0; n < 2; ++n) acc[a][b][m][n] = (f32x4){0.f, 0.f, 0.f, 0.f};
        cur = nxt; cA = nA; cB = nB; ++ui;
        if (wr == 1) PG8_BAR;
    }
    PG8_WAIT_V(0);
    PG8_BAR;
#undef PG8_SA
#undef PG8_SB
#undef PG8_STAGE
#undef PG8_LDA
#undef PG8_LDB
#undef PG8_MMA
#undef PG8_WAIT_V
#undef PG8_WAIT_L
#undef PG8_BAR
#undef PG8_SCHED
}
}
using pg8::Unit;
typedef f32x4 Acc[2][2][4][2];

#define EPI_ROWS(ai, m) _Pragma("unroll") for (int ai = 0; ai < 2; ++ai) _Pragma("unroll") for (int m = 0; m < 4; ++m)
#define EPI_FENCE() asm volatile("" ::: "memory")
#define EPI_RSTD8(rr, ssqp, invn) float rr[2][4]; EPI_ROWS(ai, m) rr[ai][m] = (ssqp)[epi_row(u, ai, wr, m, fr)]; EPI_FENCE(); EPI_ROWS(ai, m) rr[ai][m] = rstd_of(rr[ai][m], invn);
DI int epi_row(const Unit& u, int ai, int wr, int m, int fr) { return u.pm * 256 + ai * 128 + wr * 64 + m * 16 + fr; }
DI int epi_col(const Unit& u, int bj, int wc, int fq) { return u.pn * 256 + bj * 128 + wc * 32 + 8 * fq; }
DI float rstd_of(float ssq, float invn) { return __builtin_amdgcn_rsqf(ssq * invn + EPS); }

struct EpiSwiglu {
    const float* ssq; bf16_t* act;
    DI void operator()(const Acc& acc, const Unit& u, int wr, int wc, int fr, int fq) const {
        const int cb = u.pn * 128 + wc * 32 + 8 * fq;
        EPI_RSTD8(rr, ssq, 1.0f / D)
        EPI_ROWS(ai, m) { const int row = epi_row(u, ai, wr, m, fr); const float r = rr[ai][m];
            f32x4 v[2];
#pragma unroll
            for (int n = 0; n < 2; ++n)
#pragma unroll
                for (int j = 0; j < 4; ++j) v[n][j] = silu(acc[ai][0][m][n][j] * r) * (acc[ai][1][m][n][j] * r);
            *(u32x4*)(act + (size_t)row * FF + cb) = pack8(v[0], v[1]); }
    }
};
struct EpiResid {
    const float* res; float* out; float alpha; bf16_t* ob; float* ssq;
    DI void operator()(const Acc& acc, const Unit& u, int wr, int wc, int fr, int fq) const {
#pragma unroll
        for (int ai = 0; ai < 2; ++ai) {
            f32x4 pre[4][2][2];
#pragma unroll
            for (int m = 0; m < 4; ++m)
#pragma unroll
                for (int bj = 0; bj < 2; ++bj) { const size_t off = (size_t)epi_row(u, ai, wr, m, fr) * D + epi_col(u, bj, wc, fq);
                    pre[m][bj][0] = *(const f32x4*)(res + off); pre[m][bj][1] = *(const f32x4*)(res + off + 4); }
            EPI_FENCE();
#pragma unroll
            for (int m = 0; m < 4; ++m) { const int row = epi_row(u, ai, wr, m, fr); float sq = 0.f;
#pragma unroll
                for (int bj = 0; bj < 2; ++bj) { const size_t off = (size_t)row * D + epi_col(u, bj, wc, fq);
                    const f32x4 o0 = pre[m][bj][0] + alpha * acc[ai][bj][m][0], o1 = pre[m][bj][1] + alpha * acc[ai][bj][m][1];
                    *(f32x4*)(out + off) = o0; *(f32x4*)(out + off + 4) = o1;
                    if (ob) *(u32x4*)(ob + off) = pack8(o0, o1);
                    sq += (o0[0] * o0[0] + o0[1] * o0[1]) + (o0[2] * o0[2] + o0[3] * o0[3]) + (o1[0] * o1[0] + o1[1] * o1[1]) + (o1[2] * o1[2] + o1[3] * o1[3]); }
                sq += __shfl_xor(sq, 16); sq += __shfl_xor(sq, 32);
                if (fq == 0) unsafeAtomicAdd(ssq + row, sq); }
            EPI_FENCE();
        }
    }
};
struct EpiResidNorm {
    const float* res; float* out; float alpha; float* ssq; unsigned* pcnt; const float* gain;
    DI void operator()(Acc& acc, const Unit& u, int wr, int wc, int fr, int fq) const {
#pragma unroll
        for (int ai = 0; ai < 2; ++ai) {
            f32x4 pre[4][2][2];
#pragma unroll
            for (int m = 0; m < 4; ++m)
#pragma unroll
                for (int bj = 0; bj < 2; ++bj) { const size_t off = (size_t)epi_row(u, ai, wr, m, fr) * D + epi_col(u, bj, wc, fq);
                    pre[m][bj][0] = *(const f32x4*)(res + off); pre[m][bj][1] = *(const f32x4*)(res + off + 4); }
            EPI_FENCE();
#pragma unroll
            for (int m = 0; m < 4; ++m) { const int row = epi_row(u, ai, wr, m, fr); float sq = 0.f;
#pragma unroll
                for (int bj = 0; bj < 2; ++bj) {
                    const f32x4 o0 = pre[m][bj][0] + alpha * acc[ai][bj][m][0], o1 = pre[m][bj][1] + alpha * acc[ai][bj][m][1];
                    acc[ai][bj][m][0] = o0; acc[ai][bj][m][1] = o1;
                    sq += (o0[0] * o0[0] + o0[1] * o0[1]) + (o0[2] * o0[2] + o0[3] * o0[3]) + (o1[0] * o1[0] + o1[1] * o1[1]) + (o1[2] * o1[2] + o1[3] * o1[3]); }
                sq += __shfl_xor(sq, 16); sq += __shfl_xor(sq, 32);
                if (fq == 0) unsafeAtomicAdd(ssq + row, sq); }
            EPI_FENCE();
        }
        asm volatile("s_waitcnt vmcnt(0)" ::: "memory");
        __syncthreads();
        if (wr == 0 && wc == 0 && fr == 0 && fq == 0) {
            unsigned* cp = pcnt + 16 * u.pm;
            __hip_atomic_fetch_add(cp, 1u, __ATOMIC_RELAXED, __HIP_MEMORY_SCOPE_AGENT);
            unsigned sp = 0;
            while (__hip_atomic_load(cp, __ATOMIC_RELAXED, __HIP_MEMORY_SCOPE_AGENT) < 4u) { __builtin_amdgcn_s_sleep(2); if (++sp > (1u << 22)) break; }
            __builtin_amdgcn_fence(__ATOMIC_ACQUIRE, "agent");
        }
        __syncthreads();
        float rr[2][4]; f32x4 gg[2][2];
        EPI_ROWS(ai, m) rr[ai][m] = __hip_atomic_load(ssq + epi_row(u, ai, wr, m, fr), __ATOMIC_RELAXED, __HIP_MEMORY_SCOPE_AGENT);
#pragma unroll
        for (int bj = 0; bj < 2; ++bj) { const int col = epi_col(u, bj, wc, fq); gg[bj][0] = *(const f32x4*)(gain + col); gg[bj][1] = *(const f32x4*)(gain + col + 4); }
        EPI_FENCE();
        EPI_ROWS(ai, m) { const int row = epi_row(u, ai, wr, m, fr); const float r = rstd_of(rr[ai][m], 1.0f / D);
#pragma unroll
            for (int bj = 0; bj < 2; ++bj) { const size_t off = (size_t)row * D + epi_col(u, bj, wc, fq);
                *(f32x4*)(out + off) = acc[ai][bj][m][0] * r * gg[bj][0]; *(f32x4*)(out + off + 4) = acc[ai][bj][m][1] * r * gg[bj][1]; } }
    }
};
struct EpiWin {
    float* ssq1; const f32x2* rope; unsigned char* ws; bf16_t* sga;
    DI void operator()(const Acc& acc, const Unit& u, int wr, int wc, int fr, int fq) const {
        const int pn = u.pn;
        const float* ssq2 = ssq1 + T; float* ssqq = ssq1 + 2 * T; float* ssqkv = ssq1 + 3 * T;
        bf16_t* cq = (bf16_t*)(ws + O_CQ); bf16_t* ckv = (bf16_t*)(ws + O_CKV); bf16_t* kr = (bf16_t*)(ws + O_KR); bf16_t* apack = (bf16_t*)(ws + O_APACK); bf16_t* sgs = sga + (size_t)T * D;
        EPI_RSTD8(rr, ssq2, 1.0f / D)
        EPI_ROWS(ai, m) { const int row = epi_row(u, ai, wr, m, fr); const float r = rr[ai][m];
            if (pn == 0) { float sq = 0.f;
#pragma unroll
                for (int bj = 0; bj < 2; ++bj) { const f32x4 a = acc[ai][bj][m][0] * r, b = acc[ai][bj][m][1] * r;
                    *(u32x4*)(cq + (size_t)row * 256 + bj * 128 + wc * 32 + 8 * fq) = pack8(a, b);
                    sq += (a[0] * a[0] + a[1] * a[1]) + (a[2] * a[2] + a[3] * a[3]) + (b[0] * b[0] + b[1] * b[1]) + (b[2] * b[2] + b[3] * b[3]); }
                sq += __shfl_xor(sq, 16); sq += __shfl_xor(sq, 32);
                if (fq == 0) unsafeAtomicAdd(ssqq + row, sq);
            } else if (pn == 1) {
                { const f32x4 a = acc[ai][0][m][0] * r, b = acc[ai][0][m][1] * r;
                  *(u32x4*)(ckv + (size_t)row * 128 + wc * 32 + 8 * fq) = pack8(a, b);
                  float sq = (a[0] * a[0] + a[1] * a[1]) + (a[2] * a[2] + a[3] * a[3]) + (b[0] * b[0] + b[1] * b[1]) + (b[2] * b[2] + b[3] * b[3]);
                  sq += __shfl_xor(sq, 16); sq += __shfl_xor(sq, 32);
                  if (fq == 0) unsafeAtomicAdd(ssqkv + row, sq); }
                if (wc == 0) {
                    const f32x4 a = acc[ai][1][m][0] * r, b = acc[ai][1][m][1] * r;
                    const f32x4 c0 = *(const f32x4*)(rope + (size_t)row * 16 + 4 * fq), c1 = *(const f32x4*)(rope + (size_t)row * 16 + 4 * fq + 2);
                    f32x4 oa, ob;
                    oa[0] = a[0] * c0[0] - a[1] * c0[1]; oa[1] = a[1] * c0[0] + a[0] * c0[1]; oa[2] = a[2] * c0[2] - a[3] * c0[3]; oa[3] = a[3] * c0[2] + a[2] * c0[3];
                    ob[0] = b[0] * c1[0] - b[1] * c1[1]; ob[1] = b[1] * c1[0] + b[0] * c1[1]; ob[2] = b[2] * c1[2] - b[3] * c1[3]; ob[3] = b[3] * c1[2] + b[2] * c1[3];
                    *(u32x4*)(kr + (size_t)row * 32 + 8 * fq) = pack8(oa, ob); }
            } else if (pn < 4) {
#pragma unroll
                for (int bj = 0; bj < 2; ++bj) { const int uc = (pn - 2) * 256 + bj * 128 + wc * 32 + 8 * fq; const int gg = uc >> 4, i0 = uc & 15;
                    *(u32x4*)(apack + ((size_t)gg * MG + (row >> 5)) * KP + (row & 31) * 16 + i0) = pack8(acc[ai][bj][m][0] * r, acc[ai][bj][m][1] * r); }
            } else { bf16_t* dst = pn < 8 ? sga : sgs; const int c0 = ((pn - 4) & 3) * 256;
#pragma unroll
                for (int bj = 0; bj < 2; ++bj) { f32x4 a, b;
#pragma unroll
                    for (int j = 0; j < 4; ++j) { a[j] = sigm(acc[ai][bj][m][0][j] * r); b[j] = sigm(acc[ai][bj][m][1][j] * r); }
                    *(u32x4*)(dst + (size_t)row * D + c0 + bj * 128 + wc * 32 + 8 * fq) = pack8(a, b); }
            } }
    }
};
struct EpiQ {
    const float* ssqq; const f32x2* rope; bf16_t* q;
    DI void operator()(const Acc& acc, const Unit& u, int wr, int wc, int fr, int fq_in) const {
        int fq = fq_in; asm volatile("" : "+v"(fq));
        EPI_RSTD8(rr, ssqq, 1.0f / 256)
#pragma unroll
        for (int bj = 0; bj < 2; ++bj) { const int c = epi_col(u, bj, wc, fq); const int d = c % 96; const bool rot = d >= 64; const int i0 = rot ? (d - 64) >> 1 : 0;
#pragma unroll
            for (int ai = 0; ai < 2; ++ai) {
                f32x4 cs[4][2];
#pragma unroll
                for (int m = 0; m < 4; ++m) { const f32x2* rp = rope + (size_t)epi_row(u, ai, wr, m, fr) * 16 + i0;
                    cs[m][0] = rot ? *(const f32x4*)rp : (f32x4){1.f, 0.f, 1.f, 0.f}; cs[m][1] = rot ? *(const f32x4*)(rp + 2) : (f32x4){1.f, 0.f, 1.f, 0.f}; }
                EPI_FENCE();
#pragma unroll
                for (int m = 0; m < 4; ++m) { const int row = epi_row(u, ai, wr, m, fr); const float r = rr[ai][m] * QSCALE;
                    f32x4 a = acc[ai][bj][m][0] * r, b = acc[ai][bj][m][1] * r;
                    if (rot) { const f32x4 c0 = cs[m][0], c1 = cs[m][1]; f32x4 oa, ob;
                        oa[0] = a[0] * c0[0] - a[1] * c0[1]; oa[1] = a[1] * c0[0] + a[0] * c0[1]; oa[2] = a[2] * c0[2] - a[3] * c0[3]; oa[3] = a[3] * c0[2] + a[2] * c0[3];
                        ob[0] = b[0] * c1[0] - b[1] * c1[1]; ob[1] = b[1] * c1[0] + b[0] * c1[1]; ob[2] = b[2] * c1[2] - b[3] * c1[3]; ob[3] = b[3] * c1[2] + b[2] * c1[3];
                        a = oa; b = ob; }
                    *(u32x4*)(q + (size_t)row * 768 + c) = pack8(a, b); }
                EPI_FENCE();
            } }
    }
};
struct EpiRowScale {
    const float* ssq; float invn; bf16_t* o; int ldo;
    DI void operator()(const Acc& acc, const Unit& u, int wr, int wc, int fr, int fq) const {
        EPI_RSTD8(rr, ssq, invn)
        EPI_ROWS(ai, m) { const int row = epi_row(u, ai, wr, m, fr); const float r = rr[ai][m];
#pragma unroll
            for (int bj = 0; bj < 2; ++bj) *(u32x4*)(o + (size_t)row * ldo + epi_col(u, bj, wc, fq)) = pack8(acc[ai][bj][m][0] * r, acc[ai][bj][m][1] * r); }
    }
};
struct EpiVt {
    const float* ssq; bf16_t* vt;
    DI void operator()(const Acc& acc, const Unit& u, int wr, int wc, int fr, int fq) const {
#pragma unroll
        for (int bj = 0; bj < 2; ++bj) { const int c = epi_col(u, bj, wc, fq);
            const f32x4 s0 = *(const f32x4*)(ssq + c), s1 = *(const f32x4*)(ssq + c + 4); f32x4 r0, r1;
#pragma unroll
            for (int j = 0; j < 4; ++j) { r0[j] = rstd_of(s0[j], 1.0f / 128); r1[j] = rstd_of(s1[j], 1.0f / 128); }
            EPI_ROWS(ai, m) { const int row = epi_row(u, ai, wr, m, fr);
                *(u32x4*)(vt + (size_t)row * T + c) = pack8(acc[ai][bj][m][0] * r0, acc[ai][bj][m][1] * r1); } }
    }
};
struct EpiSloc {
    float* sloc;
    DI void operator()(const Acc& acc, const Unit& u, int wr, int wc, int fr, int fq) const {
        EPI_ROWS(ai, m) { const int row = epi_row(u, ai, wr, m, fr);
#pragma unroll
            for (int bj = 0; bj < 2; ++bj) { float* p = sloc + ((size_t)u.g * MG + row) * 256 + bj * 128 + wc * 32 + 8 * fq;
                *(f32x4*)p = acc[ai][bj][m][0]; *(f32x4*)(p + 4) = acc[ai][bj][m][1]; } }
    }
};
struct EpiSsmOut {
    bf16_t* gy;
    DI void operator()(const Acc& acc, const Unit& u, int wr, int wc, int fr, int fq) const {
        EPI_ROWS(ai, m) { const int row = epi_row(u, ai, wr, m, fr);
#pragma unroll
            for (int bj = 0; bj < 2; ++bj) { const int c = epi_col(u, bj, wc, fq); const int tau = c >> 4, i0 = c & 15; f32x4 a, b;
#pragma unroll
                for (int j = 0; j < 4; ++j) { a[j] = gelu_tanh(acc[ai][bj][m][0][j]); b[j] = gelu_tanh(acc[ai][bj][m][1][j]); }
                *(u32x4*)(gy + ((size_t)row * CL + tau) * 512 + u.g * 16 + i0) = pack8(a, b); } }
    }
};
template <int MODE> struct EpiGate {
    const bf16_t* gate; const bf16_t* prev; bf16_t* o;
    DI void operator()(const Acc& acc, const Unit& u, int wr, int wc, int fr, int fq) const {
#pragma unroll
        for (int ai = 0; ai < 2; ++ai) {
            u32x4 gv[4][2], pv[4][2];
#pragma unroll
            for (int m = 0; m < 4; ++m)
#pragma unroll
                for (int bj = 0; bj < 2; ++bj) { const size_t off = (size_t)epi_row(u, ai, wr, m, fr) * D + epi_col(u, bj, wc, fq);
                    gv[m][bj] = *(const u32x4*)(gate + off); if (MODE == 1) pv[m][bj] = *(const u32x4*)(prev + off); }
            EPI_FENCE();
#pragma unroll
            for (int m = 0; m < 4; ++m)
#pragma unroll
                for (int bj = 0; bj < 2; ++bj) { const size_t off = (size_t)epi_row(u, ai, wr, m, fr) * D + epi_col(u, bj, wc, fq);
                    const u32x4 g = gv[m][bj]; f32x4 a, b;
                    a[0] = bflo(g.x) * acc[ai][bj][m][0][0]; a[1] = bfhi(g.x) * acc[ai][bj][m][0][1]; a[2] = bflo(g.y) * acc[ai][bj][m][0][2]; a[3] = bfhi(g.y) * acc[ai][bj][m][0][3];
                    b[0] = bflo(g.z) * acc[ai][bj][m][1][0]; b[1] = bfhi(g.z) * acc[ai][bj][m][1][1]; b[2] = bflo(g.w) * acc[ai][bj][m][1][2]; b[3] = bfhi(g.w) * acc[ai][bj][m][1][3];
                    if (MODE == 1) { const u32x4 p = pv[m][bj];
                        a[0] += bflo(p.x); a[1] += bfhi(p.x); a[2] += bflo(p.y); a[3] += bfhi(p.y); b[0] += bflo(p.z); b[1] += bfhi(p.z); b[2] += bflo(p.w); b[3] += bfhi(p.w); }
                    *(u32x4*)(o + off) = pack8(a, b); }
            EPI_FENCE();
        }
    }
};
struct EpiGlu {
    const float* bias; bf16_t* so;
    DI void operator()(const Acc& acc, const Unit& u, int wr, int wc, int fr, int fq) const {
        const int cb = u.pn * 128 + wc * 32 + 8 * fq;
        const f32x4 bv0 = *(const f32x4*)(bias + cb), bv1 = *(const f32x4*)(bias + cb + 4), bg0 = *(const f32x4*)(bias + 512 + cb), bg1 = *(const f32x4*)(bias + 512 + cb + 4);
        EPI_ROWS(ai, m) { const int row = epi_row(u, ai, wr, m, fr); f32x4 a, b;
#pragma unroll
            for (int j = 0; j < 4; ++j) { a[j] = (acc[ai][0][m][0][j] + bv0[j]) * sigm(acc[ai][1][m][0][j] + bg0[j]); b[j] = (acc[ai][0][m][1][j] + bv1[j]) * sigm(acc[ai][1][m][1][j] + bg1[j]); }
            *(u32x4*)(so + (size_t)row * 512 + cb) = pack8(a, b); }
    }
};

struct Args { const void* in[30]; float* out; unsigned char* ws; };
typedef __attribute__((address_space(4))) const char* kseg_t;
DI const void* karg(int idx) { kseg_t kp = (kseg_t)__builtin_amdgcn_kernarg_segment_ptr(); asm volatile("" : "+s"(kp)); return *(const void* const __attribute__((address_space(4)))*)(kp + idx * 8); }
#define INF(i) ((const float*)karg(i))
#define KOUT ((float*)karg(30))
#define KWS ((unsigned char*)karg(31))
enum { I_X = 0, I_POS, I_N1, I_WG1, I_WU1, I_WD1, I_NMIX, I_WIN, I_QN, I_WUQ, I_KVN, I_WUKV, I_WOA, I_LRE, I_LIM, I_LDT, I_BRE, I_BIM, I_CRE, I_CIM, I_DSK, I_WGLU, I_BGLU, I_WOS, I_WOUT, I_N2, I_WG2, I_WU2, I_WD2, I_NF };

template <class F> DI void prep_item(const F& f, int K, int nblk, bf16_t* WT, LAS float* scr, int item, int lane) {
    const int kb = item / nblk, nb = item % nblk, k0 = 64 * kb, n0 = 32 * nb;
#pragma unroll 8
    for (int i = 0; i < 32; ++i) { const int kk = 2 * i + (lane >> 5); scr[kk * 33 + (lane & 31)] = f(k0 + kk, n0 + (lane & 31)); }
    asm volatile("s_waitcnt lgkmcnt(0)" ::: "memory");
    const int c = lane & 7;
#pragma unroll
    for (int j = 0; j < 4; ++j) { const int n = (lane >> 3) + 8 * j; const LAS float* s = scr + (8 * c) * 33 + n;
        u32x4 o; o.x = pk2(s[0 * 33], s[1 * 33]); o.y = pk2(s[2 * 33], s[3 * 33]); o.z = pk2(s[4 * 33], s[5 * 33]); o.w = pk2(s[6 * 33], s[7 * 33]);
        *(u32x4*)(WT + (size_t)(n0 + n) * K + k0 + 8 * c) = o; }
    asm volatile("s_waitcnt lgkmcnt(0)" ::: "memory");
}
struct FGateUp { const float *wg, *wu, *gain; DI float operator()(int k, int n) const { const int col = (n >> 8) * 128 + (n & 127); const long delta = (n & 128) ? ((const char*)wu - (const char*)wg) : 0l; const float* w = (const float*)((const char*)wg + delta); return w[(size_t)k * FF + col] * gain[k]; } };
struct FPlain { const float* w; int N; DI float operator()(int k, int n) const { return w[(size_t)k * N + n]; } };
struct FWin { const float *w, *gain; DI float operator()(int k, int n) const {
    int src;
    if (n < 384) src = n; else if (n < 416) { const int j = n - 384; src = 384 + (j & 1) * 16 + (j >> 1); } else if (n < 512) src = -1; else src = n - 96;
    return src < 0 ? 0.f : w[(size_t)k * 2976 + src] * gain[k]; } };
struct FWuq { const float *w, *gain; DI float operator()(int k, int n) const { const int h = n / 96, d = n % 96; int src = n; if (d >= 64) { const int j = d - 64; src = h * 96 + 64 + (j & 1) * 16 + (j >> 1); } return w[(size_t)k * 768 + src] * gain[k]; } };
struct FWukv { const float *w, *gain; int off; DI float operator()(int k, int n) const { return w[(size_t)k * 1024 + (n >> 6) * 128 + off + (n & 63)] * gain[k]; } };
struct FWglu { const float* w; DI float operator()(int k, int n) const { return w[(size_t)k * 1024 + ((n >> 7) & 1) * 512 + (n >> 8) * 128 + (n & 127)]; } };

DI void lam_pow_exact(float lre, float lim, float dt, float e, float& pr, float& pi) { const float mag = expf(e * lre * dt), ang = e * (lim * dt); pr = mag * cosf(ang); pi = mag * sinf(ang); }
DI void lam_pow(float lre, float lim, float dt, float e, float& pr, float& pi) { const float mag = __expf(e * lre * dt); const float tu = __builtin_amdgcn_fractf(e * (lim * dt) * 0.15915494309189535f); pr = mag * __builtin_amdgcn_cosf(tu); pi = mag * __builtin_amdgcn_sinf(tu); }
DI void lam_kfac(float lre, float lim, float dt, float& kr, float& ki) { float br, bi; lam_pow(lre, lim, dt, 1.0f, br, bi); const float den = lre * lre + lim * lim, nr = br - 1.0f; kr = (nr * lre + bi * lim) / den; ki = (bi * lre - nr * lim) / den; }

constexpr int KS_STRIDE = 208, VS_STRIDE = 144, KS_BYTES = 64 * KS_STRIDE, VS_BYTES = 64 * VS_STRIDE, VOFF = 2 * KS_BYTES, NKT = SEQ / 64;
#define MFMA16(a_, b_, c_) __builtin_amdgcn_mfma_f32_16x16x32_bf16((a_), (b_), (c_), 0, 0, 0)
#define ATT_STEP(KTX, LKN, LKR, LVT, WKN, WKR, WVT, sc, sn) do { const int kt_ = (KTX); \
            if (kt_ + 3 < NKT) { const size_t k3 = (size_t)(kt_ + 3) * 64; LKN = *(const u32x4*)(gkn + k3 * 512); if (tid < 256) LKR = *(const u32x4*)(gkr + k3 * 32); } \
            if (kt_ + 2 < NKT) LVT = *(const u32x4*)(gvt + (size_t)(kt_ + 2) * 64); \
            float mx0 = max3f(sc[0][0][0], sc[0][0][1], sc[0][0][2]), mx1 = max3f(sc[0][1][0], sc[0][1][1], sc[0][1][2]); \
            mx0 = max3f(mx0, sc[0][0][3], sc[1][0][0]); mx1 = max3f(mx1, sc[0][1][3], sc[1][1][0]); \
            _Pragma("unroll") \
            for (int t4 = 1; t4 < 4; ++t4) { mx0 = max3f(mx0, sc[t4][0][1], sc[t4][0][2]); mx1 = max3f(mx1, sc[t4][1][1], sc[t4][1][2]); \
                if (t4 < 3) { mx0 = max3f(mx0, sc[t4][0][3], sc[t4 + 1][0][0]); mx1 = max3f(mx1, sc[t4][1][3], sc[t4 + 1][1][0]); } else { mx0 = fmaxf(mx0, sc[3][0][3]); mx1 = fmaxf(mx1, sc[3][1][3]); } } \
            const bool up_ = (kt_ == 0) | (mx0 > 6.0f) | (mx1 > 6.0f); \
            if (__builtin_amdgcn_ballot_w64(up_) != 0ull) {     \
                mx0 = fmaxf(mx0, __shfl_xor(mx0, 16)); mx0 = fmaxf(mx0, __shfl_xor(mx0, 32)); mx1 = fmaxf(mx1, __shfl_xor(mx1, 16)); mx1 = fmaxf(mx1, __shfl_xor(mx1, 32)); \
                const float d0 = ((kt_ == 0) | (mx0 > 6.0f)) ? mx0 : 0.f, d1 = ((kt_ == 0) | (mx1 > 6.0f)) ? mx1 : 0.f; \
                const float a0 = __builtin_amdgcn_exp2f(-d0), a1 = __builtin_amdgcn_exp2f(-d1); \
                l0 *= a0; l1 *= a1; negm0 -= d0; negm1 -= d1; \
                _Pragma("unroll") \
                for (int t4 = 0; t4 < 4; ++t4) { sc[t4][0] -= d0; sc[t4][1] -= d1; oacc[t4][0] *= a0; oacc[t4][1] *= a1; } \
            } \
            { const LAS unsigned char* kp = lds + ((kt_ + 1) & 1) * KS_BYTES + r16 * KS_STRIDE + qd * 16; \
              _Pragma("unroll") \
              for (int t4 = 0; t4 < 4; ++t4) { sn[t4][0] = negm0; sn[t4][1] = negm1; } \
              _Pragma("unroll") \
              for (int ks = 0; ks < 3; ++ks) \
              _Pragma("unroll") \
                for (int t4 = 0; t4 < 4; ++t4) { const bf16x8 kf = *(const LAS bf16x8*)(kp + t4 * 16 * KS_STRIDE + ks * 64); \
                    sn[t4][0] = MFMA16(kf, qf[0][ks], sn[t4][0]); sn[t4][1] = MFMA16(kf, qf[1][ks], sn[t4][1]); } } \
            { f32x4 p0 = {0.f, 0.f, 0.f, 0.f}, p1 = {0.f, 0.f, 0.f, 0.f}; \
              _Pragma("unroll") \
              for (int t4 = 0; t4 < 4; ++t4) \
              _Pragma("unroll") \
                for (int e = 0; e < 4; ++e) { sc[t4][0][e] = __builtin_amdgcn_exp2f(sc[t4][0][e]); sc[t4][1][e] = __builtin_amdgcn_exp2f(sc[t4][1][e]); p0[e] += sc[t4][0][e]; p1[e] += sc[t4][1][e]; } \
              l0 += (p0[0] + p0[1]) + (p0[2] + p0[3]); l1 += (p1[0] + p1[1]) + (p1[2] + p1[3]); } \
            { const LAS unsigned char* vp = lds + VOFF + (kt_ & 1) * VS_BYTES + r16 * VS_STRIDE + qd * 16; \
              _Pragma("unroll") \
              for (int kp2 = 0; kp2 < 2; ++kp2) { \
                  u32x4 w0, w1; \
                  w0.x = pk2(sc[2 * kp2][0][0], sc[2 * kp2][0][1]); w0.y = pk2(sc[2 * kp2][0][2], sc[2 * kp2][0][3]); w0.z = pk2(sc[2 * kp2 + 1][0][0], sc[2 * kp2 + 1][0][1]); w0.w = pk2(sc[2 * kp2 + 1][0][2], sc[2 * kp2 + 1][0][3]); \
                  w1.x = pk2(sc[2 * kp2][1][0], sc[2 * kp2][1][1]); w1.y = pk2(sc[2 * kp2][1][2], sc[2 * kp2][1][3]); w1.z = pk2(sc[2 * kp2 + 1][1][0], sc[2 * kp2 + 1][1][1]); w1.w = pk2(sc[2 * kp2 + 1][1][2], sc[2 * kp2 + 1][1][3]); \
                  const bf16x8 pf0 = __builtin_bit_cast(bf16x8, w0), pf1 = __builtin_bit_cast(bf16x8, w1); \
                  _Pragma("unroll") \
                  for (int dt = 0; dt < 4; ++dt) { const bf16x8 vf = *(const LAS bf16x8*)(vp + dt * 16 * VS_STRIDE + kp2 * 64); \
                      oacc[dt][0] = MFMA16(vf, pf0, oacc[dt][0]); oacc[dt][1] = MFMA16(vf, pf1, oacc[dt][1]); } } } \
            if (kt_ + 2 < NKT) { *(LAS u32x4*)(lds + (kt_ & 1) * KS_BYTES + lkn) = WKN; if (tid < 256) *(LAS u32x4*)(lds + (kt_ & 1) * KS_BYTES + lkr) = WKR; } \
            if (kt_ + 1 < NKT) { *(LAS u32x2*)(lds + ((kt_ + 1) & 1) * VS_BYTES + lvt) = (u32x2){WVT.x, WVT.y}; *(LAS u32x2*)(lds + ((kt_ + 1) & 1) * VS_BYTES + lvt + 16) = (u32x2){WVT.z, WVT.w}; } \
            __syncthreads(); \
            } while (0)
DI void attn_phase(LAS unsigned char* lds, const int wid, const bf16_t* Q, const bf16_t* Kn, const bf16_t* Kr, const bf16_t* Vt, bf16_t* O, int G, int c) {
    const int lane = lane_id(), tid = wid * 64 + lane, r16 = lane & 15, qd = lane >> 4;
    for (int it = 0;; ++it) {
        const long L = (long)it * G + c; if (L >= 2048) break;
        const int xcd = (int)(L & 7), idx = (int)(L >> 3), bh = (idx >> 5) * 8 + xcd, qb = idx & 31, b = bh >> 3, h = bh & 7;
        const size_t tok0 = (size_t)b * SEQ;
        const int q0 = qb * 256 + wid * 32;
        bf16x8 qf[2][3];
#pragma unroll
        for (int qt = 0; qt < 2; ++qt) { const bf16_t* qp = Q + (tok0 + q0 + 16 * qt + r16) * 768 + h * 96 + 8 * qd;
#pragma unroll
          for (int ks = 0; ks < 3; ++ks) qf[qt][ks] = *(const bf16x8*)(qp + 32 * ks); }
        f32x4 oacc[4][2], sa[4][2], sb[4][2];
        f32x4 negm0 = {0.f, 0.f, 0.f, 0.f}, negm1 = {0.f, 0.f, 0.f, 0.f};
#pragma unroll
        for (int t4 = 0; t4 < 4; ++t4) { oacc[t4][0] = (f32x4){0.f, 0.f, 0.f, 0.f}; oacc[t4][1] = (f32x4){0.f, 0.f, 0.f, 0.f}; }
        float l0 = 0.f, l1 = 0.f;
        const int skey = tid >> 3, sch = tid & 7;
        const int rkey = (tid & 255) >> 2, rch = tid & 3;
        const bf16_t* gkn = Kn + (tok0 + skey) * 512 + h * 64 + sch * 8;
        const bf16_t* gkr = Kr + (tok0 + rkey) * 32 + rch * 8;
        const bf16_t* gvt = Vt + (size_t)(h * 64 + skey) * T + tok0 + sch * 8;
        const unsigned lkn = skey * KS_STRIDE + sch * 16, lkr = rkey * KS_STRIDE + 128 + rch * 16, lvt = VOFF + skey * VS_STRIDE + (sch >> 2) * 64 + ((sch & 1) * 4 + ((sch >> 1) & 1)) * 8;
        u32x4 rkn = *(const u32x4*)gkn, rvt = *(const u32x4*)gvt, rkr = {0u, 0u, 0u, 0u};
        if (tid < 256) rkr = *(const u32x4*)gkr;
        *(LAS u32x4*)(lds + lkn) = rkn; *(LAS u32x2*)(lds + lvt) = (u32x2){rvt.x, rvt.y}; *(LAS u32x2*)(lds + lvt + 16) = (u32x2){rvt.z, rvt.w}; if (tid < 256) *(LAS u32x4*)(lds + lkr) = rkr;
        rkn = *(const u32x4*)(gkn + 64 * 512); if (tid < 256) rkr = *(const u32x4*)(gkr + 64 * 32);
        *(LAS u32x4*)(lds + KS_BYTES + lkn) = rkn; if (tid < 256) *(LAS u32x4*)(lds + KS_BYTES + lkr) = rkr;
        __syncthreads();
        { const LAS unsigned char* kp = lds + r16 * KS_STRIDE + qd * 16;
#pragma unroll
          for (int t4 = 0; t4 < 4; ++t4) { sa[t4][0] = negm0; sa[t4][1] = negm1; }
#pragma unroll
          for (int ks = 0; ks < 3; ++ks)
#pragma unroll
            for (int t4 = 0; t4 < 4; ++t4) { const bf16x8 kf = *(const LAS bf16x8*)(kp + t4 * 16 * KS_STRIDE + ks * 64);
                sa[t4][0] = MFMA16(kf, qf[0][ks], sa[t4][0]); sa[t4][1] = MFMA16(kf, qf[1][ks], sa[t4][1]); } }
        __syncthreads();
        u32x4 akn = *(const u32x4*)(gkn + (size_t)2 * 64 * 512), avt = *(const u32x4*)(gvt + 64), akr = {0u, 0u, 0u, 0u}, bkn, bkr = {0u, 0u, 0u, 0u}, bvt;
        if (tid < 256) akr = *(const u32x4*)(gkr + (size_t)2 * 64 * 32);
        if (wid >= 4) __builtin_amdgcn_s_setprio(1);
        for (int kt = 0; kt < NKT; kt += 2) {
            ATT_STEP(kt, bkn, bkr, bvt, akn, akr, avt, sa, sb);
            ATT_STEP(kt + 1, akn, akr, avt, bkn, bkr, bvt, sb, sa);
        }
        __builtin_amdgcn_s_setprio(0);
        l0 += __shfl_xor(l0, 16); l0 += __shfl_xor(l0, 32); l1 += __shfl_xor(l1, 16); l1 += __shfl_xor(l1, 32);
        const float inv0 = 1.0f / l0, inv1 = 1.0f / l1;
#pragma unroll
        for (int qt = 0; qt < 2; ++qt) { const float inv = qt ? inv1 : inv0;
            bf16_t* op = O + (tok0 + q0 + 16 * qt + r16) * 512 + h * 64 + 4 * qd;
#pragma unroll
            for (int dt = 0; dt < 4; ++dt) { u32x2 w; w.x = pk2(oacc[dt][qt][0] * inv, oacc[dt][qt][1] * inv); w.y = pk2(oacc[dt][qt][2] * inv, oacc[dt][qt][3] * inv);
                *(u32x2*)(op + 16 * dt) = w; } }
    }
}

#define XB_TMO      128
#define XB_XCNT(j)  (256  + 64 * (j))
#define XB_XSUB(j)  (1280 + 64 * (j))
#define XB_XGEN(j)  (2304 + 64 * (j))
#define XB_TOP      3328
#define XB_TOPGEN   3392
#define XCD_BAR_WORDS 3456
#define XB_SPIN_CAP (1u << 18)

__device__ __forceinline__ unsigned xb_ld(unsigned* p)              { return __hip_atomic_load(p, __ATOMIC_RELAXED, __HIP_MEMORY_SCOPE_AGENT); }
__device__ __forceinline__ unsigned xb_add(unsigned* p, unsigned v) { return __hip_atomic_fetch_add(p, v, __ATOMIC_RELAXED, __HIP_MEMORY_SCOPE_AGENT); }
__device__ __forceinline__ unsigned xb_xcc_id() { return (unsigned)__builtin_amdgcn_s_getreg((3 << 11) | 20) & 0xFu; }
#define XB_SPIN(cond, bar) do { unsigned _sp = 0; while (cond) { __builtin_amdgcn_s_sleep(1); \
    if ((++_sp & 255u) == 0u) { if (xb_ld(&(bar)[XB_TMO])) break; if (_sp > XB_SPIN_CAP) { atomicAdd(&(bar)[XB_TMO], 1u); break; } } } } while (0)

struct XcdBarrier {
    unsigned* bar; unsigned x;
    volatile LAS unsigned* st;
};

__device__ __forceinline__ XcdBarrier xcd_barrier_post(unsigned* bar, volatile LAS unsigned* st, const bool t0) {
    XcdBarrier b; b.bar = bar; b.x = xb_xcc_id(); b.st = st;
    if (t0) (void)xb_add(&bar[XB_XCNT(b.x)], 1u);
    return b;
}
__device__ __forceinline__ void xcd_barrier_complete(unsigned* bar, unsigned x, unsigned& nloc, unsigned& nx) {
    const unsigned G = gridDim.x * gridDim.y * gridDim.z;
    unsigned sum, cnt, mine, sp = 0u;
    for (;;) {
        sum = 0u; cnt = 0u; mine = 0u;
#pragma unroll
        for (unsigned j = 0; j < 16; ++j) { const unsigned c = xb_ld(&bar[XB_XCNT(j)]); sum += c; cnt += (c > 0u) ? 1u : 0u; mine = (j == x) ? c : mine; }
        if (sum == G) break;
        __builtin_amdgcn_s_sleep(1);
        if ((++sp & 255u) == 0u) { if (xb_ld(&bar[XB_TMO])) break; if (sp > XB_SPIN_CAP) { atomicAdd(&bar[XB_TMO], 1u); break; } }
    }
    nloc = mine > 0u ? mine : 1u; nx = cnt > 0u ? cnt : 1u;
}

__device__ __forceinline__ void xcd_barrier(const XcdBarrier& b, const bool t0) {
    asm volatile("s_waitcnt vmcnt(0)" ::: "memory");
    __syncthreads();
    if (t0) {
        unsigned* bar = b.bar;
        __builtin_amdgcn_s_waitcnt(0);
        unsigned nloc = b.st[0], nx = b.st[1];
        if (nloc == 0u) { xcd_barrier_complete(bar, b.x, nloc, nx); b.st[0] = nloc; b.st[1] = nx; }
        const unsigned old = xb_add(&bar[XB_XSUB(b.x)], 1u);
        const unsigned gen = old / nloc;
        if (old + 1u == (gen + 1u) * nloc) {
            __builtin_amdgcn_fence(__ATOMIC_RELEASE, "agent");
            asm volatile("s_waitcnt vmcnt(0)" ::: "memory");
            const unsigned og = xb_add(&bar[XB_TOP], 1u);
            const unsigned tg = og / nx;
            if (og + 1u == (tg + 1u) * nx) xb_add(&bar[XB_TOPGEN], 1u);
            else XB_SPIN(xb_ld(&bar[XB_TOPGEN]) == tg, bar);
            __builtin_amdgcn_fence(__ATOMIC_ACQUIRE, "agent");
            xb_add(&bar[XB_XGEN(b.x)], 1u);
            asm volatile("s_waitcnt vmcnt(0)" ::: "memory");
        } else {
            XB_SPIN(xb_ld(&bar[XB_XGEN(b.x)]) == gen, bar);
            __builtin_amdgcn_fence(__ATOMIC_ACQUIRE, "agent");
            asm volatile("s_waitcnt vmcnt(0)" ::: "memory");
        }
    }
    __syncthreads();
}

constexpr int LDS_BYTES = 147456;
#define WSB(off) ((bf16_t*)(KWS + (off)))
#define WSF(off) ((float*)(KWS + (off)))
#define SSQ(k) (WSF(O_SSQ) + (size_t)(k) * T)
__global__ void __launch_bounds__(512, 2) fwd_megakernel(Args args_unused) {
    extern __shared__ __attribute__((aligned(16))) unsigned char lds_raw[];
    LAS unsigned char* lds = (LAS unsigned char*)lds_raw;
    cg::grid_group grid = cg::this_grid();
    const int wid_s = __builtin_amdgcn_readfirstlane((int)threadIdx.x >> 6);
#define BAR_ST ((volatile LAS unsigned*)(lds + 131072 + 64))
#define T0 (wid_s == 0 && lane_id() == 0)
    if (T0) { BAR_ST[0] = 0u; BAR_ST[1] = 0u; }
    __syncthreads();
    (void)xcd_barrier_post((unsigned*)(KWS + O_CTL), BAR_ST, T0);
#define GRID_BAR() do { XcdBarrier b_; b_.bar = (unsigned*)(KWS + O_CTL); b_.x = xb_xcc_id(); b_.st = BAR_ST; xcd_barrier(b_, T0); } while (0)
#define TID (wid_s * 64 + lane_id())
#define LANE (lane_id())
#define WID (wid_s)
#define GG ((int)gridDim.x)
#define CC ((int)blockIdx.x)
#define GW (CC * 8 + WID)
#define NGW (GG * 8)
#define GT ((long)CC * 512 + TID)
#define NGT ((long)GG * 512)

    {
        { float* z = SSQ(1); for (long i = GT; i < 5L * T; i += NGT) z[i] = 0.f; }
        { const float* x = INF(I_X); bf16_t* hb = WSB(O_HB); float* ssq1 = SSQ(0); const int lane = LANE;
          for (int row = GW; row < T; row += 2 * NGW) {
            const int row2 = row + NGW; const bool has2 = row2 < T;
            const f32x4* xr = (const f32x4*)(x + (size_t)row * D) + lane; const f32x4* xq = (const f32x4*)(x + (size_t)(has2 ? row2 : row) * D) + lane;
            f32x4 v[4], w[4]; float s = 0.f, s2 = 0.f;
#pragma unroll
            for (int j = 0; j < 4; ++j) { v[j] = xr[64 * j]; w[j] = xq[64 * j]; }
#pragma unroll
            for (int j = 0; j < 4; ++j) { s += (v[j][0] * v[j][0] + v[j][1] * v[j][1]) + (v[j][2] * v[j][2] + v[j][3] * v[j][3]); s2 += (w[j][0] * w[j][0] + w[j][1] * w[j][1]) + (w[j][2] * w[j][2] + w[j][3] * w[j][3]); }
            s = wave_sum(s); s2 = wave_sum(s2);
            if (lane == 0) { ssq1[row] = s; if (has2) ssq1[row2] = s2; }
            u32x2* o8 = (u32x2*)(hb + (size_t)row * D) + lane;
#pragma unroll
            for (int j = 0; j < 4; ++j) { u32x2 t; t.x = pk2(v[j][0], v[j][1]); t.y = pk2(v[j][2], v[j][3]); o8[64 * j] = t; }
            if (has2) { u32x2* o9 = (u32x2*)(hb + (size_t)row2 * D) + lane;
#pragma unroll
              for (int j = 0; j < 4; ++j) { u32x2 t; t.x = pk2(w[j][0], w[j][1]); t.y = pk2(w[j][2], w[j][3]); o9[64 * j] = t; } }
          } }
        { const int* pos = (const int*)karg(I_POS); f32x2* rope = (f32x2*)(KWS + O_ROPE);
          for (long i = GT; i < (long)T * 16; i += NGT) { const int t = (int)(i >> 4), fi = (int)(i & 15);
            const float invf = (float)exp2(-(double)fi * 0.83048202372184058696); const float ang = (float)pos[t] * invf;
            rope[i] = (f32x2){cosf(ang), sinf(ang)}; } }
        {
            const int lane = LANE; LAS float* scr = (LAS float*)(lds + WID * 16384);
            constexpr int I_GU = 16 * 176, I_D = 44 * 32, I_IN = 16 * 96, I_UQ = 4 * 24, I_UK = 2 * 16, I_OA = 8 * 32, I_OUT = 16 * 32;
            constexpr int NITEMS = 2 * I_GU + 2 * I_D + I_IN + I_UQ + 2 * I_UK + 3 * I_OA + I_OUT;
            for (int it = GW; it < NITEMS; it += NGW) {
                int r = it;
                if (r < I_GU) { prep_item(FGateUp{INF(I_WG1), INF(I_WU1), INF(I_N1)}, D, 176, WSB(O_WGU1), scr, r, lane); continue; } r -= I_GU;
                if (r < I_GU) { prep_item(FGateUp{INF(I_WG2), INF(I_WU2), INF(I_N2)}, D, 176, WSB(O_WGU2), scr, r, lane); continue; } r -= I_GU;
                if (r < I_D) { prep_item(FPlain{INF(I_WD1), D}, FF, 32, WSB(O_WD1), scr, r, lane); continue; } r -= I_D;
                if (r < I_D) { prep_item(FPlain{INF(I_WD2), D}, FF, 32, WSB(O_WD2), scr, r, lane); continue; } r -= I_D;
                if (r < I_IN) { prep_item(FWin{INF(I_WIN), INF(I_NMIX)}, D, 96, WSB(O_WIN), scr, r, lane); continue; } r -= I_IN;
                if (r < I_UQ) { prep_item(FWuq{INF(I_WUQ), INF(I_QN)}, 256, 24, WSB(O_WUQ), scr, r, lane); continue; } r -= I_UQ;
                if (r < I_UK) { prep_item(FWukv{INF(I_WUKV), INF(I_KVN), 0}, 128, 16, WSB(O_WUK), scr, r, lane); continue; } r -= I_UK;
                if (r < I_UK) { prep_item(FWukv{INF(I_WUKV), INF(I_KVN), 64}, 128, 16, WSB(O_WUV), scr, r, lane); continue; } r -= I_UK;
                if (r < I_OA) { prep_item(FPlain{INF(I_WOA), D}, 512, 32, WSB(O_WOA), scr, r, lane); continue; } r -= I_OA;
                if (r < I_OA) { prep_item(FWglu{INF(I_WGLU)}, 512, 32, WSB(O_WGLU), scr, r, lane); continue; } r -= I_OA;
                if (r < I_OA) { prep_item(FPlain{INF(I_WOS), D}, 512, 32, WSB(O_WOS), scr, r, lane); continue; } r -= I_OA;
                prep_item(FPlain{INF(I_WOUT), D}, D, 32, WSB(O_WOUT), scr, r, lane);
            }
        }
        { const float *ilre = INF(I_LRE), *ilim = INF(I_LIM), *ildt = INF(I_LDT), *ibre = INF(I_BRE), *ibim = INF(I_BIM), *icre = INF(I_CRE), *icim = INF(I_CIM); float* kt = WSF(O_KT);
          for (long it = GT; it < 131072; it += NGT) {
            const int pq = (int)it & 3, i = ((int)it >> 2) & 15, d = ((int)it >> 6) & 31, dir = ((int)it >> 11) & 1, g = (int)it >> 12, dg = dir * 32 + g;
            const float dt = expf(ildt[dg]); float a16[16];
#pragma unroll
            for (int q = 0; q < 16; ++q) a16[q] = 0.f;
            for (int p = pq * 16; p < pq * 16 + 16; ++p) {
                const float lre = ilre[dg * 64 + p], lim = ilim[dg * 64 + p]; float kr_, ki_, pr, pi;
                lam_kfac(lre, lim, dt, kr_, ki_); lam_pow(lre, lim, dt, (float)d, pr, pi);
                const float cr = icre[(dg * 16 + i) * 64 + p], ci = icim[(dg * 16 + i) * 64 + p];
                const float tr = cr * pr - ci * pi, ti = cr * pi + ci * pr, gr = tr * kr_ - ti * ki_, gi = tr * ki_ + ti * kr_;
                const f32x4* br = (const f32x4*)(ibre + (size_t)(dg * 64 + p) * 16); const f32x4* bi = (const f32x4*)(ibim + (size_t)(dg * 64 + p) * 16);
#pragma unroll
                for (int q = 0; q < 4; ++q) { const f32x4 x = br[q], y = bi[q];
#pragma unroll
                    for (int e = 0; e < 4; ++e) a16[4 * q + e] += gr * x[e] - gi * y[e]; }
            }
#pragma unroll
            for (int q = 0; q < 16; ++q) { a16[q] += __shfl_xor(a16[q], 1); a16[q] += __shfl_xor(a16[q], 2); }
            f32x4* o = (f32x4*)(kt + ((size_t)(g * 2 + dir) * 32 + d) * 256 + i * 16);
            if (pq == 0) {
#pragma unroll
            for (int q = 0; q < 4; ++q) o[q] = (f32x4){a16[4 * q], a16[4 * q + 1], a16[4 * q + 2], a16[4 * q + 3]}; }
          }
          bf16_t* wst = WSB(O_WST);
          for (long it = GT; it < 262144; it += NGT) {
            const int j = (int)it & 31, n = ((int)it >> 5) & 255, g = (int)it >> 13, dir = n >> 7, p = (n & 127) >> 1, ri = n & 1, dg = dir * 32 + g;
            const float dt = expf(ildt[dg]), lre = ilre[dg * 64 + p], lim = ilim[dg * 64 + p]; float kr_, ki_, pr, pi;
            lam_kfac(lre, lim, dt, kr_, ki_); lam_pow(lre, lim, dt, (float)(dir == 0 ? 31 - j : j), pr, pi);
            const float gr = pr * kr_ - pi * ki_, gi = pr * ki_ + pi * kr_;
            const f32x4* br = (const f32x4*)(ibre + (size_t)(dg * 64 + p) * 16); const f32x4* bi = (const f32x4*)(ibim + (size_t)(dg * 64 + p) * 16);
            f32x4 v[4];
#pragma unroll
            for (int q = 0; q < 4; ++q) { const f32x4 x = br[q], y = bi[q]; v[q] = ri ? (gr * y + gi * x) : (gr * x - gi * y); }
            u32x4* o = (u32x4*)(wst + ((size_t)g * 256 + n) * 512 + j * 16);
            o[0] = pack8(v[0], v[1]); o[1] = pack8(v[2], v[3]);
          }
          bf16_t* wss2 = WSB(O_WSS2);
          for (long it = GT; it < 262144; it += NGT) {
            const int pc = (int)it & 7, dir = ((int)it >> 3) & 1, n = ((int)it >> 4) & 511, g = (int)it >> 13, tau = n >> 4, i = n & 15, dg = dir * 32 + g;
            const float dt = expf(ildt[dg]), e = (float)(dir == 0 ? tau + 1 : 32 - tau); float v[16];
#pragma unroll
            for (int q = 0; q < 8; ++q) { const int p = pc * 8 + q; float pr, pi; lam_pow(ilre[dg * 64 + p], ilim[dg * 64 + p], dt, e, pr, pi);
                const float cr = icre[(dg * 16 + i) * 64 + p], ci = icim[(dg * 16 + i) * 64 + p];
                v[2 * q] = cr * pr - ci * pi; v[2 * q + 1] = -(cr * pi + ci * pr); }
            u32x4* o = (u32x4*)(wss2 + ((size_t)g * 512 + n) * KP + 512 + dir * 128 + pc * 16);
            u32x4 w0, w1; w0.x = pk2(v[0], v[1]); w0.y = pk2(v[2], v[3]); w0.z = pk2(v[4], v[5]); w0.w = pk2(v[6], v[7]); w1.x = pk2(v[8], v[9]); w1.y = pk2(v[10], v[11]); w1.z = pk2(v[12], v[13]); w1.w = pk2(v[14], v[15]);
            o[0] = w0; o[1] = w1;
          }
          float* al = WSF(O_AL);
          for (long it = GT; it < 4096; it += NGT) { const int p = (int)it & 63, dir = ((int)it >> 6) & 1, g = (int)it >> 7, dg = dir * 32 + g; float pr, pi;
            lam_pow_exact(ilre[dg * 64 + p], ilim[dg * 64 + p], expf(ildt[dg]), 32.0f, pr, pi); al[it * 2] = pr; al[it * 2 + 1] = pi; }
        }
    }
    if (GG == 0x7fffffff) grid.sync();
    GRID_BAR();

    { const float* kt = WSF(O_KT); const float* dsk = INF(I_DSK); bf16_t* wss2 = WSB(O_WSS2);
      for (long it = GT; it < 524288; it += NGT) {
        const int j = (int)it & 31, n = ((int)it >> 5) & 511, g = (int)it >> 14, tau = n >> 4, i = n & 15;
        f32x4 v[4];
#pragma unroll
        for (int q = 0; q < 4; ++q) v[q] = (f32x4){0.f, 0.f, 0.f, 0.f};
        if (j <= tau) { const f32x4* s = (const f32x4*)(kt + ((size_t)(g * 2 + 0) * 32 + (tau - j)) * 256 + i * 16);
#pragma unroll
            for (int q = 0; q < 4; ++q) v[q] += s[q]; }
        if (j >= tau) { const f32x4* s = (const f32x4*)(kt + ((size_t)(g * 2 + 1) * 32 + (j - tau)) * 256 + i * 16);
#pragma unroll
            for (int q = 0; q < 4; ++q) v[q] += s[q]; }
        if (j == tau) { const float dv = dsk[g * 16 + i];
#pragma unroll
            for (int q = 0; q < 4; ++q)
#pragma unroll
                for (int e = 0; e < 4; ++e) if (4 * q + e == i) v[q][e] += dv; }
        u32x4* o = (u32x4*)(wss2 + ((size_t)g * 512 + n) * KP + j * 16);
        o[0] = pack8(v[0], v[1]); o[1] = pack8(v[2], v[3]);
      } }
    { pg8::Gemm g{WSB(O_HB), WSB(O_WGU1), D, D, D, 0, 0}; pg8::Order S; S.init(T / 256, 22, 1, GG, CC); EpiSwiglu E{SSQ(0), WSB(O_ACT)}; pg8::gemm_phase(lds, wid_s, g, S, E); }
    GRID_BAR();
    { pg8::Gemm g{WSB(O_ACT), WSB(O_WD1), FF, FF, FF, 0, 0}; pg8::Order S; S.init(T / 256, 4, 1, GG, CC); EpiResid E{INF(I_X), WSF(O_H), 0.5f, WSB(O_HB), SSQ(1)}; pg8::gemm_phase(lds, wid_s, g, S, E); }
    GRID_BAR();
    { pg8::Gemm g{WSB(O_HB), WSB(O_WIN), D, D, D, 0, 0}; pg8::Order S; S.init(T / 256, 12, 1, GG, CC); EpiWin E{SSQ(0), (const f32x2*)(KWS + O_ROPE), KWS, (bf16_t*)KOUT}; pg8::gemm_phase(lds, wid_s, g, S, E); }
    GRID_BAR();
    { pg8::Gemm g{WSB(O_CQ), WSB(O_WUQ), 256, 256, 256, 0, 0}; pg8::Order S; S.init(T / 256, 3, 1, GG, CC); EpiQ E{SSQ(2), (const f32x2*)(KWS + O_ROPE), WSB(O_Q)}; pg8::gemm_phase(lds, wid_s, g, S, E); }
    { pg8::Gemm g{WSB(O_CKV), WSB(O_WUK), 128, 128, 128, 0, 0}; pg8::Order S; S.init(T / 256, 2, 1, GG, CC); EpiRowScale E{SSQ(3), 1.0f / 128, WSB(O_KN), 512}; pg8::gemm_phase(lds, wid_s, g, S, E); }
    { pg8::Gemm g{WSB(O_WUV), WSB(O_CKV), 128, 128, 128, 0, 0}; pg8::Order S; S.init(2, T / 256, 1, GG, CC); EpiVt E{SSQ(3), WSB(O_VT)}; pg8::gemm_phase(lds, wid_s, g, S, E); }
    { pg8::Gemm g{WSB(O_APACK), WSB(O_WST), KP, 512, 512, (size_t)MG * KP, (size_t)256 * 512}; pg8::Order S; S.init(MG / 256, 1, 32, GG, CC); EpiSloc E{WSF(O_SLOC)}; pg8::gemm_phase(lds, wid_s, g, S, E); }
    GRID_BAR();
    { const float* al = WSF(O_AL); const float* sloc = WSF(O_SLOC); bf16_t* apack = WSB(O_APACK); const int G = GG;
      for (int it = WID * G + CC; it < 512; it += 8 * G) {
        const int dir = it & 1, g = (it >> 1) & 31, b = it >> 6, p = LANE;
        const float ar = al[((g * 2 + dir) * 64 + p) * 2], ai_ = al[((g * 2 + dir) * 64 + p) * 2 + 1];
        float hr = 0.f, hi = 0.f;
        for (int c0 = 0; c0 < NCH; c0 += 32) {
            f32x2 s[32];
#pragma unroll
            for (int e = 0; e < 32; ++e) { const int cc = dir ? NCH - 1 - (c0 + e) : c0 + e; s[e] = *(const f32x2*)(sloc + ((size_t)g * MG + b * NCH + cc) * 256 + dir * 128 + 2 * p); }
#pragma unroll
            for (int e = 0; e < 32; ++e) { const int cc = dir ? NCH - 1 - (c0 + e) : c0 + e;
                *(unsigned*)(apack + ((size_t)g * MG + b * NCH + cc) * KP + 512 + dir * 128 + 2 * p) = pk2(hr, hi);
                const float nr = ar * hr - ai_ * hi + s[e][0], ni = ar * hi + ai_ * hr + s[e][1]; hr = nr; hi = ni; }
        }
      } }
    attn_phase(lds, wid_s, WSB(O_Q), WSB(O_KN), WSB(O_KR), WSB(O_VT), WSB(O_ATTN), GG, CC);
    GRID_BAR();
    { pg8::Gemm g{WSB(O_APACK), WSB(O_WSS2), KP, KP, KP, (size_t)MG * KP, (size_t)512 * KP}; pg8::Order S; S.init(MG / 256, 2, 32, GG, CC); EpiSsmOut E{WSB(O_GY)}; pg8::gemm_phase(lds, wid_s, g, S, E); }
    { pg8::Gemm g{WSB(O_ATTN), WSB(O_WOA), 512, 512, 512, 0, 0}; pg8::Order S; S.init(T / 256, 4, 1, GG, CC); EpiGate<0> E{(const bf16_t*)KOUT, nullptr, WSB(O_MRG)}; pg8::gemm_phase(lds, wid_s, g, S, E); }
    GRID_BAR();
    { pg8::Gemm g{WSB(O_GY), WSB(O_WGLU), 512, 512, 512, 0, 0}; pg8::Order S; S.init(T / 256, 4, 1, GG, CC); EpiGlu E{INF(I_BGLU), WSB(O_SO)}; pg8::gemm_phase(lds, wid_s, g, S, E); }
    GRID_BAR();
    { pg8::Gemm g{WSB(O_SO), WSB(O_WOS), 512, 512, 512, 0, 0}; pg8::Order S; S.init(T / 256, 4, 1, GG, CC); EpiGate<1> E{(const bf16_t*)KOUT + (size_t)T * D, WSB(O_MRG), WSB(O_MG)}; pg8::gemm_phase(lds, wid_s, g, S, E); }
    GRID_BAR();
    { pg8::Gemm g{WSB(O_MG), WSB(O_WOUT), D, D, D, 0, 0}; pg8::Order S; S.init(T / 256, 4, 1, GG, CC); EpiResid E{WSF(O_H), WSF(O_H), 1.0f, WSB(O_HB), SSQ(4)}; pg8::gemm_phase(lds, wid_s, g, S, E); }
    GRID_BAR();
    { pg8::Gemm g{WSB(O_HB), WSB(O_WGU2), D, D, D, 0, 0}; pg8::Order S; S.init(T / 256, 22, 1, GG, CC); EpiSwiglu E{SSQ(4), WSB(O_ACT)}; pg8::gemm_phase(lds, wid_s, g, S, E); }
    GRID_BAR();
    if (GG == 256) {
        pg8::Gemm g{WSB(O_ACT), WSB(O_WD2), FF, FF, FF, 0, 0}; pg8::Order S; S.init(T / 256, 4, 1, GG, CC); EpiResidNorm E{WSF(O_H), KOUT, 0.5f, SSQ(5), (unsigned*)(KWS + O_PCNT), INF(I_NF)}; pg8::gemm_phase(lds, wid_s, g, S, E);
    } else {
    { pg8::Gemm g{WSB(O_ACT), WSB(O_WD2), FF, FF, FF, 0, 0}; pg8::Order S; S.init(T / 256, 4, 1, GG, CC); EpiResid E{WSF(O_H), KOUT, 0.5f, nullptr, SSQ(5)}; pg8::gemm_phase(lds, wid_s, g, S, E); }
    GRID_BAR();
    { const float* ssq4 = SSQ(5); float* out = KOUT; const f32x4* gn = (const f32x4*)INF(I_NF) + LANE; const int lane = LANE;
      for (int row = GW; row < T; row += NGW) {
        const float r = rstd_of(ssq4[row], 1.0f / D);
        f32x4* o = (f32x4*)(out + (size_t)row * D) + lane;
#pragma unroll
        for (int j = 0; j < 4; ++j) o[64 * j] = o[64 * j] * r * gn[64 * j];
      } }
    }
}

extern "C" void kernel_launch(void* const* d_in, const int* in_sizes, int n_in, void* d_out, int out_size, void* d_ws, size_t ws_size, hipStream_t stream) {
    static int grid = 0;
    if (grid == 0) {
        if (n_in != 30 || out_size != T * D || ws_size < WS_NEED) { fprintf(stderr, "kernel_launch: unexpected problem (n_in %d, out %d, ws %zu)\n", n_in, out_size, ws_size); grid = -1; return; }
        int dev = 0, cus = 0, per_cu = 0;
        (void)hipGetDevice(&dev); (void)hipDeviceGetAttribute(&cus, hipDeviceAttributeMultiprocessorCount, dev);
        if (hipFuncSetAttribute((const void*)fwd_megakernel, hipFuncAttributeMaxDynamicSharedMemorySize, LDS_BYTES) != hipSuccess) { fprintf(stderr, "kernel_launch: hipFuncSetAttribute failed\n"); grid = -1; return; }
        if (hipOccupancyMaxActiveBlocksPerMultiprocessor(&per_cu, (const void*)fwd_megakernel, 512, LDS_BYTES) != hipSuccess || per_cu < 1) { fprintf(stderr, "kernel_launch: occupancy query gave %d\n", per_cu); per_cu = 1; }
        (void)hipGetLastError();
        grid = cus * per_cu; if (grid > 256) grid = 256; grid &= ~7; if (grid < 8) grid = 8;
    }
    if (grid < 0) return;
    if (hipMemsetAsync((char*)d_ws + O_CTL, 0, CTL_BYTES, stream) != hipSuccess) { fprintf(stderr, "kernel_launch: memset of the barrier words failed\n"); return; }
    Args a{};
    for (int i = 0; i < 30; ++i) a.in[i] = d_in[i];
    a.out = (float*)d_out; a.ws = (unsigned char*)d_ws;
    void* kargs[] = {&a};
    hipError_t e = hipLaunchCooperativeKernel((const void*)fwd_megakernel, dim3(grid), dim3(512), kargs, LDS_BYTES, stream);
    if (e != hipSuccess) fprintf(stderr, "cooperative launch failed: %s (grid %d)\n", hipGetErrorString(e), grid);
}
```
